# Optimizing an MI355X kernel written in HIP

```python
import math
import jax
import jax.numpy as jnp
from jax import lax
import numpy as np

D_MODEL = 1024
BATCH = 2
SEQ = 16384
DEPTH = 4
DEC_BATCH = 16
DEC_SEQ = 16
PAST_LEN = 2048

CHUNK = 64
SSM_WIDTH = 512
SSM_GROUP = 16
SSM_GROUPS = SSM_WIDTH // SSM_GROUP
SSM_STATE = 64
N_HEADS = 8
N_KV_HEADS = 2
HEAD_DIM = 64
Q_PER_KV = N_HEADS // N_KV_HEADS
ATTN_WIDTH = N_HEADS * HEAD_DIM
KV_WIDTH = N_KV_HEADS * HEAD_DIM
WINDOW = 128
WINDOW_CHUNKS = WINDOW // CHUNK
BAND = (WINDOW_CHUNKS + 1) * CHUNK
ROPE_DIM = HEAD_DIM // 4
ROPE_THETA = 500000.0
N_BRANCHES = 2
IN_COLS = SSM_WIDTH + ATTN_WIDTH + 2 * KV_WIDTH + N_BRANCHES * D_MODEL
D_FF = 2816
CONV_WIDTH = 3
N_ADA = 6
RMS_EPS = 1e-6
NEG_INF = -1e30

kernel_name = 'hybrid_s5_swa_sink_convffn_stream_step'


def rms_norm(x, g):
    xf = x.astype(jnp.float32)
    y = xf * lax.rsqrt(jnp.mean(xf * xf, axis=-1, keepdims=True) + RMS_EPS)
    return (y * g.astype(jnp.float32)).astype(x.dtype)


def modulate(x, shift, scale):
    return x * (1 + scale[:, None, :]) + shift[:, None, :]


def rotary(x, pos):
    half = ROPE_DIM // 2
    inv_freq = ROPE_THETA ** (-(jnp.arange(half, dtype=jnp.float32) * 2.0) / ROPE_DIM)
    ang = pos.astype(jnp.float32)[:, None] * inv_freq[None, :]
    cos = jnp.cos(ang)[:, None, :]
    sin = jnp.sin(ang)[:, None, :]
    xf = x.astype(jnp.float32)
    x1 = xf[..., :half]
    x2 = xf[..., half:ROPE_DIM]
    out = jnp.concatenate([x1 * cos - x2 * sin, x2 * cos + x1 * sin, xf[..., ROPE_DIM:]], axis=-1)
    return out.astype(x.dtype)


def sink_softmax(s, sink):
    m = jnp.maximum(jnp.max(s, axis=-1, keepdims=True), sink)
    p = jnp.exp(s - m)
    return p / (jnp.sum(p, axis=-1, keepdims=True) + jnp.exp(sink - m))


def banded_attention(q, k, v, sink):
    b, l = q.shape[0], q.shape[1]
    nc = l // CHUNK
    qb = q.reshape(b, nc, CHUNK, N_KV_HEADS, Q_PER_KV, HEAD_DIM).astype(jnp.float32)

    def band(t):
        tp = jnp.pad(t, ((0, 0), (WINDOW, 0), (0, 0), (0, 0)))
        tp = tp.reshape(b, nc + WINDOW_CHUNKS, CHUNK, N_KV_HEADS, HEAD_DIM)
        return jnp.concatenate([tp[:, j:j + nc] for j in range(WINDOW_CHUNKS + 1)], axis=2)

    kb = band(k).astype(jnp.float32)
    vb = band(v).astype(jnp.float32)
    s = jnp.einsum('bnqhgd,bnkhd->bnhgqk', qb, kb) * (HEAD_DIM ** -0.5)
    key_chunk = jnp.arange(nc)[:, None] - WINDOW_CHUNKS + jnp.arange(BAND)[None, :] // CHUNK
    valid = key_chunk >= 0
    s = jnp.where(valid[None, :, None, None, None, :], s, NEG_INF)
    sk = sink.astype(jnp.float32).reshape(N_KV_HEADS, Q_PER_KV)[None, None, :, :, None, None]
    p = sink_softmax(s, sk)
    o = jnp.einsum('bnhgqk,bnkhd->bnqhgd', p, vb)
    return o.reshape(b, l, ATTN_WIDTH).astype(q.dtype)


def cached_attention(q, k, v, past_k, past_v, sink):
    b, t = q.shape[0], q.shape[1]
    qs = q.reshape(b, t, N_KV_HEADS, Q_PER_KV, HEAD_DIM).astype(jnp.float32)
    k_all = jnp.concatenate([past_k, k], axis=1).astype(jnp.float32)
    v_all = jnp.concatenate([past_v, v], axis=1).astype(jnp.float32)
    s = jnp.einsum('bqhgd,bkhd->bhgqk', qs, k_all) * (HEAD_DIM ** -0.5)
    sk = sink.astype(jnp.float32).reshape(N_KV_HEADS, Q_PER_KV)[None, :, :, None, None]
    p = sink_softmax(s, sk)
    o = jnp.einsum('bhgqk,bkhd->bqhgd', p, v_all)
    return o.reshape(b, t, ATTN_WIDTH).astype(q.dtype)


def ssm_discretise(a_re, a_im, log_dt, b_re, b_im):
    a_re = a_re.astype(jnp.float32)
    a_im = a_im.astype(jnp.float32)
    dt = jnp.exp(log_dt.astype(jnp.float32))[:, None]
    mag = jnp.exp(a_re * dt)
    abar_re = mag * jnp.cos(a_im * dt)
    abar_im = mag * jnp.sin(a_im * dt)
    nr = abar_re - 1.0
    ni = abar_im
    den = a_re * a_re + a_im * a_im
    fr = (nr * a_re + ni * a_im) / den
    fi = (ni * a_re - nr * a_im) / den
    b_re = b_re.astype(jnp.float32)
    b_im = b_im.astype(jnp.float32)
    bbar_re = fr[..., None] * b_re - fi[..., None] * b_im
    bbar_im = fr[..., None] * b_im + fi[..., None] * b_re
    return abar_re, abar_im, bbar_re, bbar_im


def ssm_combine(e1, e2):
    a1r, a1i, b1r, b1i = e1
    a2r, a2i, b2r, b2i = e2
    return (a2r * a1r - a2i * a1i,
            a2r * a1i + a2i * a1r,
            a2r * b1r - a2i * b1i + b2r,
            a2r * b1i + a2i * b1r + b2i)


def ssm_mixer(u, s0_re, s0_im, a_re, a_im, log_dt, b_re, b_im, c_re, c_im, d_skip):
    b, l = u.shape[0], u.shape[1]
    uf = u.astype(jnp.float32)
    ug = uf.reshape(b, l, SSM_GROUPS, SSM_GROUP)
    abr, abi, bbr, bbi = ssm_discretise(a_re, a_im, log_dt, b_re, b_im)
    xr = jnp.einsum('gpc,blgc->blgp', bbr, ug)
    xi = jnp.einsum('gpc,blgc->blgp', bbi, ug)
    ar = jnp.broadcast_to(abr, (1, l, SSM_GROUPS, SSM_STATE))
    ai = jnp.broadcast_to(abi, (1, l, SSM_GROUPS, SSM_STATE))
    pr, pi, hr, hi = lax.associative_scan(ssm_combine, (ar, ai, xr, xi), axis=1)
    s0r = s0_re.astype(jnp.float32)[:, None]
    s0i = s0_im.astype(jnp.float32)[:, None]
    sr = hr + pr * s0r - pi * s0i
    si = hi + pr * s0i + pi * s0r
    y = (jnp.einsum('gcp,blgp->blgc', c_re.astype(jnp.float32), sr)
         - jnp.einsum('gcp,blgp->blgc', c_im.astype(jnp.float32), si))
    y = y.reshape(b, l, SSM_WIDTH) + d_skip.astype(jnp.float32) * uf
    return y.astype(u.dtype), sr[:, -1], si[:, -1]


def causal_dwconv(h, prev, w, bias):
    l = h.shape[1]
    hp = jnp.concatenate([prev.astype(h.dtype), h], axis=1)
    out = bias + hp[:, 0:l] * w[0]
    for j in range(1, CONV_WIDTH):
        out = out + hp[:, j:j + l] * w[j]
    return out, hp[:, -(CONV_WIDTH - 1):]


def block(x, c, pos, past_k, past_v, s0_re, s0_im, conv_prev,
          ada_w, ada_b, norm1_g, norm2_g, w_in, a_re, a_im, log_dt, b_re, b_im,
          c_re, c_im, d_skip, w_glu, sink, w_attn_o, w_out, w_up, conv_w, conv_b, w_down):
    b, l = x.shape[0], x.shape[1]
    mod = jnp.einsum('bd,de->be', jax.nn.silu(c), ada_w) + ada_b
    sh1, sc1, g1, sh2, sc2, g2 = jnp.split(mod, N_ADA, axis=-1)
    h = modulate(rms_norm(x, norm1_g), sh1, sc1)
    proj = h @ w_in
    o1 = SSM_WIDTH
    o2 = o1 + ATTN_WIDTH
    o3 = o2 + KV_WIDTH
    o4 = o3 + KV_WIDTH
    u, q, k, v, gates = jnp.split(proj, [o1, o2, o3, o4], axis=-1)
    ga, gb = jnp.split(gates, N_BRANCHES, axis=-1)
    y_ssm, s_re, s_im = ssm_mixer(u, s0_re, s0_im, a_re, a_im, log_dt, b_re, b_im, c_re, c_im, d_skip)
    glu_a, glu_b = jnp.split(jax.nn.gelu(y_ssm) @ w_glu, 2, axis=-1)
    branch_a = glu_a * jax.nn.sigmoid(glu_b)
    q = rotary(q.reshape(b, l, N_HEADS, HEAD_DIM), pos)
    k = rotary(k.reshape(b, l, N_KV_HEADS, HEAD_DIM), pos)
    v = v.reshape(b, l, N_KV_HEADS, HEAD_DIM)
    if past_k is None:
        o = banded_attention(q, k, v, sink)
        new_k = k[:, -WINDOW:]
        new_v = v[:, -WINDOW:]
    else:
        o = cached_attention(q, k, v, past_k, past_v, sink)
        new_k = k
        new_v = v
    branch_b = o @ w_attn_o
    merged = jax.nn.sigmoid(ga) * branch_a + jax.nn.sigmoid(gb) * branch_b
    x = x + g1[:, None, :] * (merged @ w_out)
    h = modulate(rms_norm(x, norm2_g), sh2, sc2)
    up, conv_state = causal_dwconv(h @ w_up, conv_prev, conv_w, conv_b)
    val, gate = jnp.split(up, 2, axis=-1)
    x = x + g2[:, None, :] * ((jax.nn.silu(gate) * val) @ w_down)
    dt = x.dtype
    return x, (new_k.astype(dt), new_v.astype(dt), s_re.astype(dt), s_im.astype(dt), conv_state.astype(dt))


def stack_layers(states, i):
    return jnp.stack([s[i] for s in states], axis=0)


def setup_inputs(seed: int = 0) -> dict:
    key = jax.random.key(seed)
    ks = iter(jax.random.split(key, 40))
    f32 = jnp.float32

    def nrm(shape, scale):
        return jax.random.normal(next(ks), shape, f32) * scale

    n_idx = jnp.arange(SSM_STATE, dtype=f32)
    return {
        'x_prompt': nrm((BATCH, SEQ, D_MODEL), 1.0),
        'x_sample': nrm((DEC_BATCH, DEC_SEQ, D_MODEL), 1.0),
        'cache_k': nrm((DEPTH, DEC_BATCH, WINDOW, N_KV_HEADS, HEAD_DIM), 1.0),
        'cache_v': nrm((DEPTH, DEC_BATCH, WINDOW, N_KV_HEADS, HEAD_DIM), 1.0),
        'state_ssm_re': nrm((DEPTH, DEC_BATCH, SSM_GROUPS, SSM_STATE), 0.5),
        'state_ssm_im': nrm((DEPTH, DEC_BATCH, SSM_GROUPS, SSM_STATE), 0.5),
        'state_conv': nrm((DEPTH, DEC_BATCH, CONV_WIDTH - 1, 2 * D_FF), 1.0),
        'c_prompt': nrm((BATCH, D_MODEL), 1.0),
        'c_sample': nrm((DEC_BATCH, D_MODEL), 1.0),
        'ada_w': nrm((DEPTH, D_MODEL, N_ADA * D_MODEL), 0.5 * D_MODEL ** -0.5),
        'ada_b': nrm((DEPTH, N_ADA * D_MODEL), 0.01),
        'norm1_g': 1.0 + nrm((DEPTH, D_MODEL), 0.01),
        'norm2_g': 1.0 + nrm((DEPTH, D_MODEL), 0.01),
        'w_in': nrm((DEPTH, D_MODEL, IN_COLS), D_MODEL ** -0.5),
        'ssm_a_re': -0.5 + nrm((DEPTH, SSM_GROUPS, SSM_STATE), 0.01),
        'ssm_a_im': math.pi * n_idx + nrm((DEPTH, SSM_GROUPS, SSM_STATE), 0.01),
        'ssm_log_dt': jax.random.uniform(next(ks), (DEPTH, SSM_GROUPS), f32, math.log(1e-3), math.log(1e-1)),
        'ssm_b_re': nrm((DEPTH, SSM_GROUPS, SSM_STATE, SSM_GROUP), (2 * SSM_GROUP) ** -0.5),
        'ssm_b_im': nrm((DEPTH, SSM_GROUPS, SSM_STATE, SSM_GROUP), (2 * SSM_GROUP) ** -0.5),
        'ssm_c_re': nrm((DEPTH, SSM_GROUPS, SSM_GROUP, SSM_STATE), SSM_STATE ** -0.5),
        'ssm_c_im': nrm((DEPTH, SSM_GROUPS, SSM_GROUP, SSM_STATE), SSM_STATE ** -0.5),
        'ssm_d': nrm((DEPTH, SSM_WIDTH), 1.0),
        'w_glu': nrm((DEPTH, SSM_WIDTH, 2 * D_MODEL), SSM_WIDTH ** -0.5),
        'attn_sink': nrm((DEPTH, N_HEADS), 0.5),
        'w_attn_o': nrm((DEPTH, ATTN_WIDTH, D_MODEL), ATTN_WIDTH ** -0.5),
        'w_out': nrm((DEPTH, D_MODEL, D_MODEL), D_MODEL ** -0.5),
        'ffn_w_up': nrm((DEPTH, D_MODEL, 2 * D_FF), D_MODEL ** -0.5),
        'ffn_conv_w': nrm((DEPTH, CONV_WIDTH, 2 * D_FF), CONV_WIDTH ** -0.5),
        'ffn_conv_b': nrm((DEPTH, 2 * D_FF), 0.01),
        'ffn_w_down': nrm((DEPTH, D_FF, D_MODEL), D_FF ** -0.5),
        'final_g': 1.0 + nrm((D_MODEL,), 0.01),
    }


def reference(x_prompt, x_sample, cache_k, cache_v, state_ssm_re, state_ssm_im, state_conv,
              c_prompt, c_sample, ada_w, ada_b, norm1_g, norm2_g, w_in, ssm_a_re, ssm_a_im,
              ssm_log_dt, ssm_b_re, ssm_b_im, ssm_c_re, ssm_c_im, ssm_d, w_glu, attn_sink,
              w_attn_o, w_out, ffn_w_up, ffn_conv_w, ffn_conv_b, ffn_w_down, final_g):
    bp, lp = x_prompt.shape[0], x_prompt.shape[1]
    ls = x_sample.shape[1]
    pos_p = jnp.arange(lp)
    pos_s = PAST_LEN + jnp.arange(ls)
    zero_ssm = jnp.zeros((bp, SSM_GROUPS, SSM_STATE), x_prompt.dtype)
    zero_conv = jnp.zeros((bp, CONV_WIDTH - 1, 2 * D_FF), x_prompt.dtype)
    xp = x_prompt
    xs = x_sample
    st_p = []
    st_s = []
    for i in range(DEPTH):
        w = (ada_w[i], ada_b[i], norm1_g[i], norm2_g[i], w_in[i], ssm_a_re[i], ssm_a_im[i],
             ssm_log_dt[i], ssm_b_re[i], ssm_b_im[i], ssm_c_re[i], ssm_c_im[i], ssm_d[i],
             w_glu[i], attn_sink[i], w_attn_o[i], w_out[i], ffn_w_up[i], ffn_conv_w[i],
             ffn_conv_b[i], ffn_w_down[i])
        xp, sp = block(xp, c_prompt, pos_p, None, None, zero_ssm, zero_ssm, zero_conv, *w)
        xs, ss = block(xs, c_sample, pos_s, cache_k[i], cache_v[i], state_ssm_re[i],
                       state_ssm_im[i], state_conv[i], *w)
        st_p.append(sp)
        st_s.append(ss)
    y_prompt = rms_norm(xp, final_g)
    y_sample = rms_norm(xs, final_g)
    return (y_prompt, y_sample,
            stack_layers(st_p, 0), stack_layers(st_p, 1), stack_layers(st_p, 2),
            stack_layers(st_p, 3), stack_layers(st_p, 4),
            stack_layers(st_s, 0), stack_layers(st_s, 1), stack_layers(st_s, 2),
            stack_layers(st_s, 3), stack_layers(st_s, 4))
```

```cpp
#include <hip/hip_runtime.h>
#include <hip/hip_cooperative_groups.h>
#include <cstdio>
#include <cstdint>
namespace cg = cooperative_groups;
namespace pg8 {
#define PG8_LAS __attribute__((address_space(3)))
typedef unsigned short bf16_t;
typedef short bf16x8 __attribute__((ext_vector_type(8)));
typedef float f32x4 __attribute__((ext_vector_type(4)));
typedef unsigned u32x4 __attribute__((ext_vector_type(4)));
constexpr int BM = 256, BK = 64, HALF = 128, HTB = HALF * BK * 2  , STAGE_BYTES = 8 * HTB, NXCD = 8, WGM = 8;

__host__ __device__ __forceinline__ int lds_byte(int r, int c) { const int st = (r >> 4) * 2 + (c >> 5), rr = r & 15, cc = c & 31, ob = rr * 64 + cc * 2; return st * 1024 + (ob ^ (((ob >> 9) & 1) << 5)); }
__host__ __device__ __forceinline__ void stage_rc(int b, int& R, int& C) { const int st = b / 1024, sb = b % 1024, swz = sb ^ (((sb >> 9) & 1) << 5); R = (st >> 1) * 16 + swz / 64; C = (st & 1) * 32 + (swz % 64) / 2; }
__host__ __device__ __forceinline__ int perm32(int rho) { const int n = rho >> 4, i = rho & 15; return 8 * (i >> 2) + 4 * n + (i & 3); }

struct Unit { int pm, pn; };
struct Gemm { const bf16_t* A; const bf16_t* Bt; int M, N, K; };
struct StaticOrder {
    int nM, nN, nwg, G, c;
    __host__ __device__ void init(int M, int N, int G_, int c_) { nM = M / BM; nN = N / BM; nwg = nM * nN; G = G_; c = c_; }
    __host__ __device__ bool next(int i, Unit& u) const {
        const long L = (long)i * G + c; if (L >= nwg) return false;
        int wgid = (int)L; { const int q = nwg / NXCD, r = nwg % NXCD, xcd = wgid % NXCD, off = wgid / NXCD; wgid = (xcd < r ? xcd * (q + 1) : r * (q + 1) + (xcd - r) * q) + off; }
        const int nig = WGM * nN, gid = wgid / nig, fm = gid * WGM, gsz = (nM - fm) < WGM ? (nM - fm) : WGM;
        u.pm = fm + ((wgid % nig) % gsz); u.pn = (wgid % nig) / gsz; return true;
    }
    __device__ __forceinline__ void a_ready(const Unit&) const {}
    __device__ __forceinline__ void done(const Unit&) const {}
};
__device__ __forceinline__ unsigned cvt_pk_bf16(float lo, float hi) { unsigned r; asm volatile("v_cvt_pk_bf16_f32 %0, %1, %2" : "=v"(r) : "v"(lo), "v"(hi)); return r; }
template <class Epi, class Sched, int AMAP = 0, bool STAMP = false>
__device__ __forceinline__ void gemm_phase(PG8_LAS unsigned char* lds, const Gemm g, const Sched& S, const Epi& E, unsigned long long* stamps) {
    int tid_o = threadIdx.x; asm volatile("" : "+v"(tid_o)); const int tid = tid_o, wid = __builtin_amdgcn_readfirstlane(tid >> 6), lane = tid & 63, wr = wid >> 2, wc = wid & 3, fr = lane & 15, fq = lane >> 4;
    const int K = g.K, nt = K / BK;
    int ts_lo = 0, ts_hi = 0, nts = 0; const unsigned long long rt_entry = STAMP ? (unsigned long long)0ull : 0ull;
#define PG8_STAMP() do { if (STAMP && wid == 0 && nts < 64) { const unsigned long long _c = (unsigned long long)0ull; \
        ts_lo = (lane == nts) ? (int)(unsigned)_c : ts_lo; ts_hi = (lane == nts) ? (int)(unsigned)(_c >> 32) : ts_hi; ++nts; } } while (0)
    PG8_STAMP();
    unsigned voffA[2], voffB[2];
#pragma unroll
    for (int i = 0; i < 2; ++i) { int R, C; stage_rc(tid * 16 + i * 8192, R, C); const int Rb = Epi::PERM ? ((R & ~31) + perm32(R & 31)) : R;
        const int Ra = AMAP ? ((R >> 6) * 62 + (R & 63)) : R; voffA[i] = (unsigned)(Ra * K + C) * 2u; voffB[i] = (unsigned)(Rb * K + C) * 2u; }
    const size_t kstep = (size_t)(BK * 2);
    const size_t hstep = (size_t)HALF * K * 2;
    const size_t tstep = 2 * hstep; const size_t hstepA = AMAP ? (size_t)124 * K * 2 : hstep; const size_t tstepA = 2 * hstepA;
    const unsigned ldsw = (unsigned)wid * 1024u;
    const int aoff = lds_byte(wr * 64 + fr, fq * 8), boff = lds_byte(wc * 32 + fr, fq * 8);
#define PG8_SA(b, h) (((b) * 2 + (h)) * HTB)
#define PG8_SB(b, h) ((4 + (b) * 2 + (h)) * HTB)
#define PG8_STAGE(bufoff, gbase, voff) do { _Pragma("unroll") for (int _i = 0; _i < 2; ++_i) \
        __builtin_amdgcn_global_load_lds((const unsigned*)((const char*)(gbase) + (voff)[_i]), (PG8_LAS unsigned*)(lds + (bufoff) + ldsw + _i * 8192), 16, 0, 0); } while (0)
#define PG8_LDA(dst, b, h) do { _Pragma("unroll") for (int m = 0; m < 4; ++m) _Pragma("unroll") for (int k = 0; k < 2; ++k) dst[m][k] = *(const PG8_LAS bf16x8*)(lds + PG8_SA(b, h) + aoff + m * 2048 + k * 1024); } while (0)
#define PG8_LDB(dst, b, h) do { _Pragma("unroll") for (int n = 0; n < 2; ++n) _Pragma("unroll") for (int k = 0; k < 2; ++k) dst[n][k] = *(const PG8_LAS bf16x8*)(lds + PG8_SB(b, h) + boff + n * 2048 + k * 1024); } while (0)
#define PG8_MMA(ai, bj, At, Bt) do { __builtin_amdgcn_s_setprio(1); _Pragma("unroll") for (int m = 0; m < 4; ++m) _Pragma("unroll") for (int n = 0; n < 2; ++n) _Pragma("unroll") for (int k = 0; k < 2; ++k) \
        acc[ai][bj][m][n] = __builtin_amdgcn_mfma_f32_16x16x32_bf16(Bt[n][k], At[m][k], acc[ai][bj][m][n], 0, 0, 0); __builtin_amdgcn_s_setprio(0); } while (0)
#define PG8_WAIT_V(n) asm volatile("s_waitcnt vmcnt(" #n ")" ::: "memory")
#define PG8_WAIT_L(n) asm volatile("s_waitcnt lgkmcnt(" #n ")" ::: "memory")
#define PG8_BAR __builtin_amdgcn_s_barrier()
#define PG8_SCHED __builtin_amdgcn_sched_barrier(0)
    Unit cur, nxt; int ui = 0;
    if (!S.next(0, cur)) return;
    f32x4 acc[2][2][4][2];
#pragma unroll
    for (int a = 0; a < 2; ++a)
#pragma unroll
        for (int b = 0; b < 2; ++b)
#pragma unroll
            for (int m = 0; m < 4; ++m)
#pragma unroll
                for (int n = 0; n < 2; ++n) acc[a][b][m][n] = (f32x4){0.f, 0.f, 0.f, 0.f};
    bf16x8 At[4][2], B0[2][2], B1[2][2];
    const char* cA = (const char*)g.A + (size_t)cur.pm * tstepA; const char* cB = (const char*)g.Bt + (size_t)cur.pn * tstep;
    S.a_ready(cur);
    PG8_STAGE(PG8_SB(0, 0), cB, voffB); PG8_STAGE(PG8_SA(0, 0), cA, voffA); PG8_STAGE(PG8_SB(0, 1), cB + hstep, voffB); PG8_STAGE(PG8_SA(0, 1), cA + hstepA, voffA);
    if (wr == 1) PG8_BAR;
    PG8_WAIT_V(4); PG8_BAR;
    PG8_STAGE(PG8_SB(1, 0), cB + kstep, voffB); PG8_STAGE(PG8_SA(1, 0), cA + kstep, voffA); PG8_STAGE(PG8_SB(1, 1), cB + hstep + kstep, voffB);
    PG8_WAIT_V(6); PG8_BAR;
    PG8_STAMP();
    for (;;) {
        const bool has_next = S.next(ui + 1, nxt);
        const char* nA = has_next ? (const char*)g.A + (size_t)nxt.pm * tstepA : cA; const char* nB = has_next ? (const char*)g.Bt + (size_t)nxt.pn * tstep : cB;
        for (int t = 0; t < nt; t += 2) {
            const bool last = (t == nt - 2);
            const char* a1 = cA + (size_t)(t + 1) * kstep;
            const char* a2 = last ? nA : cA + (size_t)(t + 2) * kstep; const char* b2 = last ? nB : cB + (size_t)(t + 2) * kstep;
            const char* a3 = a2 + kstep; const char* b3 = b2 + kstep;
            if (last && has_next) S.a_ready(nxt);
            PG8_LDB(B0, 0, 0); PG8_SCHED; PG8_LDA(At, 0, 0); PG8_STAGE(PG8_SA(1, 1), a1 + hstepA, voffA);
            PG8_WAIT_L(8); PG8_BAR; PG8_WAIT_L(0); PG8_MMA(0, 0, At, B0); PG8_BAR; PG8_SCHED;
            PG8_LDB(B1, 0, 1); PG8_STAGE(PG8_SB(0, 0), b2, voffB);
            PG8_BAR; PG8_WAIT_L(0); PG8_MMA(0, 1, At, B1); PG8_BAR;
            PG8_LDA(At, 0, 1); PG8_STAGE(PG8_SA(0, 0), a2, voffA);
            PG8_BAR; PG8_WAIT_L(0); PG8_MMA(1, 0, At, B0); PG8_BAR; PG8_SCHED;
            PG8_STAGE(PG8_SB(0, 1), b2 + hstep, voffB);
            PG8_WAIT_V(6); PG8_BAR; PG8_MMA(1, 1, At, B1); PG8_BAR;
            PG8_LDB(B0, 1, 0); PG8_SCHED; PG8_LDA(At, 1, 0); PG8_STAGE(PG8_SA(0, 1), a2 + hstepA, voffA);
            PG8_WAIT_L(8); PG8_BAR; PG8_WAIT_L(0); PG8_MMA(0, 0, At, B0); PG8_BAR; PG8_SCHED;
            PG8_LDB(B1, 1, 1); PG8_STAGE(PG8_SB(1, 0), b3, voffB);
            PG8_BAR; PG8_WAIT_L(0); PG8_MMA(0, 1, At, B1); PG8_BAR;
            PG8_LDA(At, 1, 1); PG8_STAGE(PG8_SA(1, 0), a3, voffA);
            PG8_BAR; PG8_WAIT_L(0); PG8_MMA(1, 0, At, B0); PG8_BAR; PG8_SCHED;
            PG8_STAGE(PG8_SB(1, 1), b3 + hstep, voffB);
            PG8_WAIT_V(6); PG8_BAR; PG8_MMA(1, 1, At, B1); PG8_BAR;
        }
        PG8_STAMP();
        if constexpr (!Epi::AFTER_DRAIN) { E(acc, cur, wr, wc, fr, fq); S.done(cur); }
        PG8_STAMP();
        if (!has_next) break;
#pragma unroll
        for (int a = 0; a < 2; ++a)
#pragma unroll
            for (int b = 0; b < 2; ++b)
#pragma unroll
                for (int m = 0; m < 4; ++m)
#pragma unroll
                    for (int n = 0; n < 2; ++n) acc[a][b][m][n] = (f32x4){0.f, 0.f, 0.f, 0.f};
        cur = nxt; cA = nA; cB = nB; ++ui;
    }
    PG8_WAIT_V(0);
    if (wr == 0) PG8_BAR;
    PG8_BAR;
    if constexpr (Epi::AFTER_DRAIN) { E.fused(acc, cur, wr, wc, fr, fq, lds, wid, lane); S.done(cur); }
    PG8_STAMP();
    if (STAMP && wid == 0) { stamps[lane] = lane < nts ? (((unsigned long long)(unsigned)ts_hi << 32) | (unsigned)ts_lo) : 0ull;
        if (lane == 62) stamps[62] = rt_entry; if (lane == 63) stamps[63] = (unsigned long long)0ull; }
#undef PG8_STAMP
#undef PG8_SA
#undef PG8_SB
#undef PG8_STAGE
#undef PG8_LDA
#undef PG8_LDB
#undef PG8_MMA
#undef PG8_WAIT_V
#undef PG8_WAIT_L
#undef PG8_BAR
#undef PG8_SCHED
}
}
namespace mk {
#ifndef SCHB
#define SCHB __builtin_amdgcn_sched_barrier(0)
#endif
using pg8::Unit; using pg8::Gemm; using pg8::StaticOrder; using pg8::cvt_pk_bf16;
#define LAS __attribute__((address_space(3)))
typedef unsigned short bf16;
typedef float f32x4 __attribute__((ext_vector_type(4)));
typedef short bf16x8 __attribute__((ext_vector_type(8)));
typedef unsigned u32x2 __attribute__((ext_vector_type(2)));
typedef unsigned u32x4 __attribute__((ext_vector_type(4)));

constexpr int D = 1024, SEQ = 16384, TP = 32768, TS = 256, MT = 33024, DEPTH = 4, INC = 3328, FF = 2816, FF2 = 5632, NADA = 6144;
constexpr int HSEQ = 16386, HS_SAMPLE = 33280, H_ROWS = 33536, UP_TILES = 133;
constexpr int NWG = 256, NTHR = 512;
constexpr int LDS_BYTES = 135168;
constexpr size_t O_Y = 0, O_YS = 33554432, O_KP = 33816576, O_VP = 33947648, O_SRP = 34078720, O_SIP = 34095104, O_CP = 34111488,
                 O_KS = 34201600, O_VS = 34332672, O_SRS = 34463744, O_SIS = 34594816, O_CS = 34725888, O_END = 35446784;
constexpr size_t W_L = 29360128, W_IN = 0, W_GLU = 6815744, W_O = 8912896, W_OUT = 9961472, W_UP = 12058624, W_DN = 23592960;
constexpr size_t WS_W = 0, WS_MOD = 117440512, WS_ROPE = 119209984, WS_CH = 120258560, WS_H = 128647168, WS_O = WS_H, WS_YG = WS_H + 33816576,
                 WS_U = 197328896, WS_Q = 264962048, WS_K = 298778624, WS_V = 307232768, WS_G = 315686912, WS_P = 450953216, WS_END = 518586368, WS_ACT = WS_U;

struct Params { const float* in[31]; float* out; unsigned char* ws; };
enum { I_XP = 0, I_XS, I_CK, I_CV, I_SRE, I_SIM, I_SCONV, I_CP, I_CS, I_ADAW, I_ADAB, I_N1G, I_N2G, I_WIN, I_ARE, I_AIM, I_LDT, I_BRE, I_BIM, I_CRE, I_CIM, I_SD,
       I_WGLU, I_SINK, I_WO, I_WOUT, I_WUP, I_CW, I_CB, I_WDN, I_FG };

__device__ __forceinline__ float bf2f(unsigned h) { return __uint_as_float(h << 16); }
__device__ __forceinline__ unsigned f2bf(float f) { unsigned u = __float_as_uint(f); return (u + 0x7fffu + ((u >> 16) & 1u)) >> 16; }
__device__ __forceinline__ float sigm(float x) { return 1.0f / (1.0f + __expf(-x)); }
__device__ __forceinline__ float gelu_tanh(float x) { const float z = 1.5957691216f * (x + 0.044715f * x * x * x); return x / (1.0f + __expf(-z)); }
__device__ __forceinline__ f32x4 ld_bf4(const bf16* p) { const u32x2 v = *(const u32x2*)p; return (f32x4){__uint_as_float(v.x << 16), __uint_as_float(v.x & 0xffff0000u), __uint_as_float(v.y << 16), __uint_as_float(v.y & 0xffff0000u)}; }
__device__ __forceinline__ void st_bf4(bf16* p, f32x4 v) { u32x2 o; o.x = cvt_pk_bf16(v.x, v.y); o.y = cvt_pk_bf16(v.z, v.w); *(u32x2*)p = o; }
__device__ __forceinline__ int modrow_of(int row) { return row < TP ? (row >> 14) : 2 + ((row - TP) >> 4); }
__device__ __forceinline__ int pos_of(int row) { return row < TP ? (row & (SEQ - 1)) : 2048 + ((row - TP) & 15); }
__device__ __forceinline__ float wave_sum(float v) {
#pragma unroll
    for (int o = 1; o < 64; o <<= 1) v += __shfl_xor(v, o);
    return v;
}
template <int CTRL> __device__ __forceinline__ float dpp_mov(float old, float src) {
    return __builtin_bit_cast(float, __builtin_amdgcn_update_dpp(__builtin_bit_cast(int, old), __builtin_bit_cast(int, src), CTRL, 0xf, 0xf, false));
}
__device__ __forceinline__ f32x4 row_prev1(f32x4 cur, f32x4 pm) { f32x4 r;
#pragma unroll
    for (int e = 0; e < 4; ++e) r[e] = dpp_mov<0x111>(dpp_mov<0x121>(0.f, pm[e]), cur[e]);
    return r; }
__device__ __forceinline__ f32x4 row_prev2(f32x4 cur, f32x4 pm) { f32x4 r;
#pragma unroll
    for (int e = 0; e < 4; ++e) r[e] = dpp_mov<0x112>(dpp_mov<0x122>(0.f, pm[e]), cur[e]);
    return r; }

struct EpiWin {
    static constexpr bool PERM = false, AFTER_DRAIN = false;
    float* U; bf16* Q; bf16* Kb; bf16* Vb; bf16* G; const float* rope; float* out; int layer;
    __device__ __forceinline__ f32x4 rot(f32x4 v, int pos, int fq) const {
        const float* rp = rope + (unsigned)(pos * 16 + 4 * (fq & 1));
        const f32x4 cs = *(const f32x4*)rp, sn = *(const f32x4*)(rp + 8);
        f32x4 o, r;
#pragma unroll
        for (int e = 0; e < 4; ++e) o[e] = __shfl_xor(v[e], 32);
        if (fq < 2) r = v * cs - o * sn; else r = v * cs + o * sn;
        return r;
    }
    __device__ __forceinline__ void operator()(const f32x4 (&acc)[2][2][4][2], const Unit& u, int wr, int wc, int fr, int fq) const {
        const int pn = u.pn;
#pragma unroll
        for (int ai = 0; ai < 2; ++ai)
#pragma unroll
            for (int m = 0; m < 4; ++m) {
                const int row = u.pm * 256 + ai * 128 + wr * 64 + m * 16 + fr;
                const int pos = pos_of(row);
                if (pn < 2) {
#pragma unroll
                    for (int bj = 0; bj < 2; ++bj)
#pragma unroll
                        for (int n = 0; n < 2; ++n) *(f32x4*)(U + (unsigned)(row * 512 + pn * 256 + bj * 128 + wc * 32 + n * 16 + 4 * fq)) = acc[ai][bj][m][n];
                } else if (pn < 4) {
#pragma unroll
                    for (int bj = 0; bj < 2; ++bj)
#pragma unroll
                        for (int n = 0; n < 2; ++n) {
                            f32x4 v = acc[ai][bj][m][n] * 0.125f;
                            if (n == 0 && (wc & 1) == 0) v = rot(v, pos, fq);
                            st_bf4(Q + (unsigned)(row * 512 + (pn - 2) * 256 + bj * 128 + wc * 32 + n * 16 + 4 * fq), v);
                        }
                } else if (pn == 4) {
#pragma unroll
                    for (int bj = 0; bj < 2; ++bj)
#pragma unroll
                        for (int n = 0; n < 2; ++n) {
                            f32x4 v = acc[ai][bj][m][n];
                            const int c = wc * 32 + n * 16 + 4 * fq;
                            if (bj == 0 && n == 0 && (wc & 1) == 0) v = rot(v, pos, fq);
                            st_bf4((bj == 0 ? Kb : Vb) + (unsigned)(row * 128 + c), v);
                            if (row >= TP) *(f32x4*)(out + (bj == 0 ? O_KS : O_VS) + (unsigned)((layer * 256 + (row - TP)) * 128 + c)) = v;
                            else if (pos >= SEQ - 128) *(f32x4*)(out + (bj == 0 ? O_KP : O_VP) + (unsigned)(((layer * 2 + (row >> 14)) * 128 + (pos - (SEQ - 128))) * 128 + c)) = v;
                        }
                } else {
#pragma unroll
                    for (int bj = 0; bj < 2; ++bj)
#pragma unroll
                        for (int n = 0; n < 2; ++n) {
                            const f32x4 a = acc[ai][bj][m][n]; f32x4 v;
#pragma unroll
                            for (int e = 0; e < 4; ++e) v[e] = sigm(a[e]);
                            st_bf4(G + (unsigned)(row * 2048 + (pn - 5) * 256 + bj * 128 + wc * 32 + n * 16 + 4 * fq), v);
                        }
                }
            }
    }
};
struct EpiAttnO {
    static constexpr bool PERM = false, AFTER_DRAIN = false;
    const bf16* G; bf16* P;
    __device__ __forceinline__ void operator()(const f32x4 (&acc)[2][2][4][2], const Unit& u, int wr, int wc, int fr, int fq) const {
#pragma unroll
        for (int ai = 0; ai < 2; ++ai)
#pragma unroll
            for (int m = 0; m < 4; ++m) {
                const int row = u.pm * 256 + ai * 128 + wr * 64 + m * 16 + fr;
#pragma unroll
                for (int bj = 0; bj < 2; ++bj)
#pragma unroll
                    for (int n = 0; n < 2; ++n) {
                        const int col = u.pn * 256 + bj * 128 + wc * 32 + n * 16 + 4 * fq;
                        const f32x4 gb = ld_bf4(G + (unsigned)(row * 2048 + 1024 + col));
                        st_bf4(P + (unsigned)(row * 1024 + col), gb * acc[ai][bj][m][n]);
                    }
            }
    }
};
struct EpiGlu {
    static constexpr bool PERM = false, AFTER_DRAIN = false;
    const bf16* G; bf16* P;
    __device__ __forceinline__ void operator()(const f32x4 (&acc)[2][2][4][2], const Unit& u, int wr, int wc, int fr, int fq) const {
#pragma unroll
        for (int ai = 0; ai < 2; ++ai)
#pragma unroll
            for (int m = 0; m < 4; ++m) {
                const int row = u.pm * 256 + ai * 128 + wr * 64 + m * 16 + fr;
#pragma unroll
                for (int bj = 0; bj < 2; ++bj) {
                    const int j = 16 * (8 * u.pn + 4 * bj + wc) + 4 * fq;
                    const f32x4 a = acc[ai][bj][m][0], b = acc[ai][bj][m][1];
                    const f32x4 ga = ld_bf4(G + (unsigned)(row * 2048 + j)), pb = ld_bf4(P + (unsigned)(row * 1024 + j));
                    f32x4 v;
#pragma unroll
                    for (int e = 0; e < 4; ++e) v[e] = ga[e] * a[e] * sigm(b[e]) + pb[e];
                    st_bf4(P + (unsigned)(row * 1024 + j), v);
                }
            }
    }
};
struct EpiRes {
    static constexpr bool PERM = false, AFTER_DRAIN = false;
    const float* xp; const float* xs; float* X; const float* gvec;
    __device__ __forceinline__ void operator()(const f32x4 (&acc)[2][2][4][2], const Unit& u, int wr, int wc, int fr, int fq) const {
#pragma unroll
        for (int ai = 0; ai < 2; ++ai)
#pragma unroll
            for (int m = 0; m < 4; ++m) {
                const int row = u.pm * 256 + ai * 128 + wr * 64 + m * 16 + fr;
                const float* xb = u.pm < 128 ? xp : xs - (size_t)TP * D;
                const unsigned go = (unsigned)(modrow_of(row) * NADA);
#pragma unroll
                for (int bj = 0; bj < 2; ++bj)
#pragma unroll
                    for (int n = 0; n < 2; ++n) {
                        const int col = u.pn * 256 + bj * 128 + wc * 32 + n * 16 + 4 * fq;
                        *(f32x4*)(X + (unsigned)(row * D + col)) = *(const f32x4*)(xb + (unsigned)(row * D + col)) + *(const f32x4*)(gvec + (go + col)) * acc[ai][bj][m][n];
                    }
            }
    }
};
template <bool SAMPLE> struct EpiUp {
    static constexpr bool PERM = false, AFTER_DRAIN = false;
    bf16* ACT; const float* cw; const float* cb; const float* sconv; float* out; int layer;
    __device__ __forceinline__ void operator()(const f32x4 (&acc)[2][2][4][2], const Unit& u, int wr, int wc, int fr, int fq) const {
        const f32x4 z = (f32x4){0.f, 0.f, 0.f, 0.f};
#pragma unroll
        for (int bj = 0; bj < 2; ++bj) {
            const int jf = 16 * (8 * u.pn + 4 * bj + wc) + 4 * fq;
            const f32x4 wv0 = *(const f32x4*)(cw + jf), wv1 = *(const f32x4*)(cw + FF2 + jf), wv2 = *(const f32x4*)(cw + 2 * FF2 + jf), bv = *(const f32x4*)(cb + jf);
            const f32x4 wg0 = *(const f32x4*)(cw + FF + jf), wg1 = *(const f32x4*)(cw + FF2 + FF + jf), wg2 = *(const f32x4*)(cw + 2 * FF2 + FF + jf), bg = *(const f32x4*)(cb + FF + jf);
#pragma unroll
            for (int ai = 0; ai < 2; ++ai)
#pragma unroll
                for (int m = 0; m < 4; ++m) {
                    const f32x4 cv = acc[ai][bj][m][0], cg = acc[ai][bj][m][1];
                    const f32x4 pv = m > 0 ? acc[ai][bj][m > 0 ? m - 1 : 0][0] : z, pg = m > 0 ? acc[ai][bj][m > 0 ? m - 1 : 0][1] : z;
                    f32x4 val = bv + wv2 * cv, gat = bg + wg2 * cg;
                    bool valid; unsigned aoff;
                    if (SAMPLE) {
                        const int s = 8 * ai + 4 * wr + m, t = fr;
                        f32x4 p1v = row_prev1(cv, z), p2v = row_prev2(cv, z), p1g = row_prev1(cg, z), p2g = row_prev2(cg, z);
                        if (t < 2) {
                            const float* st = sconv + (unsigned)(s * 2 * FF2 + jf);
                            const f32x4 s1v = *(const f32x4*)(st + FF2), s1g = *(const f32x4*)(st + FF2 + FF);
                            if (t == 0) { p1v = s1v; p1g = s1g; p2v = *(const f32x4*)st; p2g = *(const f32x4*)(st + FF); }
                            else { p2v = s1v; p2g = s1g; }
                        }
                        val += wv0 * p2v + wv1 * p1v; gat += wg0 * p2g + wg1 * p1g;
                        valid = true; aoff = (unsigned)(TP + 16 * s + t) * FF + jf;
                        if (t >= 14) { float* o = out + O_CS + (unsigned)(((layer * 16 + s) * 2 + (t - 14)) * FF2 + jf); *(f32x4*)o = cv; *(f32x4*)(o + FF) = cg; }
                    } else {
                        val += wv0 * row_prev2(cv, pv) + wv1 * row_prev1(cv, pv);
                        gat += wg0 * row_prev2(cg, pg) + wg1 * row_prev1(cg, pg);
                        const int j = 16 * m + fr, hs = 248 * u.pm + 62 * (2 * ai + wr) + j;
                        const int b = hs >= HSEQ ? 1 : 0, pos = hs - b * HSEQ - 2;
                        valid = (j >= 2) && (pos >= 0) && (hs < 2 * HSEQ);
                        aoff = (unsigned)(b * SEQ + pos) * FF + jf;
                        if (valid && pos >= SEQ - 2) { float* o = out + O_CP + (unsigned)(((layer * 2 + b) * 2 + (pos - (SEQ - 2))) * FF2 + jf); *(f32x4*)o = cv; *(f32x4*)(o + FF) = cg; }
                    }
                    if (valid) {
                        f32x4 a;
#pragma unroll
                        for (int e = 0; e < 4; ++e) a[e] = gat[e] * sigm(gat[e]) * val[e];
                        st_bf4(ACT + aoff, a);
                    }
                    SCHB;
                }
        }
    }
};

__device__ __forceinline__ int dstrow(int mode, int half, int n) { if (mode == 0) return n; const int j = n < half ? n : n - half; return 32 * (j >> 4) + (j & 15) + (n < half ? 0 : 16); }
__device__ __forceinline__ void transpose_item(const float* W, int K, int N, bf16* WT, int mode, int half, LAS float* scr, int item, int lane) {
    const int nblk = N / 32, kb = item / nblk, nb = item % nblk, k0 = 64 * kb, n0 = 32 * nb;
#pragma unroll 8
    for (int i = 0; i < 32; ++i) { const int kk = 2 * i + (lane >> 5); scr[kk * 33 + (lane & 31)] = W[(size_t)(k0 + kk) * N + n0 + (lane & 31)]; }
    asm volatile("s_waitcnt lgkmcnt(0)" ::: "memory");
    const int c = lane & 7;
#pragma unroll
    for (int j = 0; j < 4; ++j) { const int n = (lane >> 3) + 8 * j; const LAS float* s = scr + (8 * c) * 33 + n;
        u32x4 o; o.x = cvt_pk_bf16(s[0 * 33], s[1 * 33]); o.y = cvt_pk_bf16(s[2 * 33], s[3 * 33]); o.z = cvt_pk_bf16(s[4 * 33], s[5 * 33]); o.w = cvt_pk_bf16(s[6 * 33], s[7 * 33]);
        *(u32x4*)(WT + (size_t)dstrow(mode, half, n0 + n) * K + k0 + 8 * c) = o; }
    asm volatile("s_waitcnt lgkmcnt(0)" ::: "memory");
}
__device__ __forceinline__ void dsincos(double x, double& s, double& c) {
    const double k = rint(x * 0.15915494309189535);
    const double r = (x - k * 6.283185307179586) - k * 2.4492935982947064e-16;
    const double r2 = r * r;
    double ts = 1.0, tc = 1.0, ss = 1.0, cc = 1.0;
#pragma unroll
    for (int i = 1; i <= 13; ++i) { tc = -tc * r2 / (double)((2 * i - 1) * (2 * i)); cc += tc; ts = -ts * r2 / (double)((2 * i) * (2 * i + 1)); ss += ts; }
    s = ss * r; c = cc;
}
__device__ void p0_prologue(const Params& p, LAS unsigned char* lds, int bid, int tid) {
    asm volatile("" : "+v"(tid));
    const int lane = tid & 63, wave = tid >> 6;
    float* mod = (float*)(p.ws + WS_MOD);
    if (bid < 192) {
        LAS float* sc = (LAS float*)lds;
        LAS float* part = (LAS float*)(lds + 81920);
        for (int idx = tid; idx < 18 * 1024; idx += NTHR) { const int bb = idx >> 10, d = idx & 1023;
            const float c = bb < 2 ? p.in[I_CP][bb * 1024 + d] : p.in[I_CS][(bb - 2) * 1024 + d]; sc[d * 20 + bb] = c / (1.0f + __expf(-c)); }
        __syncthreads();
        const int l = bid / 48, e0 = (bid % 48) * 128, col = tid & 127, dq = tid >> 7;
        float a[18];
#pragma unroll
        for (int i = 0; i < 18; ++i) a[i] = 0.f;
        const float* wp = p.in[I_ADAW] + ((size_t)l * 1024 + dq * 256) * NADA + e0 + col;
#pragma unroll 4
        for (int d = 0; d < 256; ++d) {
            const float w = wp[(size_t)d * NADA];
            const LAS f32x4* s4 = (const LAS f32x4*)(sc + (dq * 256 + d) * 20);
            const f32x4 s0 = s4[0], s1 = s4[1], s2 = s4[2], s3 = s4[3], s5 = s4[4];
            a[0] += w * s0.x; a[1] += w * s0.y; a[2] += w * s0.z; a[3] += w * s0.w; a[4] += w * s1.x; a[5] += w * s1.y; a[6] += w * s1.z; a[7] += w * s1.w;
            a[8] += w * s2.x; a[9] += w * s2.y; a[10] += w * s2.z; a[11] += w * s2.w; a[12] += w * s3.x; a[13] += w * s3.y; a[14] += w * s3.z; a[15] += w * s3.w;
            a[16] += w * s5.x; a[17] += w * s5.y;
        }
#pragma unroll
        for (int i = 0; i < 18; ++i) part[(dq * 128 + col) * 18 + i] = a[i];
        __syncthreads();
        for (int idx = tid; idx < 128 * 18; idx += NTHR) { const int c2 = idx & 127, bb = idx >> 7;
            const float v = part[(0 * 128 + c2) * 18 + bb] + part[(1 * 128 + c2) * 18 + bb] + part[(2 * 128 + c2) * 18 + bb] + part[(3 * 128 + c2) * 18 + bb] + p.in[I_ADAB][l * NADA + e0 + c2];
            mod[((size_t)l * 18 + bb) * NADA + e0 + c2] = v; }
        __syncthreads();
    }
    {
        float* rope = (float*)(p.ws + WS_ROPE);
        for (int idx = bid * NTHR + tid; idx < SEQ * 8; idx += NWG * NTHR) { const int pos = idx >> 3, i = idx & 7;
            const double f = i == 0 ? 1.0 : i == 1 ? 0.19392274474868576 : i == 2 ? 0.03760603093086393 : i == 3 ? 0.007292664737217109 : i == 4 ? 0.001414213562373095 : i == 5 ? 0.0002742481756762073 : i == 6 ? 5.318295896944988e-05 : 1.031338537721246e-05;
            double s, c; dsincos((double)pos * f, s, c); rope[pos * 16 + i] = (float)c; rope[pos * 16 + 8 + i] = (float)s; }
    }
    {
        LAS float* scr = (LAS float*)(lds + wave * 8704);
        constexpr int I_1 = 16 * 104, I_2 = 8 * 64, I_3 = 8 * 32, I_4 = 16 * 32, I_5 = 16 * 176, I_6 = 44 * 32, I_L = I_1 + I_2 + I_3 + I_4 + I_5 + I_6;
        const int gw = bid * 8 + wave;
        for (int it = gw; it < DEPTH * I_L; it += NWG * 8) {
            const int l = it / I_L; int r = it % I_L; unsigned char* wl = p.ws + WS_W + (size_t)l * W_L;
            if (r < I_1) { transpose_item(p.in[I_WIN] + (size_t)l * D * INC, D, INC, (bf16*)(wl + W_IN), 0, 0, scr, r, lane); continue; } r -= I_1;
            if (r < I_2) { transpose_item(p.in[I_WGLU] + (size_t)l * 512 * 2048, 512, 2048, (bf16*)(wl + W_GLU), 1, 1024, scr, r, lane); continue; } r -= I_2;
            if (r < I_3) { transpose_item(p.in[I_WO] + (size_t)l * 512 * 1024, 512, 1024, (bf16*)(wl + W_O), 0, 0, scr, r, lane); continue; } r -= I_3;
            if (r < I_4) { transpose_item(p.in[I_WOUT] + (size_t)l * D * D, D, D, (bf16*)(wl + W_OUT), 0, 0, scr, r, lane); continue; } r -= I_4;
            if (r < I_5) { transpose_item(p.in[I_WUP] + (size_t)l * D * FF2, D, FF2, (bf16*)(wl + W_UP), 1, FF, scr, r, lane); continue; } r -= I_5;
            transpose_item(p.in[I_WDN] + (size_t)l * FF * D, FF, D, (bf16*)(wl + W_DN), 0, 0, scr, r, lane);
        }
    }
}

__device__ void norm_phase(const Params& p, int layer, int mode, int bid, int tid) {
    asm volatile("" : "+v"(tid));
    const int lane = tid & 63, wave = tid >> 6, gw = bid * 8 + wave;
    float* X = p.out; bf16* H = (bf16*)(p.ws + WS_H);
    const float* mod = (const float*)(p.ws + WS_MOD) + (size_t)layer * 18 * NADA;
    const float* gsrc = mode == 0 ? p.in[I_N1G] + layer * D : mode == 1 ? p.in[I_N2G] + layer * D : p.in[I_FG];
    f32x4 g[4];
#pragma unroll
    for (int j = 0; j < 4; ++j) g[j] = *(const f32x4*)(gsrc + 4 * lane + 256 * j);
    if (mode == 1 && gw < 4) { const int hs = (gw & 1) + (gw >> 1) * HSEQ; unsigned* o = (unsigned*)(H + (size_t)hs * D); unsigned zz = 0u; asm volatile("" : "+v"(zz));
#pragma unroll
        for (int j = 0; j < 8; ++j) o[lane + 64 * j] = zz; }
    for (int row = gw; row < MT; row += NWG * 8) {
        const float* xr = (mode == 0 && layer == 0) ? (row < TP ? p.in[I_XP] + (size_t)row * D : p.in[I_XS] + (size_t)(row - TP) * D) : X + (size_t)row * D;
        f32x4 v[4]; float s = 0.f;
#pragma unroll
        for (int j = 0; j < 4; ++j) { v[j] = *(const f32x4*)(xr + 4 * lane + 256 * j); s += (v[j].x * v[j].x + v[j].y * v[j].y) + (v[j].z * v[j].z + v[j].w * v[j].w); }
        const float rstd = 1.0f / sqrtf(wave_sum(s) * (1.0f / D) + 1e-6f);
        if (mode == 2) {
#pragma unroll
            for (int j = 0; j < 4; ++j) *(f32x4*)(X + (size_t)row * D + 4 * lane + 256 * j) = v[j] * rstd * g[j];
        } else {
            const float* mr = mod + (size_t)modrow_of(row) * NADA + (mode == 0 ? 0 : 3072);
            size_t hrow = row;
            if (mode == 1) hrow = row < TP ? (size_t)(row >> 14) * HSEQ + 2 + (row & (SEQ - 1)) : (size_t)HS_SAMPLE + (row - TP);
#pragma unroll
            for (int j = 0; j < 4; ++j) { const f32x4 sh = *(const f32x4*)(mr + 4 * lane + 256 * j), sc = *(const f32x4*)(mr + 1024 + 4 * lane + 256 * j);
                st_bf4(H + hrow * D + 4 * lane + 256 * j, (v[j] * rstd * g[j]) * (sc + 1.0f) + sh); }
        }
    }
}

struct SsmPar { float abr, abi; float bbr[16], bbi[16]; };
__device__ __forceinline__ void ssm_disc(const Params& p, int layer, int g, int lane, float& abr, float& abi, float& fr, float& fi) {
    const int gi = (layer * 32 + g) * 64 + lane;
    const float are = p.in[I_ARE][gi], aim = p.in[I_AIM][gi], dt = expf(p.in[I_LDT][layer * 32 + g]);
    const float mag = expf(are * dt); float sn, cs; sincosf(aim * dt, &sn, &cs);
    abr = mag * cs; abi = mag * sn;
    const float nr = abr - 1.0f, ni = abi, den = are * are + aim * aim;
    fr = (nr * are + ni * aim) / den; fi = (ni * are - nr * aim) / den;
}
__device__ void ssm_task(const Params& p, int layer, int mode, int sq, int g, int chunk, int lane, LAS unsigned char* wl) {
    LAS float* ul = (LAS float*)wl;
    LAS bf16* Sl = (LAS bf16*)(wl + 4096);
    float abr, abi, fr, fi; ssm_disc(p, layer, g, lane, abr, abi, fr, fi);
    float bbr[16], bbi[16];
    { const size_t bo = (((size_t)layer * 32 + g) * 64 + lane) * 16;
#pragma unroll
      for (int c4 = 0; c4 < 4; ++c4) { const f32x4 br = *(const f32x4*)(p.in[I_BRE] + bo + 4 * c4), bi = *(const f32x4*)(p.in[I_BIM] + bo + 4 * c4);
#pragma unroll
          for (int e = 0; e < 4; ++e) { bbr[4 * c4 + e] = fr * br[e] - fi * bi[e]; bbi[4 * c4 + e] = fr * bi[e] + fi * br[e]; } } }
    const bool cproj = mode != 0;
    const int g4 = lane >> 4, cl = lane & 15;
    bf16x8 cf[4];
    float dsk = 0.f;
    if (cproj) {
        const size_t co = (((size_t)layer * 32 + g) * 16 + cl) * 64;
#pragma unroll
        for (int ks = 0; ks < 4; ++ks) { const float* src = (ks < 2 ? p.in[I_CRE] : p.in[I_CIM]) + co + 32 * (ks & 1) + 8 * g4; const float sg = ks < 2 ? 1.0f : -1.0f;
            const f32x4 a = *(const f32x4*)src, b = *(const f32x4*)(src + 4);
            u32x4 o; o.x = cvt_pk_bf16(sg * a.x, sg * a.y); o.y = cvt_pk_bf16(sg * a.z, sg * a.w); o.z = cvt_pk_bf16(sg * b.x, sg * b.y); o.w = cvt_pk_bf16(sg * b.z, sg * b.w);
            cf[ks] = __builtin_bit_cast(bf16x8, o); }
        dsk = p.in[I_SD][layer * 512 + g * 16 + cl];
    }
    const int nsteps = mode == 1 ? 16 : 64;
    const size_t r0 = mode == 1 ? (size_t)TP + sq * 16 : (size_t)sq * SEQ + chunk * 64;
    const float* U = (const float*)(p.ws + WS_U);
#pragma unroll
    for (int i = 0; i < 4; ++i) { const int idx = lane + 64 * i; if (idx < nsteps * 4) { const int t = idx >> 2, c4 = idx & 3; *(LAS f32x4*)(ul + t * 16 + 4 * c4) = *(const f32x4*)(U + (r0 + t) * 512 + g * 16 + 4 * c4); } }
    float sr = 0.f, si = 0.f;
    float* CH = (float*)(p.ws + WS_CH);
    const size_t cho = (((size_t)(sq * 32 + g)) * 256 + chunk) * 128;
    if (mode == 1) { const size_t so = (((size_t)layer * 16 + sq) * 32 + g) * 64 + lane; sr = p.in[I_SRE][so]; si = p.in[I_SIM][so]; }
    else if (mode == 2) { sr = CH[cho + lane]; si = CH[cho + 64 + lane]; }
    asm volatile("s_waitcnt vmcnt(0) lgkmcnt(0)" ::: "memory"); __builtin_amdgcn_wave_barrier();
    bf16* Yg = (bf16*)(p.ws + WS_YG);
    for (int hh = 0; hh * 32 < nsteps; ++hh) {
        const int ns = nsteps - hh * 32 < 32 ? nsteps - hh * 32 : 32;
        for (int t = 0; t < ns; ++t) {
            const LAS f32x4* up = (const LAS f32x4*)(ul + (hh * 32 + t) * 16);
            const f32x4 u0 = up[0], u1 = up[1], u2 = up[2], u3 = up[3];
            float xr = 0.f, xi = 0.f;
#pragma unroll
            for (int e = 0; e < 4; ++e) { xr = fmaf(bbr[e], u0[e], xr); xi = fmaf(bbi[e], u0[e], xi); }
#pragma unroll
            for (int e = 0; e < 4; ++e) { xr = fmaf(bbr[4 + e], u1[e], xr); xi = fmaf(bbi[4 + e], u1[e], xi); }
#pragma unroll
            for (int e = 0; e < 4; ++e) { xr = fmaf(bbr[8 + e], u2[e], xr); xi = fmaf(bbi[8 + e], u2[e], xi); }
#pragma unroll
            for (int e = 0; e < 4; ++e) { xr = fmaf(bbr[12 + e], u3[e], xr); xi = fmaf(bbi[12 + e], u3[e], xi); }
            const float nsr = fmaf(abr, sr, fmaf(-abi, si, xr)), nsi = fmaf(abr, si, fmaf(abi, sr, xi));
            sr = nsr; si = nsi;
            if (cproj) { Sl[t * 136 + lane] = (bf16)f2bf(sr); Sl[t * 136 + 64 + lane] = (bf16)f2bf(si); }
        }
        if (cproj) {
            asm volatile("s_waitcnt lgkmcnt(0)" ::: "memory"); __builtin_amdgcn_wave_barrier();
#pragma unroll
            for (int mt = 0; mt < 2; ++mt) {
                f32x4 ya = (f32x4){0.f, 0.f, 0.f, 0.f};
#pragma unroll
                for (int ks = 0; ks < 4; ++ks) { const bf16x8 a = *(const LAS bf16x8*)(Sl + (16 * mt + cl) * 136 + 32 * ks + 8 * g4); ya = __builtin_amdgcn_mfma_f32_16x16x32_bf16(a, cf[ks], ya, 0, 0, 0); }
#pragma unroll
                for (int i = 0; i < 4; ++i) { const int t = 16 * mt + 4 * g4 + i;
                    if (t < ns) { const float y = ya[i] + dsk * ul[(hh * 32 + t) * 16 + cl]; Yg[(r0 + hh * 32 + t) * 512 + g * 16 + cl] = (bf16)f2bf(gelu_tanh(y)); } }
            }
            asm volatile("s_waitcnt lgkmcnt(0)" ::: "memory"); __builtin_amdgcn_wave_barrier();
        }
    }
    if (mode == 0) { CH[cho + lane] = sr; CH[cho + 64 + lane] = si; }
    else if (mode == 1) { const size_t so = (((size_t)layer * 16 + sq) * 32 + g) * 64 + lane; p.out[O_SRS + so] = sr; p.out[O_SIS + so] = si; }
    else if (chunk == 255) { const size_t so = (((size_t)layer * 2 + sq) * 32 + g) * 64 + lane; p.out[O_SRP + so] = sr; p.out[O_SIP + so] = si; }
    asm volatile("s_waitcnt lgkmcnt(0)" ::: "memory"); __builtin_amdgcn_wave_barrier();
}
__device__ void ssm_phase(const Params& p, int layer, int pass3, LAS unsigned char* lds, int bid, int tid) {
    asm volatile("" : "+v"(tid));
    const int lane = tid & 63, wave = tid >> 6; LAS unsigned char* wl = lds + wave * 12800;
    const int gw = bid * 8 + wave, ntask = pass3 ? 16384 : 16384 + 512;
    for (int tk = gw; tk < ntask; tk += NWG * 8) {
        if (tk < 16384) { const int chunk = tk & 255, sqg = tk >> 8; ssm_task(p, layer, pass3 ? 2 : 0, sqg >> 5, sqg & 31, chunk, lane, wl); }
        else { const int s = tk - 16384; ssm_task(p, layer, 1, s >> 5, s & 31, 0, lane, wl); }
    }
}
__device__ void carry_phase(const Params& p, int layer, int bid, int tid) {
    asm volatile("" : "+v"(tid));
    const int lane = tid & 63, wave = tid >> 6, gw = bid * 8 + wave;
    if (gw >= 64) return;
    float abr, abi, fr, fi; ssm_disc(p, layer, gw & 31, lane, abr, abi, fr, fi);
    float ar = abr, ai = abi;
#pragma unroll
    for (int i = 0; i < 6; ++i) { const float nr = ar * ar - ai * ai, ni = 2.0f * ar * ai; ar = nr; ai = ni; }
    float* CH = (float*)(p.ws + WS_CH) + (size_t)gw * 256 * 128;
    float cr = 0.f, ci = 0.f;
    for (int c0 = 0; c0 < 256; c0 += 8) {
        float fr8[8], fi8[8];
#pragma unroll
        for (int j = 0; j < 8; ++j) { fr8[j] = CH[(c0 + j) * 128 + lane]; fi8[j] = CH[(c0 + j) * 128 + 64 + lane]; }
#pragma unroll
        for (int j = 0; j < 8; ++j) { CH[(c0 + j) * 128 + lane] = cr; CH[(c0 + j) * 128 + 64 + lane] = ci;
            const float nr = fmaf(ar, cr, fmaf(-ai, ci, fr8[j])), ni = fmaf(ar, ci, fmaf(ai, cr, fi8[j])); cr = nr; ci = ni; }
    }
}

__device__ void attn_phase(const Params& p, int layer, LAS unsigned char* lds, int bid, int tid) {
    asm volatile("" : "+v"(tid));
    const int lane = tid & 63, wave = tid >> 6, g4 = lane >> 4, cl = lane & 15;
    LAS bf16* Kl = (LAS bf16*)lds;
    LAS bf16* Vt = (LAS bf16*)(lds + 27648);
    const bf16* Qb = (const bf16*)(p.ws + WS_Q); const bf16* Kb = (const bf16*)(p.ws + WS_K); const bf16* Vb = (const bf16*)(p.ws + WS_V);
    bf16* Ob = (bf16*)(p.ws + WS_O);
    for (int tk = bid; tk < 1024 + 32; tk += NWG) {
        const bool smp = tk >= 1024;
        const int b = smp ? (tk - 1024) >> 1 : tk >> 9, n = smp ? 0 : (tk >> 1) & 255, kvh = tk & 1;
        __syncthreads();
#pragma unroll
        for (int i = 0; i < 3; ++i) {
            const int idx = tid + NTHR * i, key = idx >> 3, c8 = idx & 7;
            u32x4 kv = (u32x4){0u, 0u, 0u, 0u}, vv = (u32x4){0u, 0u, 0u, 0u};
            if (!smp) {
                const int pos = 64 * (n - 2) + key;
                if (pos >= 0) { const size_t o = ((size_t)b * SEQ + pos) * 128 + kvh * 64 + 8 * c8; kv = *(const u32x4*)(Kb + o); vv = *(const u32x4*)(Vb + o); }
            } else if (key < 128) {
                const size_t o = ((((size_t)layer * 16 + b) * 128 + key) * 2 + kvh) * 64 + 8 * c8;
                const f32x4 k0 = *(const f32x4*)(p.in[I_CK] + o), k1 = *(const f32x4*)(p.in[I_CK] + o + 4), v0 = *(const f32x4*)(p.in[I_CV] + o), v1 = *(const f32x4*)(p.in[I_CV] + o + 4);
                kv.x = cvt_pk_bf16(k0.x, k0.y); kv.y = cvt_pk_bf16(k0.z, k0.w); kv.z = cvt_pk_bf16(k1.x, k1.y); kv.w = cvt_pk_bf16(k1.z, k1.w);
                vv.x = cvt_pk_bf16(v0.x, v0.y); vv.y = cvt_pk_bf16(v0.z, v0.w); vv.z = cvt_pk_bf16(v1.x, v1.y); vv.w = cvt_pk_bf16(v1.z, v1.w);
            } else if (key < 144) {
                const size_t o = ((size_t)TP + b * 16 + (key - 128)) * 128 + kvh * 64 + 8 * c8; kv = *(const u32x4*)(Kb + o); vv = *(const u32x4*)(Vb + o);
            }
            *(LAS u32x4*)(Kl + key * 72 + 8 * c8) = kv;
            LAS bf16* vd = Vt + (8 * c8) * 200 + key;
            vd[0] = (bf16)(vv.x & 0xffffu); vd[200] = (bf16)(vv.x >> 16); vd[400] = (bf16)(vv.y & 0xffffu); vd[600] = (bf16)(vv.y >> 16);
            vd[800] = (bf16)(vv.z & 0xffffu); vd[1000] = (bf16)(vv.z >> 16); vd[1200] = (bf16)(vv.w & 0xffffu); vd[1400] = (bf16)(vv.w >> 16);
        }
        __syncthreads();
        const int gh = wave & 3, qh = wave >> 2, h = kvh * 4 + gh;
        if (smp && qh == 1) continue;
        const int nq = smp ? 16 : 32;
        const size_t qrow0 = smp ? (size_t)TP + b * 16 : (size_t)b * SEQ + 64 * n + 32 * qh;
        bf16x8 qf[2][2];
#pragma unroll
        for (int nt = 0; nt < 2; ++nt) { int qi = 16 * nt + cl; if (qi >= nq) qi = nq - 1;
#pragma unroll
            for (int ks = 0; ks < 2; ++ks) qf[nt][ks] = *(const bf16x8*)(Qb + (qrow0 + qi) * 512 + h * 64 + 32 * ks + 8 * g4); }
        f32x4 s[12][2];
#pragma unroll
        for (int mt = 0; mt < 12; ++mt) {
            s[mt][0] = (f32x4){0.f, 0.f, 0.f, 0.f}; s[mt][1] = (f32x4){0.f, 0.f, 0.f, 0.f};
#pragma unroll
            for (int ks = 0; ks < 2; ++ks) { const bf16x8 a = *(const LAS bf16x8*)(Kl + (16 * mt + cl) * 72 + 32 * ks + 8 * g4);
                s[mt][0] = __builtin_amdgcn_mfma_f32_16x16x32_bf16(a, qf[0][ks], s[mt][0], 0, 0, 0);
                s[mt][1] = __builtin_amdgcn_mfma_f32_16x16x32_bf16(a, qf[1][ks], s[mt][1], 0, 0, 0); }
            const bool valid = smp ? (mt < 9) : (n - 2 + (mt >> 2) >= 0);
            if (!valid) { s[mt][0] = (f32x4){-1e30f, -1e30f, -1e30f, -1e30f}; s[mt][1] = s[mt][0]; }
        }
        const float sink = p.in[I_SINK][layer * 8 + h];
        float inv[2];
#pragma unroll
        for (int nt = 0; nt < 2; ++nt) {
            float mx = sink;
#pragma unroll
            for (int mt = 0; mt < 12; ++mt) mx = fmaxf(mx, fmaxf(fmaxf(s[mt][nt].x, s[mt][nt].y), fmaxf(s[mt][nt].z, s[mt][nt].w)));
            mx = fmaxf(mx, __shfl_xor(mx, 16)); mx = fmaxf(mx, __shfl_xor(mx, 32));
            float sum = 0.f;
#pragma unroll
            for (int mt = 0; mt < 12; ++mt) {
#pragma unroll
                for (int e = 0; e < 4; ++e) { const float pe = __expf(s[mt][nt][e] - mx); s[mt][nt][e] = pe; sum += pe; } }
            sum += __shfl_xor(sum, 16); sum += __shfl_xor(sum, 32);
            inv[nt] = 1.0f / (sum + __expf(sink - mx));
        }
        f32x4 o[4][2];
#pragma unroll
        for (int dt = 0; dt < 4; ++dt) { o[dt][0] = (f32x4){0.f, 0.f, 0.f, 0.f}; o[dt][1] = (f32x4){0.f, 0.f, 0.f, 0.f}; }
#pragma unroll
        for (int ks = 0; ks < 6; ++ks) {
            bf16x8 pf[2];
#pragma unroll
            for (int nt = 0; nt < 2; ++nt) { u32x4 t; t.x = cvt_pk_bf16(s[2 * ks][nt].x, s[2 * ks][nt].y); t.y = cvt_pk_bf16(s[2 * ks][nt].z, s[2 * ks][nt].w);
                t.z = cvt_pk_bf16(s[2 * ks + 1][nt].x, s[2 * ks + 1][nt].y); t.w = cvt_pk_bf16(s[2 * ks + 1][nt].z, s[2 * ks + 1][nt].w); pf[nt] = __builtin_bit_cast(bf16x8, t); }
#pragma unroll
            for (int dt = 0; dt < 4; ++dt) {
                const LAS bf16* vp = Vt + (16 * dt + cl) * 200 + 32 * ks + 4 * g4;
                const u32x2 lo = *(const LAS u32x2*)vp, hi = *(const LAS u32x2*)(vp + 16);
                const bf16x8 a = __builtin_bit_cast(bf16x8, (u32x4){lo.x, lo.y, hi.x, hi.y});
                o[dt][0] = __builtin_amdgcn_mfma_f32_16x16x32_bf16(a, pf[0], o[dt][0], 0, 0, 0);
                o[dt][1] = __builtin_amdgcn_mfma_f32_16x16x32_bf16(a, pf[1], o[dt][1], 0, 0, 0);
            }
        }
#pragma unroll
        for (int nt = 0; nt < 2; ++nt) { const int qi = 16 * nt + cl;
            if (qi < nq) {
#pragma unroll
                for (int dt = 0; dt < 4; ++dt) st_bf4(Ob + (qrow0 + qi) * 512 + h * 64 + 16 * dt + 4 * g4, o[dt][nt] * inv[nt]); } }
    }
    __syncthreads();
}

__global__ void __launch_bounds__(512, 2) fwd(Params p) {
    extern __shared__ __attribute__((aligned(16))) unsigned char lds_raw[];
    LAS unsigned char* lds = (LAS unsigned char*)lds_raw;
    cg::grid_group grid = cg::this_grid();
    const int bid = blockIdx.x, tid = threadIdx.x, G = gridDim.x;
    unsigned char* ws = p.ws;
    float* X = p.out;
    bf16* H = (bf16*)(ws + WS_H);
    const float* modall = (const float*)(ws + WS_MOD);

#if !defined(ONLY) || ONLY == 0
    p0_prologue(p, lds, bid, tid);
#endif
    grid.sync();
    for (int layer = 0; layer < DEPTH; ++layer) {
        unsigned char* wl = ws + WS_W + (size_t)layer * W_L;
        const float* modl = modall + (size_t)layer * 18 * NADA;
#if !defined(ONLY) || ONLY == 1
        norm_phase(p, layer, 0, bid, tid);
#endif
        grid.sync();
#if !defined(ONLY) || ONLY == 2
        { Gemm g{H, (const bf16*)(wl + W_IN), MT, INC, D}; StaticOrder S; S.init(MT, INC, G, bid);
          EpiWin E{(float*)(ws + WS_U), (bf16*)(ws + WS_Q), (bf16*)(ws + WS_K), (bf16*)(ws + WS_V), (bf16*)(ws + WS_G), (const float*)(ws + WS_ROPE), p.out, layer};
          pg8::gemm_phase<EpiWin, StaticOrder, 0>(lds, g, S, E, nullptr); }
        grid.sync();
#endif
#if !defined(ONLY) || ONLY == 3
        ssm_phase(p, layer, 0, lds, bid, tid);
#endif
#if !defined(ONLY) || ONLY == 4
        attn_phase(p, layer, lds, bid, tid);
#endif
        grid.sync();
#if !defined(ONLY) || ONLY == 5
        carry_phase(p, layer, bid, tid);
        { Gemm g{(const bf16*)(ws + WS_O), (const bf16*)(wl + W_O), MT, D, 512}; StaticOrder S; S.init(MT, D, G, bid);
          EpiAttnO E{(const bf16*)(ws + WS_G), (bf16*)(ws + WS_P)};
          pg8::gemm_phase<EpiAttnO, StaticOrder, 0>(lds, g, S, E, nullptr); }
        grid.sync();
#endif
#if !defined(ONLY) || ONLY == 3
        ssm_phase(p, layer, 1, lds, bid, tid);
#endif
        grid.sync();
#if !defined(ONLY) || ONLY == 6
        { Gemm g{(const bf16*)(ws + WS_YG), (const bf16*)(wl + W_GLU), MT, 2048, 512}; StaticOrder S; S.init(MT, 2048, G, bid);
          EpiGlu E{(const bf16*)(ws + WS_G), (bf16*)(ws + WS_P)};
          pg8::gemm_phase<EpiGlu, StaticOrder, 0>(lds, g, S, E, nullptr); }
        grid.sync();
#endif
#if !defined(ONLY) || ONLY == 7
        { Gemm g{(const bf16*)(ws + WS_P), (const bf16*)(wl + W_OUT), MT, D, D}; StaticOrder S; S.init(MT, D, G, bid);
          EpiRes E{layer == 0 ? p.in[I_XP] : X, layer == 0 ? p.in[I_XS] : X + (size_t)TP * D, X, modl + 2048};
          pg8::gemm_phase<EpiRes, StaticOrder, 0>(lds, g, S, E, nullptr); }
        grid.sync();
#endif
#if !defined(ONLY) || ONLY == 1
        norm_phase(p, layer, 1, bid, tid);
#endif
        grid.sync();
#if !defined(ONLY) || ONLY == 9
        { Gemm g{H, (const bf16*)(wl + W_UP), UP_TILES * 256, FF2, D}; StaticOrder S; S.init(UP_TILES * 256, FF2, G, bid);
          EpiUp<false> E{(bf16*)(ws + WS_ACT), p.in[I_CW] + (size_t)layer * 3 * FF2, p.in[I_CB] + (size_t)layer * FF2, nullptr, p.out, layer};
          pg8::gemm_phase<EpiUp<false>, StaticOrder, 1>(lds, g, S, E, nullptr); }
        { Gemm g{H + (size_t)HS_SAMPLE * D, (const bf16*)(wl + W_UP), 256, FF2, D}; StaticOrder S; S.init(256, FF2, G, G - 1 - bid);
          EpiUp<true> E{(bf16*)(ws + WS_ACT), p.in[I_CW] + (size_t)layer * 3 * FF2, p.in[I_CB] + (size_t)layer * FF2, p.in[I_SCONV] + (size_t)layer * 16 * 2 * FF2, p.out, layer};
          pg8::gemm_phase<EpiUp<true>, StaticOrder, 0>(lds, g, S, E, nullptr); }
        grid.sync();
#endif
#if !defined(ONLY) || ONLY == 10
        { Gemm g{(const bf16*)(ws + WS_ACT), (const bf16*)(wl + W_DN), MT, D, FF}; StaticOrder S; S.init(MT, D, G, bid);
          EpiRes E{X, X + (size_t)TP * D, X, modl + 5120};
          pg8::gemm_phase<EpiRes, StaticOrder, 0>(lds, g, S, E, nullptr); }
#endif
        grid.sync();
    }
#if !defined(ONLY) || ONLY == 1
    norm_phase(p, 0, 2, bid, tid);
#endif
}
}

extern "C" void kernel_launch(void* const* d_in, const int* in_sizes, int n_in, void* d_out, int out_size, void* d_ws, size_t ws_size, hipStream_t stream) {
    static int ok = 0;
    if (ok == 0) {
        ok = 1;
        if (n_in != 31 || (size_t)out_size != mk::O_END || ws_size < mk::WS_END) { fprintf(stderr, "kernel_launch: unexpected shapes n_in %d out %d ws %zu (need %zu)\n", n_in, out_size, ws_size, (size_t)mk::WS_END); ok = -1; }
        if (hipFuncSetAttribute((const void*)mk::fwd, hipFuncAttributeMaxDynamicSharedMemorySize, mk::LDS_BYTES) != hipSuccess) { fprintf(stderr, "kernel_launch: hipFuncSetAttribute failed\n"); ok = -1; }
        int per_cu = 0;
        if (hipOccupancyMaxActiveBlocksPerMultiprocessor(&per_cu, (const void*)mk::fwd, mk::NTHR, mk::LDS_BYTES) != hipSuccess || per_cu < 1) fprintf(stderr, "kernel_launch: occupancy query says %d blocks per CU\n", per_cu);
        (void)hipGetLastError();
    }
    if (ok < 0) return;
    mk::Params p{};
    for (int i = 0; i < 31; ++i) p.in[i] = (const float*)d_in[i];
    p.out = (float*)d_out; p.ws = (unsigned char*)d_ws;
    void* args[] = {&p};
    hipError_t e = hipLaunchCooperativeKernel((void*)mk::fwd, dim3(mk::NWG), dim3(mk::NTHR), args, mk::LDS_BYTES, stream);
    if (e != hipSuccess) fprintf(stderr, "kernel_launch: cooperative launch failed: %s\n", hipGetErrorString(e));
}
```

```cpp
#include <hip/hip_runtime.h>
#include <hip/hip_cooperative_groups.h>
#include <cstdio>
#include <cstdint>
namespace cg = cooperative_groups;
namespace pg8 {
#define PG8_LAS __attribute__((address_space(3)))
typedef unsigned short bf16_t;
typedef short bf16x8 __attribute__((ext_vector_type(8)));
typedef float f32x4 __attribute__((ext_vector_type(4)));
typedef unsigned u32x4 __attribute__((ext_vector_type(4)));
constexpr int BM = 256, BK = 64, HALF = 128, HTB = HALF * BK * 2  , STAGE_BYTES = 8 * HTB, NXCD = 8, WGM = 8;

__host__ __device__ __forceinline__ int lds_byte(int r, int c) { const int st = (r >> 4) * 2 + (c >> 5), rr = r & 15, cc = c & 31, ob = rr * 64 + cc * 2; return st * 1024 + (ob ^ (((ob >> 9) & 1) << 5)); }
__host__ __device__ __forceinline__ void stage_rc(int b, int& R, int& C) { const int st = b / 1024, sb = b % 1024, swz = sb ^ (((sb >> 9) & 1) << 5); R = (st >> 1) * 16 + swz / 64; C = (st & 1) * 32 + (swz % 64) / 2; }
__host__ __device__ __forceinline__ int perm32(int rho) { const int n = rho >> 4, i = rho & 15; return 8 * (i >> 2) + 4 * n + (i & 3); }

struct Unit { int pm, pn; };
struct Gemm { const bf16_t* A; const bf16_t* Bt; int M, N, K; };
struct StaticOrder {
    int nM, nN, nwg, G, c;
    __host__ __device__ void init(int M, int N, int G_, int c_) { nM = M / BM; nN = N / BM; nwg = nM * nN; G = G_; c = c_; }
    __host__ __device__ bool next(int i, Unit& u) const {
        const long L = (long)i * G + c; if (L >= nwg) return false;
        int wgid = (int)L; { const int q = nwg / NXCD, r = nwg % NXCD, xcd = wgid % NXCD, off = wgid / NXCD; wgid = (xcd < r ? xcd * (q + 1) : r * (q + 1) + (xcd - r) * q) + off; }
        const int nig = WGM * nN, gid = wgid / nig, fm = gid * WGM, gsz = (nM - fm) < WGM ? (nM - fm) : WGM;
        u.pm = fm + ((wgid % nig) % gsz); u.pn = (wgid % nig) / gsz; return true;
    }
    __device__ __forceinline__ void a_ready(const Unit&) const {}
    __device__ __forceinline__ void done(const Unit&) const {}
};
__device__ __forceinline__ unsigned cvt_pk_bf16(float lo, float hi) { unsigned r; asm volatile("v_cvt_pk_bf16_f32 %0, %1, %2" : "=v"(r) : "v"(lo), "v"(hi)); return r; }
template <class Epi, class Sched, int AMAP = 0, bool STAMP = false>
__device__ __forceinline__ void gemm_phase(PG8_LAS unsigned char* lds, const Gemm g, const Sched& S, const Epi& E, unsigned long long* stamps) {
    int tid_o = threadIdx.x; asm volatile("" : "+v"(tid_o)); const int tid = tid_o, wid = __builtin_amdgcn_readfirstlane(tid >> 6), lane = tid & 63, wr = wid >> 2, wc = wid & 3, fr = lane & 15, fq = lane >> 4;
    const int K = g.K, nt = K / BK;
    int ts_lo = 0, ts_hi = 0, nts = 0; const unsigned long long rt_entry = STAMP ? (unsigned long long)0ull : 0ull;
#define PG8_STAMP() do { if (STAMP && wid == 0 && nts < 64) { const unsigned long long _c = (unsigned long long)0ull; \
        ts_lo = (lane == nts) ? (int)(unsigned)_c : ts_lo; ts_hi = (lane == nts) ? (int)(unsigned)(_c >> 32) : ts_hi; ++nts; } } while (0)
    PG8_STAMP();
    unsigned voffA[2], voffB[2];
#pragma unroll
    for (int i = 0; i < 2; ++i) { int R, C; stage_rc(tid * 16 + i * 8192, R, C); const int Rb = Epi::PERM ? ((R & ~31) + perm32(R & 31)) : R;
        const int Ra = AMAP ? ((R >> 6) * 62 + (R & 63)) : R; voffA[i] = (unsigned)(Ra * K + C) * 2u; voffB[i] = (unsigned)(Rb * K + C) * 2u; }
    const size_t kstep = (size_t)(BK * 2);
    const size_t hstep = (size_t)HALF * K * 2;
    const size_t tstep = 2 * hstep; const size_t hstepA = AMAP ? (size_t)124 * K * 2 : hstep; const size_t tstepA = 2 * hstepA;
    const unsigned ldsw = (unsigned)wid * 1024u;
    const int aoff = lds_byte(wr * 64 + fr, fq * 8), boff = lds_byte(wc * 32 + fr, fq * 8);
#define PG8_SA(b, h) (((b) * 2 + (h)) * HTB)
#define PG8_SB(b, h) ((4 + (b) * 2 + (h)) * HTB)
#define PG8_STAGE(bufoff, gbase, voff) do { _Pragma("unroll") for (int _i = 0; _i < 2; ++_i) \
        __builtin_amdgcn_global_load_lds((const unsigned*)((const char*)(gbase) + (voff)[_i]), (PG8_LAS unsigned*)(lds + (bufoff) + ldsw + _i * 8192), 16, 0, 0); } while (0)
#define PG8_LDA(dst, b, h) do { _Pragma("unroll") for (int m = 0; m < 4; ++m) _Pragma("unroll") for (int k = 0; k < 2; ++k) dst[m][k] = *(const PG8_LAS bf16x8*)(lds + PG8_SA(b, h) + aoff + m * 2048 + k * 1024); } while (0)
#define PG8_LDB(dst, b, h) do { _Pragma("unroll") for (int n = 0; n < 2; ++n) _Pragma("unroll") for (int k = 0; k < 2; ++k) dst[n][k] = *(const PG8_LAS bf16x8*)(lds + PG8_SB(b, h) + boff + n * 2048 + k * 1024); } while (0)
#define PG8_MMA(ai, bj, At, Bt) do { __builtin_amdgcn_s_setprio(1); _Pragma("unroll") for (int m = 0; m < 4; ++m) _Pragma("unroll") for (int n = 0; n < 2; ++n) _Pragma("unroll") for (int k = 0; k < 2; ++k) \
        acc[ai][bj][m][n] = __builtin_amdgcn_mfma_f32_16x16x32_bf16(Bt[n][k], At[m][k], acc[ai][bj][m][n], 0, 0, 0); __builtin_amdgcn_s_setprio(0); } while (0)
#define PG8_WAIT_V(n) asm volatile("s_waitcnt vmcnt(" #n ")" ::: "memory")
#define PG8_WAIT_L(n) asm volatile("s_waitcnt lgkmcnt(" #n ")" ::: "memory")
#define PG8_BAR __builtin_amdgcn_s_barrier()
#define PG8_SCHED __builtin_amdgcn_sched_barrier(0)
    Unit cur, nxt; int ui = 0;
    if (!S.next(0, cur)) return;
    f32x4 acc[2][2][4][2];
#pragma unroll
    for (int a = 0; a < 2; ++a)
#pragma unroll
        for (int b = 0; b < 2; ++b)
#pragma unroll
            for (int m = 0; m < 4; ++m)
#pragma unroll
                for (int n = 0; n < 2; ++n) acc[a][b][m][n] = (f32x4){0.f, 0.f, 0.f, 0.f};
    bf16x8 At[4][2], B0[2][2], B1[2][2];
    const char* cA = (const char*)g.A + (size_t)cur.pm * tstepA; const char* cB = (const char*)g.Bt + (size_t)cur.pn * tstep;
    S.a_ready(cur);
    PG8_STAGE(PG8_SB(0, 0), cB, voffB); PG8_STAGE(PG8_SA(0, 0), cA, voffA); PG8_STAGE(PG8_SB(0, 1), cB + hstep, voffB); PG8_STAGE(PG8_SA(0, 1), cA + hstepA, voffA);
    if (wr == 1) PG8_BAR;
    PG8_WAIT_V(4); PG8_BAR;
    PG8_STAGE(PG8_SB(1, 0), cB + kstep, voffB); PG8_STAGE(PG8_SA(1, 0), cA + kstep, voffA); PG8_STAGE(PG8_SB(1, 1), cB + hstep + kstep, voffB);
    PG8_WAIT_V(6); PG8_BAR;
    PG8_STAMP();
    for (;;) {
        const bool has_next = S.next(ui + 1, nxt);
        const char* nA = has_next ? (const char*)g.A + (size_t)nxt.pm * tstepA : cA; const char* nB = has_next ? (const char*)g.Bt + (size_t)nxt.pn * tstep : cB;
        for (int t = 0; t < nt; t += 2) {
            const bool last = (t == nt - 2);
            const char* a1 = cA + (size_t)(t + 1) * kstep;
            const char* a2 = last ? nA : cA + (size_t)(t + 2) * kstep; const char* b2 = last ? nB : cB + (size_t)(t + 2) * kstep;
            const char* a3 = a2 + kstep; const char* b3 = b2 + kstep;
            if (last && has_next) S.a_ready(nxt);
            PG8_LDB(B0, 0, 0); PG8_SCHED; PG8_LDA(At, 0, 0); PG8_STAGE(PG8_SA(1, 1), a1 + hstepA, voffA);
            PG8_WAIT_L(8); PG8_BAR; PG8_WAIT_L(0); PG8_MMA(0, 0, At, B0); PG8_BAR; PG8_SCHED;
            PG8_LDB(B1, 0, 1); PG8_STAGE(PG8_SB(0, 0), b2, voffB);
            PG8_BAR; PG8_WAIT_L(0); PG8_MMA(0, 1, At, B1); PG8_BAR;
            PG8_LDA(At, 0, 1); PG8_STAGE(PG8_SA(0, 0), a2, voffA);
            PG8_BAR; PG8_WAIT_L(0); PG8_MMA(1, 0, At, B0); PG8_BAR; PG8_SCHED;
            PG8_STAGE(PG8_SB(0, 1), b2 + hstep, voffB);
            PG8_WAIT_V(6); PG8_BAR; PG8_MMA(1, 1, At, B1); PG8_BAR;
            PG8_LDB(B0, 1, 0); PG8_SCHED; PG8_LDA(At, 1, 0); PG8_STAGE(PG8_SA(0, 1), a2 + hstepA, voffA);
            PG8_WAIT_L(8); PG8_BAR; PG8_WAIT_L(0); PG8_MMA(0, 0, At, B0); PG8_BAR; PG8_SCHED;
            PG8_LDB(B1, 1, 1); PG8_STAGE(PG8_SB(1, 0), b3, voffB);
            PG8_BAR; PG8_WAIT_L(0); PG8_MMA(0, 1, At, B1); PG8_BAR;
            PG8_LDA(At, 1, 1); PG8_STAGE(PG8_SA(1, 0), a3, voffA);
            PG8_BAR; PG8_WAIT_L(0); PG8_MMA(1, 0, At, B0); PG8_BAR; PG8_SCHED;
            PG8_STAGE(PG8_SB(1, 1), b3 + hstep, voffB);
            PG8_WAIT_V(6); PG8_BAR; PG8_MMA(1, 1, At, B1); PG8_BAR;
        }
        PG8_STAMP();
        if constexpr (!Epi::AFTER_DRAIN) { E(acc, cur, wr, wc, fr, fq); S.done(cur); }
        PG8_STAMP();
        if (!has_next) break;
#pragma unroll
        for (int a = 0; a < 2; ++a)
#pragma unroll
            for (int b = 0; b < 2; ++b)
#pragma unroll
                for (int m = 0; m < 4; ++m)
#pragma unroll
                    for (int n = 0; n < 2; ++n) acc[a][b][m][n] = (f32x4){0.f, 0.f, 0.f, 0.f};
        cur = nxt; cA = nA; cB = nB; ++ui;
    }
    PG8_WAIT_V(0);
    if (wr == 0) PG8_BAR;
    PG8_BAR;
    if constexpr (Epi::AFTER_DRAIN) { E.fused(acc, cur, wr, wc, fr, fq, lds, wid, lane); S.done(cur); }
    PG8_STAMP();
    if (STAMP && wid == 0) { stamps[lane] = lane < nts ? (((unsigned long long)(unsigned)ts_hi << 32) | (unsigned)ts_lo) : 0ull;
        if (lane == 62) stamps[62] = rt_entry; if (lane == 63) stamps[63] = (unsigned long long)0ull; }
#undef PG8_STAMP
#undef PG8_SA
#undef PG8_SB
#undef PG8_STAGE
#undef PG8_LDA
#undef PG8_LDB
#undef PG8_MMA
#undef PG8_WAIT_V
#undef PG8_WAIT_L
#undef PG8_BAR
#undef PG8_SCHED
}
}
namespace xb {
#define XB_TMO      128
#define XB_XCNT(j)  (256  + 64 * (j))
#define XB_XSUB(j)  (1280 + 64 * (j))
#define XB_XGEN(j)  (2304 + 64 * (j))
#define XB_TOP      3328
#define XB_TOPGEN   3392
#define XCD_BAR_WORDS 3456
#define XB_SPIN_CAP (1u << 18)

__device__ __forceinline__ unsigned xb_ld(unsigned* p)              { return __hip_atomic_load(p, __ATOMIC_RELAXED, __HIP_MEMORY_SCOPE_AGENT); }
__device__ __forceinline__ unsigned xb_add(unsigned* p, unsigned v) { return __hip_atomic_fetch_add(p, v, __ATOMIC_RELAXED, __HIP_MEMORY_SCOPE_AGENT); }
__device__ __forceinline__ unsigned xb_xcc_id() { return (unsigned)__builtin_amdgcn_s_getreg((3 << 11) | 20) & 0xFu; }
#define XB_SPIN(cond, bar) do { unsigned _sp = 0; while (cond) { __builtin_amdgcn_s_sleep(1); \
    if ((++_sp & 255u) == 0u) { if (xb_ld(&(bar)[XB_TMO])) break; if (_sp > XB_SPIN_CAP) { atomicAdd(&(bar)[XB_TMO], 1u); break; } } } } while (0)

struct XcdBarrier {
    unsigned* bar; unsigned x;
    volatile __attribute__((address_space(3))) unsigned* st;
};

__device__ __forceinline__ XcdBarrier xcd_barrier_post(unsigned* bar, volatile __attribute__((address_space(3))) unsigned* st) {
    XcdBarrier b; b.bar = bar; b.x = xb_xcc_id(); b.st = st;
    if (threadIdx.x == 0) (void)xb_add(&bar[XB_XCNT(b.x)], 1u);
    return b;
}
__device__ __forceinline__ void xcd_barrier_complete(unsigned* bar, unsigned x, unsigned& nloc, unsigned& nx) {
    const unsigned G = gridDim.x * gridDim.y * gridDim.z;
    unsigned sum, cnt, mine, sp = 0u;
    for (;;) {
        sum = 0u; cnt = 0u; mine = 0u;
#pragma unroll
        for (unsigned j = 0; j < 16; ++j) { const unsigned c = xb_ld(&bar[XB_XCNT(j)]); sum += c; cnt += (c > 0u) ? 1u : 0u; mine = (j == x) ? c : mine; }
        if (sum == G) break;
        __builtin_amdgcn_s_sleep(1);
        if ((++sp & 255u) == 0u) { if (xb_ld(&bar[XB_TMO])) break; if (sp > XB_SPIN_CAP) { atomicAdd(&bar[XB_TMO], 1u); break; } }
    }
    nloc = mine > 0u ? mine : 1u; nx = cnt > 0u ? cnt : 1u;
}

__device__ __forceinline__ void xcd_barrier(const XcdBarrier& b) {
    asm volatile("s_waitcnt vmcnt(0)" ::: "memory");
    __syncthreads();
    if (threadIdx.x == 0) {
        unsigned* bar = b.bar;
        __builtin_amdgcn_s_waitcnt(0);
        unsigned nloc = b.st[0], nx = b.st[1];
        if (nloc == 0u) { xcd_barrier_complete(bar, b.x, nloc, nx); b.st[0] = nloc; b.st[1] = nx; }
        const unsigned old = xb_add(&bar[XB_XSUB(b.x)], 1u);
        const unsigned gen = old / nloc;
        if (old + 1u == (gen + 1u) * nloc) {
            __builtin_amdgcn_fence(__ATOMIC_RELEASE, "agent");
            asm volatile("s_waitcnt vmcnt(0)" ::: "memory");
            const unsigned og = xb_add(&bar[XB_TOP], 1u);
            const unsigned tg = og / nx;
            if (og + 1u == (tg + 1u) * nx) xb_add(&bar[XB_TOPGEN], 1u);
            else XB_SPIN(xb_ld(&bar[XB_TOPGEN]) == tg, bar);
            __builtin_amdgcn_fence(__ATOMIC_ACQUIRE, "agent");
            xb_add(&bar[XB_XGEN(b.x)], 1u);
            asm volatile("s_waitcnt vmcnt(0)" ::: "memory");
        } else {
            XB_SPIN(xb_ld(&bar[XB_XGEN(b.x)]) == gen, bar);
            __builtin_amdgcn_fence(__ATOMIC_ACQUIRE, "agent");
            asm volatile("s_waitcnt vmcnt(0)" ::: "memory");
        }
    }
    __syncthreads();
}

}
#ifndef PROBE
#define PROBE 0
#endif
#define REPK(k) _Pragma("unroll 1") for (int rep_ = 0; rep_ < ((PROBE == (k)) ? 2 : 1); ++rep_)
namespace mk {
#ifndef SCHB
#define SCHB (void)0
#endif
using pg8::Unit; using pg8::Gemm; using pg8::StaticOrder; using pg8::cvt_pk_bf16;
#define LAS __attribute__((address_space(3)))
typedef unsigned short bf16;
typedef float f32x4 __attribute__((ext_vector_type(4)));
typedef short bf16x8 __attribute__((ext_vector_type(8)));
typedef unsigned u32x2 __attribute__((ext_vector_type(2)));
typedef unsigned u32x4 __attribute__((ext_vector_type(4)));

constexpr int D = 1024, SEQ = 16384, TP = 32768, TS = 256, MT = 33024, DEPTH = 4, INC = 3328, FF = 2816, FF2 = 5632, NADA = 6144;
constexpr int HSEQ = 16386, HS_SAMPLE = 33280, H_ROWS = 33536, UP_TILES = 133;
constexpr int NWG = 256, NTHR = 512;
constexpr int LDS_BYTES = 135168;
constexpr size_t O_Y = 0, O_YS = 33554432, O_KP = 33816576, O_VP = 33947648, O_SRP = 34078720, O_SIP = 34095104, O_CP = 34111488,
                 O_KS = 34201600, O_VS = 34332672, O_SRS = 34463744, O_SIS = 34594816, O_CS = 34725888, O_END = 35446784;
constexpr size_t WS_BAR = 518586368, BAR_BYTES = 16384;
constexpr size_t WS_ZERO = 518602752;
constexpr int MISC_OFF = 131072;
constexpr size_t W_L = 29360128, W_IN = 0, W_GLU = 6815744, W_O = 8912896, W_OUT = 9961472, W_UP = 12058624, W_DN = 23592960;
constexpr size_t WS_W = 0, WS_MOD = 117440512, WS_ROPE = 119209984, WS_CH = 120258560, WS_H = 128647168, WS_O = WS_H, WS_YG = WS_H + 33816576,
                 WS_U = 197328896, WS_Q = 264962048, WS_K = 298778624, WS_V = 307232768, WS_G = 315686912, WS_P = 450953216, WS_END = 518586368, WS_ACT = WS_U;

struct Params { const float* in[31]; float* out; unsigned char* ws; };
enum { I_XP = 0, I_XS, I_CK, I_CV, I_SRE, I_SIM, I_SCONV, I_CP, I_CS, I_ADAW, I_ADAB, I_N1G, I_N2G, I_WIN, I_ARE, I_AIM, I_LDT, I_BRE, I_BIM, I_CRE, I_CIM, I_SD,
       I_WGLU, I_SINK, I_WO, I_WOUT, I_WUP, I_CW, I_CB, I_WDN, I_FG };

__device__ __forceinline__ float bf2f(unsigned h) { return __uint_as_float(h << 16); }
__device__ __forceinline__ unsigned f2bf(float f) { unsigned u = __float_as_uint(f); return (u + 0x7fffu + ((u >> 16) & 1u)) >> 16; }
__device__ __forceinline__ float sigm(float x) { return __builtin_amdgcn_rcpf(1.0f + __builtin_amdgcn_exp2f(-1.4426950409f * x)); }
__device__ __forceinline__ float gelu_tanh(float x) { const float z = 1.5957691216f * (x + 0.044715f * x * x * x); return x * sigm(z); }
__device__ __forceinline__ f32x4 ld_bf4(const bf16* p) { const u32x2 v = *(const u32x2*)p; return (f32x4){__uint_as_float(v.x << 16), __uint_as_float(v.x & 0xffff0000u), __uint_as_float(v.y << 16), __uint_as_float(v.y & 0xffff0000u)}; }
__device__ __forceinline__ void st_bf4(bf16* p, f32x4 v) { u32x2 o; o.x = cvt_pk_bf16(v.x, v.y); o.y = cvt_pk_bf16(v.z, v.w); *(u32x2*)p = o; }
__device__ __forceinline__ int modrow_of(int row) { return row < TP ? (row >> 14) : 2 + ((row - TP) >> 4); }
__device__ __forceinline__ int pos_of(int row) { return row < TP ? (row & (SEQ - 1)) : 2048 + ((row - TP) & 15); }
__device__ __forceinline__ float wave_sum(float v) {
#pragma unroll
    for (int o = 1; o < 64; o <<= 1) v += __shfl_xor(v, o);
    return v;
}
template <int CTRL> __device__ __forceinline__ float dpp_mov(float old, float src) {
    return __builtin_bit_cast(float, __builtin_amdgcn_update_dpp(__builtin_bit_cast(int, old), __builtin_bit_cast(int, src), CTRL, 0xf, 0xf, false));
}
template <int CTRL> __device__ __forceinline__ float dpp_rot(float src) {
    return __builtin_bit_cast(float, __builtin_amdgcn_mov_dpp(__builtin_bit_cast(int, src), CTRL, 0xf, 0xf, true));
}
__device__ __forceinline__ f32x4 row_prev1(f32x4 cur, f32x4 pm) { f32x4 r;
#pragma unroll
    for (int e = 0; e < 4; ++e) r[e] = dpp_mov<0x111>(dpp_rot<0x121>(pm[e]), cur[e]);
    return r; }
__device__ __forceinline__ f32x4 row_prev2(f32x4 cur, f32x4 pm) { f32x4 r;
#pragma unroll
    for (int e = 0; e < 4; ++e) r[e] = dpp_mov<0x112>(dpp_rot<0x122>(pm[e]), cur[e]);
    return r; }

typedef float f32x2 __attribute__((ext_vector_type(2)));
template <int E> __device__ __forceinline__ f32x2 conv_pair(f32x4 b, f32x4 w0, f32x4 w1, f32x4 w2, f32x4 cur, f32x4 pm) {
    const f32x2 c = (f32x2){cur[E], cur[E + 1]};
    const f32x2 p1 = (f32x2){dpp_mov<0x111>(dpp_rot<0x121>(pm[E]), cur[E]), dpp_mov<0x111>(dpp_rot<0x121>(pm[E + 1]), cur[E + 1])};
    const f32x2 p2 = (f32x2){dpp_mov<0x112>(dpp_rot<0x122>(pm[E]), cur[E]), dpp_mov<0x112>(dpp_rot<0x122>(pm[E + 1]), cur[E + 1])};
    f32x2 r = (f32x2){b[E], b[E + 1]} + (f32x2){w2[E], w2[E + 1]} * c;
    r = (f32x2){w1[E], w1[E + 1]} * p1 + r;
    r = (f32x2){w0[E], w0[E + 1]} * p2 + r;
    return r;
}
struct EpiWin {
    static constexpr bool PERM = false, AFTER_DRAIN = false;
    bf16* U; bf16* Q; bf16* Kb; bf16* Vb; bf16* G; const float* rope; float* out; int layer;
    __device__ __forceinline__ f32x4 rot(f32x4 v, f32x4 cs, f32x4 sn, int fq) const {
        f32x4 o, r;
#pragma unroll
        for (int e = 0; e < 4; ++e) o[e] = __shfl_xor(v[e], 32);
        if (fq < 2) r = v * cs - o * sn; else r = v * cs + o * sn;
        return r;
    }
    __device__ __forceinline__ void operator()(const f32x4 (&acc)[2][2][4][2], const Unit& u, int wr, int wc, int fr, int fq) const {
        const int pn = u.pn;
        const bool need_rot = (pn >= 2 && pn <= 4) && (wc & 1) == 0;
#pragma unroll
        for (int ai = 0; ai < 2; ++ai) {
            f32x4 rcs[4], rsn[4];
#pragma unroll
            for (int m = 0; m < 4; ++m) { rcs[m] = (f32x4){1.f, 1.f, 1.f, 1.f}; rsn[m] = (f32x4){0.f, 0.f, 0.f, 0.f};
                if (need_rot) { const float* rp = rope + (unsigned)(pos_of(u.pm * 256 + ai * 128 + wr * 64 + m * 16 + fr) * 16 + 4 * (fq & 1)); rcs[m] = *(const f32x4*)rp; rsn[m] = *(const f32x4*)(rp + 8); } }
#pragma unroll
            for (int m = 0; m < 4; ++m) {
                const int row = u.pm * 256 + ai * 128 + wr * 64 + m * 16 + fr;
                const int pos = pos_of(row);
                if (pn < 2) {
#pragma unroll
                    for (int bj = 0; bj < 2; ++bj)
#pragma unroll
                        for (int n = 0; n < 2; ++n) st_bf4(U + (unsigned)(row * 512 + pn * 256 + bj * 128 + wc * 32 + n * 16 + 4 * fq), acc[ai][bj][m][n]);
                } else if (pn < 4) {
#pragma unroll
                    for (int bj = 0; bj < 2; ++bj)
#pragma unroll
                        for (int n = 0; n < 2; ++n) {
                            f32x4 v = acc[ai][bj][m][n] * 0.125f;
                            if (n == 0 && (wc & 1) == 0) v = rot(v, rcs[m], rsn[m], fq);
                            st_bf4(Q + (unsigned)(row * 512 + (pn - 2) * 256 + bj * 128 + wc * 32 + n * 16 + 4 * fq), v);
                        }
                } else if (pn == 4) {
#pragma unroll
                    for (int bj = 0; bj < 2; ++bj)
#pragma unroll
                        for (int n = 0; n < 2; ++n) {
                            f32x4 v = acc[ai][bj][m][n];
                            const int c = wc * 32 + n * 16 + 4 * fq;
                            if (bj == 0 && n == 0 && (wc & 1) == 0) v = rot(v, rcs[m], rsn[m], fq);
                            st_bf4((bj == 0 ? Kb : Vb) + (unsigned)(row * 128 + c), v);
                            if (row >= TP) *(f32x4*)(out + (bj == 0 ? O_KS : O_VS) + (unsigned)((layer * 256 + (row - TP)) * 128 + c)) = v;
                            else if (pos >= SEQ - 128) *(f32x4*)(out + (bj == 0 ? O_KP : O_VP) + (unsigned)(((layer * 2 + (row >> 14)) * 128 + (pos - (SEQ - 128))) * 128 + c)) = v;
                        }
                } else {
#pragma unroll
                    for (int bj = 0; bj < 2; ++bj)
#pragma unroll
                        for (int n = 0; n < 2; ++n) {
                            const f32x4 a = acc[ai][bj][m][n]; f32x4 v;
#pragma unroll
                            for (int e = 0; e < 4; ++e) v[e] = sigm(a[e]);
                            st_bf4(G + (unsigned)(row * 2048 + (pn - 5) * 256 + bj * 128 + wc * 32 + n * 16 + 4 * fq), v);
                        }
                }
            }
        }
    }
};
struct EpiAttnO {
    static constexpr bool PERM = false, AFTER_DRAIN = false;
    const bf16* G; bf16* P;
    __device__ __forceinline__ void quad(int row, int cb, int fq, f32x4 v0, f32x4 v1) const {
        const int col = cb + 4 * fq;
        st_bf4(P + (unsigned)(row * 1024 + col), ld_bf4(G + (unsigned)(row * 2048 + 1024 + col)) * v0);
        st_bf4(P + (unsigned)(row * 1024 + col + 16), ld_bf4(G + (unsigned)(row * 2048 + 1024 + col + 16)) * v1);
    }
    __device__ __forceinline__ void operator()(const f32x4 (&acc)[2][2][4][2], const Unit& u, int wr, int wc, int fr, int fq) const {
#pragma unroll
        for (int ai = 0; ai < 2; ++ai) {
            u32x2 gq[4][2][2];
#pragma unroll
            for (int m = 0; m < 4; ++m)
#pragma unroll
                for (int bj = 0; bj < 2; ++bj)
#pragma unroll
                    for (int n = 0; n < 2; ++n) gq[m][bj][n] = *(const u32x2*)(G + (unsigned)((u.pm * 256 + ai * 128 + wr * 64 + m * 16 + fr) * 2048 + 1024 + u.pn * 256 + bj * 128 + wc * 32 + 16 * n + 4 * fq));
#pragma unroll
            for (int m = 0; m < 4; ++m)
#pragma unroll
                for (int bj = 0; bj < 2; ++bj)
#pragma unroll
                    for (int n = 0; n < 2; ++n) { const u32x2 q = gq[m][bj][n];
                        const f32x4 gb = (f32x4){__uint_as_float(q.x << 16), __uint_as_float(q.x & 0xffff0000u), __uint_as_float(q.y << 16), __uint_as_float(q.y & 0xffff0000u)};
                        st_bf4(P + (unsigned)((u.pm * 256 + ai * 128 + wr * 64 + m * 16 + fr) * 1024 + u.pn * 256 + bj * 128 + wc * 32 + 16 * n + 4 * fq), gb * acc[ai][bj][m][n]); }
        }
    }
};
struct EpiGlu {
    static constexpr bool PERM = false, AFTER_DRAIN = false;
    const bf16* G; bf16* P;
    __device__ __forceinline__ void quad(int row, int cb, int fq, f32x4 a, f32x4 b) const {
        const int j = (cb >> 1) + 4 * fq;
        const f32x4 ga = ld_bf4(G + (unsigned)(row * 2048 + j)), pb = ld_bf4(P + (unsigned)(row * 1024 + j));
        f32x4 v;
#pragma unroll
        for (int e = 0; e < 4; ++e) v[e] = ga[e] * a[e] * sigm(b[e]) + pb[e];
        st_bf4(P + (unsigned)(row * 1024 + j), v);
    }
    __device__ __forceinline__ void operator()(const f32x4 (&acc)[2][2][4][2], const Unit& u, int wr, int wc, int fr, int fq) const {
#pragma unroll
        for (int ai = 0; ai < 2; ++ai) {
            u32x2 gq[4][2], pq[4][2];
#pragma unroll
            for (int m = 0; m < 4; ++m)
#pragma unroll
                for (int bj = 0; bj < 2; ++bj) { const int row = u.pm * 256 + ai * 128 + wr * 64 + m * 16 + fr, j = ((u.pn * 256 + bj * 128 + wc * 32) >> 1) + 4 * fq;
                    gq[m][bj] = *(const u32x2*)(G + (unsigned)(row * 2048 + j)); pq[m][bj] = *(const u32x2*)(P + (unsigned)(row * 1024 + j)); }
#pragma unroll
            for (int m = 0; m < 4; ++m)
#pragma unroll
                for (int bj = 0; bj < 2; ++bj) { const int row = u.pm * 256 + ai * 128 + wr * 64 + m * 16 + fr, j = ((u.pn * 256 + bj * 128 + wc * 32) >> 1) + 4 * fq;
                    const u32x2 q = gq[m][bj], r = pq[m][bj];
                    const f32x4 ga = (f32x4){__uint_as_float(q.x << 16), __uint_as_float(q.x & 0xffff0000u), __uint_as_float(q.y << 16), __uint_as_float(q.y & 0xffff0000u)};
                    const f32x4 pb = (f32x4){__uint_as_float(r.x << 16), __uint_as_float(r.x & 0xffff0000u), __uint_as_float(r.y << 16), __uint_as_float(r.y & 0xffff0000u)};
                    const f32x4 a = acc[ai][bj][m][0], bb = acc[ai][bj][m][1]; f32x4 v;
#pragma unroll
                    for (int e2 = 0; e2 < 4; ++e2) v[e2] = ga[e2] * a[e2] * sigm(bb[e2]) + pb[e2];
                    st_bf4(P + (unsigned)(row * 1024 + j), v); }
        }
    }
};
struct EpiRes {
    static constexpr bool PERM = false, AFTER_DRAIN = false;
    const float* xb; float* X; const float* gvec;
    __device__ __forceinline__ void quad(int row, int cb, int fq, f32x4 v0, f32x4 v1) const {
        const unsigned go = (unsigned)(modrow_of(row) * NADA), o = (unsigned)(row * D + cb + 4 * fq);
        *(f32x4*)(X + o) = *(const f32x4*)(xb + o) + *(const f32x4*)(gvec + (go + cb + 4 * fq)) * v0;
        *(f32x4*)(X + o + 16) = *(const f32x4*)(xb + o + 16) + *(const f32x4*)(gvec + (go + cb + 4 * fq + 16)) * v1;
    }
    __device__ __forceinline__ void operator()(const f32x4 (&acc)[2][2][4][2], const Unit& u, int wr, int wc, int fr, int fq) const {
        const unsigned go = (unsigned)(modrow_of(u.pm * 256) * NADA);
        f32x4 gv[2][2];
#pragma unroll
        for (int bj = 0; bj < 2; ++bj)
#pragma unroll
            for (int n = 0; n < 2; ++n) gv[bj][n] = *(const f32x4*)(gvec + (go + u.pn * 256 + bj * 128 + wc * 32 + 16 * n + 4 * fq));
#pragma unroll
        for (int ai = 0; ai < 2; ++ai) {
            f32x4 xr[4][2][2];
#pragma unroll
            for (int m = 0; m < 4; ++m)
#pragma unroll
                for (int bj = 0; bj < 2; ++bj)
#pragma unroll
                    for (int n = 0; n < 2; ++n) xr[m][bj][n] = *(const f32x4*)(xb + (unsigned)((u.pm * 256 + ai * 128 + wr * 64 + m * 16 + fr) * D + u.pn * 256 + bj * 128 + wc * 32 + 16 * n + 4 * fq));
#pragma unroll
            for (int m = 0; m < 4; ++m)
#pragma unroll
                for (int bj = 0; bj < 2; ++bj)
#pragma unroll
                    for (int n = 0; n < 2; ++n) *(f32x4*)(X + (unsigned)((u.pm * 256 + ai * 128 + wr * 64 + m * 16 + fr) * D + u.pn * 256 + bj * 128 + wc * 32 + 16 * n + 4 * fq)) = xr[m][bj][n] + gv[bj][n] * acc[ai][bj][m][n];
        }
    }
};
template <int SPLIT, class Epi> __device__ __forceinline__ void small_gemm(const bf16* A, const bf16* Wt, int N, int K, int row0, const Epi& E, LAS unsigned char* lds, int bid, int tid) {
    asm volatile("" : "+v"(tid));
    const int lane = tid & 63, wave = tid >> 6, fr = lane & 15, fq = lane >> 4;
    const int nct = N >> 5, ntile = 16 * nct, tpw = 8 / SPLIT, kp = wave % SPLIT, tl = wave / SPLIT, kb = (K / SPLIT) * kp, ke = kb + K / SPLIT;
    LAS f32x4* red = (LAS f32x4*)lds;
    for (int t0 = bid * tpw; t0 < ntile; t0 += NWG * tpw) {
        const int tile = t0 + tl, rt = tile / nct, ct = tile - rt * nct;
        const bf16* ap = A + (unsigned)((16 * rt + fr) * K + 8 * fq);
        const bf16* bp0 = Wt + (unsigned)((32 * ct + fr) * K + 8 * fq);
        const bf16* bp1 = bp0 + (unsigned)(16 * K);
        f32x4 c0 = (f32x4){0.f, 0.f, 0.f, 0.f}, c1 = (f32x4){0.f, 0.f, 0.f, 0.f};
        for (int k0 = kb; k0 < ke; k0 += 256) {
            const int nst = (ke - k0) >> 5;
            bf16x8 a[8], b0[8], b1[8];
#pragma unroll
            for (int s = 0; s < 8; ++s) if (s < nst) { a[s] = *(const bf16x8*)(ap + k0 + 32 * s); b0[s] = *(const bf16x8*)(bp0 + k0 + 32 * s); b1[s] = *(const bf16x8*)(bp1 + k0 + 32 * s); }
#pragma unroll
            for (int s = 0; s < 8; ++s) if (s < nst) { c0 = __builtin_amdgcn_mfma_f32_16x16x32_bf16(b0[s], a[s], c0, 0, 0, 0); c1 = __builtin_amdgcn_mfma_f32_16x16x32_bf16(b1[s], a[s], c1, 0, 0, 0); }
        }
        if (SPLIT > 1) {
            __builtin_amdgcn_sched_barrier(0); asm volatile("s_nop 15\n\ts_nop 15" ::: "memory"); __builtin_amdgcn_sched_barrier(0);
            red[(wave * 2 + 0) * 64 + lane] = c0; red[(wave * 2 + 1) * 64 + lane] = c1;
            __syncthreads();
            if (kp == 0) {
#pragma unroll
                for (int j = 1; j < SPLIT; ++j) { c0 += red[((wave + j) * 2 + 0) * 64 + lane]; c1 += red[((wave + j) * 2 + 1) * 64 + lane]; }
            }
        }
        if (kp == 0) E.quad(row0 + 16 * rt + fr, 32 * ct, fq, c0, c1);
        if (SPLIT > 1) __syncthreads();
    }
}
template <bool SAMPLE> struct EpiUp {
    static constexpr bool PERM = false, AFTER_DRAIN = false;
    bf16* ACT; const float* cw; const float* cb; const float* sconv; float* out; int layer;
    __device__ __forceinline__ void operator()(const f32x4 (&acc)[2][2][4][2], const Unit& u, int wr, int wc, int fr, int fq) const {
        const f32x4 z = (f32x4){0.f, 0.f, 0.f, 0.f};
#pragma unroll
        for (int bj = 0; bj < 2; ++bj) {
            const int jf = 16 * (8 * u.pn + 4 * bj + wc) + 4 * fq;
            typedef const __attribute__((address_space(4))) f32x4* cptr4;
            const f32x4 wv0 = *(cptr4)(cw + jf), wv1 = *(cptr4)(cw + FF2 + jf), wv2 = *(cptr4)(cw + 2 * FF2 + jf), bv = *(cptr4)(cb + jf);
            const f32x4 wg0 = *(cptr4)(cw + FF + jf), wg1 = *(cptr4)(cw + FF2 + FF + jf), wg2 = *(cptr4)(cw + 2 * FF2 + FF + jf), bg = *(cptr4)(cb + FF + jf);
#pragma unroll
            for (int ai = 0; ai < 2; ++ai)
#pragma unroll
                for (int m = 0; m < 4; ++m) {
                    const f32x4 cv = acc[ai][bj][m][0], cg = acc[ai][bj][m][1];
                    const f32x4 pv = m > 0 ? acc[ai][bj][m > 0 ? m - 1 : 0][0] : z, pg = m > 0 ? acc[ai][bj][m > 0 ? m - 1 : 0][1] : z;
                    f32x4 val = bv + wv2 * cv, gat = bg + wg2 * cg;
                    bool valid; unsigned aoff;
                    if (SAMPLE) {
                        const int s = 8 * ai + 4 * wr + m, t = fr;
                        f32x4 p1v = row_prev1(cv, z), p2v = row_prev2(cv, z), p1g = row_prev1(cg, z), p2g = row_prev2(cg, z);
                        if (t < 2) {
                            const float* st = sconv + (unsigned)(s * 2 * FF2 + jf);
                            const f32x4 s1v = *(const f32x4*)(st + FF2), s1g = *(const f32x4*)(st + FF2 + FF);
                            if (t == 0) { p1v = s1v; p1g = s1g; p2v = *(const f32x4*)st; p2g = *(const f32x4*)(st + FF); }
                            else { p2v = s1v; p2g = s1g; }
                        }
                        val += wv0 * p2v + wv1 * p1v; gat += wg0 * p2g + wg1 * p1g;
                        valid = true; aoff = (unsigned)(TP + 16 * s + t) * FF + jf;
                        if (t >= 14) { float* o = out + O_CS + (unsigned)(((layer * 16 + s) * 2 + (t - 14)) * FF2 + jf); *(f32x4*)o = cv; *(f32x4*)(o + FF) = cg; }
                    } else {
                        { f32x2 v01 = conv_pair<0>(bv, wv0, wv1, wv2, cv, pv), v23 = conv_pair<2>(bv, wv0, wv1, wv2, cv, pv);
                          asm volatile("" : "+v"(v01), "+v"(v23));
                          const f32x2 g01 = conv_pair<0>(bg, wg0, wg1, wg2, cg, pg), g23 = conv_pair<2>(bg, wg0, wg1, wg2, cg, pg);
                          val = (f32x4){v01.x, v01.y, v23.x, v23.y}; gat = (f32x4){g01.x, g01.y, g23.x, g23.y}; }
                        const int j = 16 * m + fr, hs = 248 * u.pm + 62 * (2 * ai + wr) + j;
                        const int b = hs >= HSEQ ? 1 : 0, pos = hs - b * HSEQ - 2;
                        valid = (j >= 2) && (pos >= 0) && (hs < 2 * HSEQ);
                        aoff = (unsigned)(b * SEQ + pos) * FF + jf;
                        if (valid && pos >= SEQ - 2) { float* o = out + O_CP + (unsigned)(((layer * 2 + b) * 2 + (pos - (SEQ - 2))) * FF2 + jf); *(f32x4*)o = cv; *(f32x4*)(o + FF) = cg; }
                    }
                    if (valid) {
                        f32x4 a;
#pragma unroll
                        for (int e = 0; e < 4; ++e) a[e] = gat[e] * sigm(gat[e]) * val[e];
                        st_bf4(ACT + aoff, a);
                    }
                    SCHB;
                }
        }
    }
};

__device__ __forceinline__ int dstrow(int mode, int half, int n) { if (mode == 0) return n; const int j = n < half ? n : n - half; return 32 * (j >> 4) + (j & 15) + (n < half ? 0 : 16); }
__device__ __forceinline__ void transpose_item(const float* W, int K, int N, bf16* WT, int mode, int half, LAS float* scr, int item, int lane) {
    const int nblk = N / 32, kb = item / nblk, nb = item % nblk, k0 = 64 * kb, n0 = 32 * nb;
#pragma unroll 8
    for (int i = 0; i < 32; ++i) { const int kk = 2 * i + (lane >> 5); scr[kk * 33 + (lane & 31)] = W[(size_t)(k0 + kk) * N + n0 + (lane & 31)]; }
    asm volatile("s_waitcnt lgkmcnt(0)" ::: "memory");
    const int c = lane & 7;
#pragma unroll
    for (int j = 0; j < 4; ++j) { const int n = (lane >> 3) + 8 * j; const LAS float* s = scr + (8 * c) * 33 + n;
        u32x4 o; o.x = cvt_pk_bf16(s[0 * 33], s[1 * 33]); o.y = cvt_pk_bf16(s[2 * 33], s[3 * 33]); o.z = cvt_pk_bf16(s[4 * 33], s[5 * 33]); o.w = cvt_pk_bf16(s[6 * 33], s[7 * 33]);
        *(u32x4*)(WT + (size_t)dstrow(mode, half, n0 + n) * K + k0 + 8 * c) = o; }
    asm volatile("s_waitcnt lgkmcnt(0)" ::: "memory");
}
__device__ __forceinline__ void dsincos(double x, double& s, double& c) {
    const double k = rint(x * 0.15915494309189535);
    const double r = (x - k * 6.283185307179586) - k * 2.4492935982947064e-16;
    const double r2 = r * r;
    double ts = 1.0, tc = 1.0, ss = 1.0, cc = 1.0;
#pragma unroll
    for (int i = 1; i <= 13; ++i) { tc = -tc * r2 / (double)((2 * i - 1) * (2 * i)); cc += tc; ts = -ts * r2 / (double)((2 * i) * (2 * i + 1)); ss += ts; }
    s = ss * r; c = cc;
}
__device__ __forceinline__ void p0_prologue(const Params& p, LAS unsigned char* lds, int bid, int tid) {
    asm volatile("" : "+v"(tid));
    const int lane = tid & 63, wave = tid >> 6;
    float* mod = (float*)(p.ws + WS_MOD);
    if (bid < 192) {
        LAS float* sc = (LAS float*)lds;
        LAS float* part = (LAS float*)(lds + 81920);
        for (int idx = tid; idx < 18 * 1024; idx += NTHR) { const int bb = idx >> 10, d = idx & 1023;
            const float c = bb < 2 ? p.in[I_CP][bb * 1024 + d] : p.in[I_CS][(bb - 2) * 1024 + d]; sc[d * 20 + bb] = c / (1.0f + __expf(-c)); }
        __syncthreads();
        const int l = bid / 48, e0 = (bid % 48) * 128, col = tid & 127, dq = tid >> 7;
        float a[18];
#pragma unroll
        for (int i = 0; i < 18; ++i) a[i] = 0.f;
        const float* wp = p.in[I_ADAW] + ((size_t)l * 1024 + dq * 256) * NADA + e0 + col;
#pragma unroll 8
        for (int d = 0; d < 256; ++d) {
            const float w = wp[(size_t)d * NADA];
            const LAS f32x4* s4 = (const LAS f32x4*)(sc + (dq * 256 + d) * 20);
            const f32x4 s0 = s4[0], s1 = s4[1], s2 = s4[2], s3 = s4[3], s5 = s4[4];
            a[0] += w * s0.x; a[1] += w * s0.y; a[2] += w * s0.z; a[3] += w * s0.w; a[4] += w * s1.x; a[5] += w * s1.y; a[6] += w * s1.z; a[7] += w * s1.w;
            a[8] += w * s2.x; a[9] += w * s2.y; a[10] += w * s2.z; a[11] += w * s2.w; a[12] += w * s3.x; a[13] += w * s3.y; a[14] += w * s3.z; a[15] += w * s3.w;
            a[16] += w * s5.x; a[17] += w * s5.y;
        }
#pragma unroll
        for (int i = 0; i < 18; ++i) part[(dq * 128 + col) * 18 + i] = a[i];
        __syncthreads();
        for (int idx = tid; idx < 128 * 18; idx += NTHR) { const int c2 = idx & 127, bb = idx >> 7;
            const float v = part[(0 * 128 + c2) * 18 + bb] + part[(1 * 128 + c2) * 18 + bb] + part[(2 * 128 + c2) * 18 + bb] + part[(3 * 128 + c2) * 18 + bb] + p.in[I_ADAB][l * NADA + e0 + c2];
            mod[((size_t)l * 18 + bb) * NADA + e0 + c2] = v; }
        __syncthreads();
    }
    {
        float* rope = (float*)(p.ws + WS_ROPE);
        for (int idx = bid * NTHR + tid; idx < SEQ * 8; idx += NWG * NTHR) { const int pos = idx >> 3, i = idx & 7;
            const double f = i == 0 ? 1.0 : i == 1 ? 0.19392274474868576 : i == 2 ? 0.03760603093086393 : i == 3 ? 0.007292664737217109 : i == 4 ? 0.001414213562373095 : i == 5 ? 0.0002742481756762073 : i == 6 ? 5.318295896944988e-05 : 1.031338537721246e-05;
            double s, c; dsincos((double)pos * f, s, c); rope[pos * 16 + i] = (float)c; rope[pos * 16 + 8 + i] = (float)s; }
    }
    {
        LAS float* scr = (LAS float*)(lds + wave * 8704);
        constexpr int I_1 = 16 * 104, I_2 = 8 * 64, I_3 = 8 * 32, I_4 = 16 * 32, I_5 = 16 * 176, I_6 = 44 * 32, I_L = I_1 + I_2 + I_3 + I_4 + I_5 + I_6;
        const int gw = bid * 8 + wave;
        for (int it = gw; it < DEPTH * I_L; it += NWG * 8) {
            const int l = it / I_L; int r = it % I_L; unsigned char* wl = p.ws + WS_W + (size_t)l * W_L;
            if (r < I_1) { transpose_item(p.in[I_WIN] + (size_t)l * D * INC, D, INC, (bf16*)(wl + W_IN), 0, 0, scr, r, lane); continue; } r -= I_1;
            if (r < I_2) { transpose_item(p.in[I_WGLU] + (size_t)l * 512 * 2048, 512, 2048, (bf16*)(wl + W_GLU), 1, 1024, scr, r, lane); continue; } r -= I_2;
            if (r < I_3) { transpose_item(p.in[I_WO] + (size_t)l * 512 * 1024, 512, 1024, (bf16*)(wl + W_O), 0, 0, scr, r, lane); continue; } r -= I_3;
            if (r < I_4) { transpose_item(p.in[I_WOUT] + (size_t)l * D * D, D, D, (bf16*)(wl + W_OUT), 0, 0, scr, r, lane); continue; } r -= I_4;
            if (r < I_5) { transpose_item(p.in[I_WUP] + (size_t)l * D * FF2, D, FF2, (bf16*)(wl + W_UP), 1, FF, scr, r, lane); continue; } r -= I_5;
            transpose_item(p.in[I_WDN] + (size_t)l * FF * D, FF, D, (bf16*)(wl + W_DN), 0, 0, scr, r, lane);
        }
    }
}

__device__ __forceinline__ void norm_phase(const Params& p, int layer, int mode, int bid, int tid) {
    asm volatile("" : "+v"(tid));
    const int lane = tid & 63, wave = tid >> 6, gw = bid * 8 + wave;
    float* X = p.out; bf16* H = (bf16*)(p.ws + WS_H);
    const float* mod = (const float*)(p.ws + WS_MOD) + (size_t)layer * 18 * NADA;
    const float* gsrc = mode == 0 ? p.in[I_N1G] + layer * D : mode == 1 ? p.in[I_N2G] + layer * D : p.in[I_FG];
    f32x4 g[4];
#pragma unroll
    for (int j = 0; j < 4; ++j) g[j] = *(const f32x4*)(gsrc + 4 * lane + 256 * j);
    if (mode == 1 && gw < 4) { const int hs = (gw & 1) + (gw >> 1) * HSEQ; unsigned* o = (unsigned*)(H + (size_t)hs * D); unsigned zz = 0u; asm volatile("" : "+v"(zz));
#pragma unroll
        for (int j = 0; j < 8; ++j) o[lane + 64 * j] = zz; }
    for (int row = gw; row < MT; row += NWG * 8) {
        const float* xr = (mode == 0 && layer == 0) ? (row < TP ? p.in[I_XP] + (size_t)row * D : p.in[I_XS] + (size_t)(row - TP) * D) : X + (size_t)row * D;
        f32x4 v[4]; float s = 0.f;
#pragma unroll
        for (int j = 0; j < 4; ++j) { v[j] = *(const f32x4*)(xr + 4 * lane + 256 * j); s += (v[j].x * v[j].x + v[j].y * v[j].y) + (v[j].z * v[j].z + v[j].w * v[j].w); }
        const float rstd = 1.0f / sqrtf(wave_sum(s) * (1.0f / D) + 1e-6f);
        if (mode == 2) {
#pragma unroll
            for (int j = 0; j < 4; ++j) *(f32x4*)(X + (size_t)row * D + 4 * lane + 256 * j) = v[j] * rstd * g[j];
        } else {
            const float* mr = mod + (size_t)modrow_of(row) * NADA + (mode == 0 ? 0 : 3072);
            size_t hrow = row;
            if (mode == 1) hrow = row < TP ? (size_t)(row >> 14) * HSEQ + 2 + (row & (SEQ - 1)) : (size_t)HS_SAMPLE + (row - TP);
#pragma unroll
            for (int j = 0; j < 4; ++j) { const f32x4 sh = *(const f32x4*)(mr + 4 * lane + 256 * j), sc = *(const f32x4*)(mr + 1024 + 4 * lane + 256 * j);
                st_bf4(H + hrow * D + 4 * lane + 256 * j, (v[j] * rstd * g[j]) * (sc + 1.0f) + sh); }
        }
    }
}

struct SsmPar { float abr, abi; float bbr[16], bbi[16]; };
__device__ __forceinline__ void ssm_disc(const Params& p, int layer, int g, int lane, float& abr, float& abi, float& fr, float& fi) {
    const int gi = (layer * 32 + g) * 64 + lane;
    const float are = p.in[I_ARE][gi], aim = p.in[I_AIM][gi], dt = expf(p.in[I_LDT][layer * 32 + g]);
    const float mag = expf(are * dt); float sn, cs; sincosf(aim * dt, &sn, &cs);
    abr = mag * cs; abi = mag * sn;
    const float nr = abr - 1.0f, ni = abi, den = are * are + aim * aim;
    fr = (nr * are + ni * aim) / den; fi = (ni * are - nr * aim) / den;
}
__device__ __forceinline__ void ssm_task(const Params& p, int layer, int mode, int sq, int g, int chunk, int lane, LAS unsigned char* wl) {
    LAS float* ul = (LAS float*)wl;
    LAS bf16* Sl = (LAS bf16*)(wl + 4096);
    float abr, abi, fr, fi; ssm_disc(p, layer, g, lane, abr, abi, fr, fi);
    typedef float f32x2 __attribute__((ext_vector_type(2)));
    f32x2 bb[16];
    { const size_t bo = (((size_t)layer * 32 + g) * 64 + lane) * 16;
#pragma unroll
      for (int c4 = 0; c4 < 4; ++c4) { const f32x4 br = *(const f32x4*)(p.in[I_BRE] + bo + 4 * c4), bi = *(const f32x4*)(p.in[I_BIM] + bo + 4 * c4);
#pragma unroll
          for (int e = 0; e < 4; ++e) { bb[4 * c4 + e].x = fr * br[e] - fi * bi[e]; bb[4 * c4 + e].y = fr * bi[e] + fi * br[e]; } } }
    const bool cproj = mode != 0;
    const int g4 = lane >> 4, cl = lane & 15;
    bf16x8 cf[4];
    float dsk = 0.f;
    if (cproj) {
        const size_t co = (((size_t)layer * 32 + g) * 16 + cl) * 64;
#pragma unroll
        for (int ks = 0; ks < 4; ++ks) { const float* src = (ks < 2 ? p.in[I_CRE] : p.in[I_CIM]) + co + 32 * (ks & 1) + 8 * g4; const float sg = ks < 2 ? 1.0f : -1.0f;
            const f32x4 a = *(const f32x4*)src, b = *(const f32x4*)(src + 4);
            u32x4 o; o.x = cvt_pk_bf16(sg * a.x, sg * a.y); o.y = cvt_pk_bf16(sg * a.z, sg * a.w); o.z = cvt_pk_bf16(sg * b.x, sg * b.y); o.w = cvt_pk_bf16(sg * b.z, sg * b.w);
            cf[ks] = __builtin_bit_cast(bf16x8, o); }
        dsk = p.in[I_SD][layer * 512 + g * 16 + cl];
    }
    const int nsteps = mode == 1 ? 16 : 64;
    const size_t r0 = mode == 1 ? (size_t)TP + sq * 16 : (size_t)sq * SEQ + chunk * 64;
    const float* U = (const float*)(p.ws + WS_U);
#pragma unroll
    for (int i = 0; i < 4; ++i) { const int idx = lane + 64 * i; if (idx < nsteps * 4) { const int t = idx >> 2, c4 = idx & 3; *(LAS f32x4*)(ul + t * 16 + 4 * c4) = *(const f32x4*)(U + (r0 + t) * 512 + g * 16 + 4 * c4); } }
    float sr = 0.f, si = 0.f;
    float* CH = (float*)(p.ws + WS_CH);
    const size_t cho = (((size_t)(sq * 32 + g)) * 256 + chunk) * 128;
    if (mode == 1) { const size_t so = (((size_t)layer * 16 + sq) * 32 + g) * 64 + lane; sr = p.in[I_SRE][so]; si = p.in[I_SIM][so]; }
    else if (mode == 2) { sr = CH[cho + lane]; si = CH[cho + 64 + lane]; }
    asm volatile("s_waitcnt vmcnt(0) lgkmcnt(0)" ::: "memory"); __builtin_amdgcn_wave_barrier();
    bf16* Yg = (bf16*)(p.ws + WS_YG);
    for (int hh = 0; hh * 32 < nsteps; ++hh) {
        const int ns = nsteps - hh * 32 < 32 ? nsteps - hh * 32 : 32;
#pragma unroll 4
        for (int t = 0; t < ns; ++t) {
            const LAS f32x4* up = (const LAS f32x4*)(ul + (hh * 32 + t) * 16);
            const f32x4 u0 = up[0], u1 = up[1], u2 = up[2], u3 = up[3];
            f32x2 xa = (f32x2){0.f, 0.f}, xb = (f32x2){0.f, 0.f};
#pragma unroll
            for (int e = 0; e < 4; ++e) { xa = bb[e] * (f32x2){u0[e], u0[e]} + xa; xb = bb[4 + e] * (f32x2){u1[e], u1[e]} + xb; }
#pragma unroll
            for (int e = 0; e < 4; ++e) { xa = bb[8 + e] * (f32x2){u2[e], u2[e]} + xa; xb = bb[12 + e] * (f32x2){u3[e], u3[e]} + xb; }
            const float xr = xa.x + xb.x, xi = xa.y + xb.y;
            const float nsr = fmaf(abr, sr, fmaf(-abi, si, xr)), nsi = fmaf(abr, si, fmaf(abi, sr, xi));
            sr = nsr; si = nsi;
            if (cproj) { Sl[t * 136 + lane] = (bf16)f2bf(sr); Sl[t * 136 + 64 + lane] = (bf16)f2bf(si); }
        }
        if (cproj) {
            asm volatile("s_waitcnt lgkmcnt(0)" ::: "memory"); __builtin_amdgcn_wave_barrier();
#pragma unroll
            for (int mt = 0; mt < 2; ++mt) {
                f32x4 ya = (f32x4){0.f, 0.f, 0.f, 0.f};
#pragma unroll
                for (int ks = 0; ks < 4; ++ks) { const bf16x8 a = *(const LAS bf16x8*)(Sl + (16 * mt + cl) * 136 + 32 * ks + 8 * g4); ya = __builtin_amdgcn_mfma_f32_16x16x32_bf16(a, cf[ks], ya, 0, 0, 0); }
#pragma unroll
                for (int i = 0; i < 4; ++i) { const int t = 16 * mt + 4 * g4 + i;
                    if (t < ns) { const float y = ya[i] + dsk * ul[(hh * 32 + t) * 16 + cl]; Yg[(r0 + hh * 32 + t) * 512 + g * 16 + cl] = (bf16)f2bf(gelu_tanh(y)); } }
            }
            asm volatile("s_waitcnt lgkmcnt(0)" ::: "memory"); __builtin_amdgcn_wave_barrier();
        }
    }
    if (mode == 0) { CH[cho + lane] = sr; CH[cho + 64 + lane] = si; }
    else if (mode == 1) { const size_t so = (((size_t)layer * 16 + sq) * 32 + g) * 64 + lane; p.out[O_SRS + so] = sr; p.out[O_SIS + so] = si; }
    else if (chunk == 255) { const size_t so = (((size_t)layer * 2 + sq) * 32 + g) * 64 + lane; p.out[O_SRP + so] = sr; p.out[O_SIP + so] = si; }
    asm volatile("s_waitcnt lgkmcnt(0)" ::: "memory"); __builtin_amdgcn_wave_barrier();
}
__device__ __forceinline__ void split_hl(f32x4 a, f32x4 c, u32x4& hi, u32x4& lo) {
    hi.x = cvt_pk_bf16(a.x, a.y); hi.y = cvt_pk_bf16(a.z, a.w); hi.z = cvt_pk_bf16(c.x, c.y); hi.w = cvt_pk_bf16(c.z, c.w);
    lo.x = cvt_pk_bf16(a.x - __uint_as_float(hi.x << 16), a.y - __uint_as_float(hi.x & 0xffff0000u)); lo.y = cvt_pk_bf16(a.z - __uint_as_float(hi.y << 16), a.w - __uint_as_float(hi.y & 0xffff0000u));
    lo.z = cvt_pk_bf16(c.x - __uint_as_float(hi.z << 16), c.y - __uint_as_float(hi.z & 0xffff0000u)); lo.w = cvt_pk_bf16(c.z - __uint_as_float(hi.w << 16), c.w - __uint_as_float(hi.w & 0xffff0000u));
}
__device__ __forceinline__ void ssm_task_v2(const Params& p, int layer, int mode, int sq, int g, int chunk0, int nchunk, int cstride, int lane, LAS unsigned char* wl) {
    LAS float* Xl = (LAS float*)wl;
    LAS bf16* Sl = (LAS bf16*)(wl + 8448);
    const int g4 = lane >> 4, cl = lane & 15;
    float abr, abi, fr, fi; ssm_disc(p, layer, g, lane, abr, abi, fr, fi);
    bf16x8 bfr[8];
    const int gg = g4 & 1;
#pragma unroll
    for (int q = 0; q < 4; ++q) {
        const int st = 16 * q + cl;
        const float frs = __shfl(fr, st), fis = __shfl(fi, st);
        const size_t bo = (((size_t)layer * 32 + g) * 64 + st) * 16 + 8 * gg;
        const f32x4 r0 = *(const f32x4*)(p.in[I_BRE] + bo), r1 = *(const f32x4*)(p.in[I_BRE] + bo + 4), i0 = *(const f32x4*)(p.in[I_BIM] + bo), i1 = *(const f32x4*)(p.in[I_BIM] + bo + 4);
        const f32x4 a0 = frs * r0 - fis * i0, a1 = frs * r1 - fis * i1, c0 = frs * i0 + fis * r0, c1 = frs * i1 + fis * r1;
        u32x4 hre, him;
        hre.x = cvt_pk_bf16(a0.x, a0.y); hre.y = cvt_pk_bf16(a0.z, a0.w); hre.z = cvt_pk_bf16(a1.x, a1.y); hre.w = cvt_pk_bf16(a1.z, a1.w);
        him.x = cvt_pk_bf16(c0.x, c0.y); him.y = cvt_pk_bf16(c0.z, c0.w); him.z = cvt_pk_bf16(c1.x, c1.y); him.w = cvt_pk_bf16(c1.z, c1.w);
        if (g4 >= 2) { hre = (u32x4){0u, 0u, 0u, 0u}; him = hre; }
        bfr[q] = __builtin_bit_cast(bf16x8, hre); bfr[4 + q] = __builtin_bit_cast(bf16x8, him);
    }
    const bool cproj = mode != 0;
    bf16x8 cf[4];
    float dsk = 0.f;
    if (cproj) {
        const size_t co = (((size_t)layer * 32 + g) * 16 + cl) * 64;
#pragma unroll
        for (int ks = 0; ks < 4; ++ks) { const float* src = (ks < 2 ? p.in[I_CRE] : p.in[I_CIM]) + co + 32 * (ks & 1) + 8 * g4; const float sg = ks < 2 ? 1.0f : -1.0f;
            const f32x4 a = *(const f32x4*)src, c = *(const f32x4*)(src + 4);
            u32x4 o; o.x = cvt_pk_bf16(sg * a.x, sg * a.y); o.y = cvt_pk_bf16(sg * a.z, sg * a.w); o.z = cvt_pk_bf16(sg * c.x, sg * c.y); o.w = cvt_pk_bf16(sg * c.z, sg * c.w);
            cf[ks] = __builtin_bit_cast(bf16x8, o); }
        dsk = p.in[I_SD][layer * 512 + g * 16 + cl];
    }
    const int nblk = mode == 1 ? 1 : 4;
    bf16* Yg = (bf16*)(p.ws + WS_YG);
    const bf16* U = (const bf16*)(p.ws + WS_U);
    float* CH = (float*)(p.ws + WS_CH);
    for (int ci = 0; ci < nchunk; ++ci) {
    const int chunk = chunk0 + ci * cstride;
    const unsigned r0 = mode == 1 ? (unsigned)(TP + sq * 16) : (unsigned)(sq * SEQ + chunk * 64);
    float sr = 0.f, si = 0.f;
    const size_t cho = (((size_t)(sq * 32 + g)) * 256 + chunk) * 128;
    if (mode == 1) { const size_t so = (((size_t)layer * 16 + sq) * 32 + g) * 64 + lane; sr = p.in[I_SRE][so]; si = p.in[I_SIM][so]; }
    else if (mode == 2) { sr = CH[cho + lane]; si = CH[cho + 64 + lane]; }
    u32x4 ulq[4];
#pragma unroll
    for (int blk = 0; blk < 4; ++blk) if (blk < nblk) {
        ulq[blk] = *(const u32x4*)(U + (r0 + 16 * blk + cl) * 512u + g * 16 + 8 * gg);
    }
#pragma unroll
    for (int blk = 0; blk < 4; ++blk) if (blk < nblk) {
        u32x4 ua;
        ua = g4 < 2 ? ulq[blk] : (u32x4){0u, 0u, 0u, 0u};
        float ud[4];
        if (cproj) {
#pragma unroll
            for (int i = 0; i < 4; ++i) ud[i] = bf2f(U[(r0 + 16 * blk + 4 * g4 + i) * 512u + g * 16 + cl]);
        }
        const bf16x8 uf = __builtin_bit_cast(bf16x8, ua);
        f32x4 xs[8];
#pragma unroll
        for (int nt = 0; nt < 8; ++nt) {
            xs[nt] = __builtin_amdgcn_mfma_f32_16x16x32_bf16(uf, bfr[nt], (f32x4){0.f, 0.f, 0.f, 0.f}, 0, 0, 0);
        }
        __builtin_amdgcn_sched_barrier(0); asm volatile("s_nop 15\n\ts_nop 15" ::: "memory"); __builtin_amdgcn_sched_barrier(0);
#pragma unroll
        for (int nt = 0; nt < 8; ++nt) {
#pragma unroll
            for (int i = 0; i < 4; ++i) Xl[(4 * g4 + i) * 132 + 16 * nt + cl] = xs[nt][i];
        }
        asm volatile("s_waitcnt lgkmcnt(0)" ::: "memory"); __builtin_amdgcn_wave_barrier();
        float xrv[16], xiv[16];
#pragma unroll
        for (int t = 0; t < 16; ++t) { xrv[t] = Xl[t * 132 + lane]; xiv[t] = Xl[t * 132 + 64 + lane]; }
        asm volatile("s_waitcnt lgkmcnt(0)" ::: "memory");
#pragma unroll
        for (int t = 0; t < 16; ++t) {
            const float nsr = fmaf(abr, sr, fmaf(-abi, si, xrv[t])), nsi = fmaf(abr, si, fmaf(abi, sr, xiv[t]));
            sr = nsr; si = nsi;
            if (cproj) { const unsigned pk = cvt_pk_bf16(sr, si); Sl[t * 136 + lane] = (bf16)(pk & 0xffffu); Sl[t * 136 + 64 + lane] = (bf16)(pk >> 16); }
        }
        if (cproj) {
            asm volatile("s_waitcnt lgkmcnt(0)" ::: "memory"); __builtin_amdgcn_wave_barrier();
            f32x4 ya = (f32x4){0.f, 0.f, 0.f, 0.f};
#pragma unroll
            for (int ks = 0; ks < 4; ++ks) { const bf16x8 a = *(const LAS bf16x8*)(Sl + cl * 136 + 32 * ks + 8 * g4); ya = __builtin_amdgcn_mfma_f32_16x16x32_bf16(a, cf[ks], ya, 0, 0, 0); }
#pragma unroll
            for (int i = 0; i < 4; ++i) { const float y = ya[i] + dsk * ud[i]; Yg[(r0 + 16 * blk + 4 * g4 + i) * 512u + g * 16 + cl] = (bf16)f2bf(gelu_tanh(y)); }
        }
        asm volatile("s_waitcnt lgkmcnt(0)" ::: "memory"); __builtin_amdgcn_wave_barrier();
    }
    if (mode == 0) { CH[cho + lane] = sr; CH[cho + 64 + lane] = si; }
    else if (mode == 1) { const size_t so = (((size_t)layer * 16 + sq) * 32 + g) * 64 + lane; p.out[O_SRS + so] = sr; p.out[O_SIS + so] = si; }
    else if (chunk == 255) { const size_t so = (((size_t)layer * 2 + sq) * 32 + g) * 64 + lane; p.out[O_SRP + so] = sr; p.out[O_SIP + so] = si; }
    }
}
__device__ __forceinline__ void ssm_phase(const Params& p, int layer, int pass3, LAS unsigned char* lds, int bid, int tid) {
    asm volatile("" : "+v"(tid));
    const int lane = tid & 63, wave = tid >> 6; LAS unsigned char* wl = lds + wave * 12800;
    const int gw = bid * 8 + wave;
    { const int sqg = gw >> 5; ssm_task_v2(p, layer, pass3 ? 2 : 0, sqg >> 5, sqg & 31, gw & 31, 8, 32, lane, wl); }
    if (!pass3 && gw >= 1536) { const int sg = gw - 1536; ssm_task_v2(p, layer, 1, sg >> 5, sg & 31, 0, 1, 1, lane, wl); }
}
__device__ __forceinline__ void carry_phase(const Params& p, int layer, int bid, int tid) {
    asm volatile("" : "+v"(tid));
    const int lane = tid & 63, wave = tid >> 6, gw = bid * 8 + wave;
    if (gw >= 64) return;
    float abr, abi, fr, fi; ssm_disc(p, layer, gw & 31, lane, abr, abi, fr, fi);
    float ar = abr, ai = abi;
#pragma unroll
    for (int i = 0; i < 6; ++i) { const float nr = ar * ar - ai * ai, ni = 2.0f * ar * ai; ar = nr; ai = ni; }
    float* CH = (float*)(p.ws + WS_CH) + (size_t)gw * 256 * 128;
    float cr = 0.f, ci = 0.f;
    for (int c0 = 0; c0 < 256; c0 += 32) {
        float fr8[32], fi8[32];
#pragma unroll
        for (int j = 0; j < 32; ++j) { fr8[j] = CH[(c0 + j) * 128 + lane]; fi8[j] = CH[(c0 + j) * 128 + 64 + lane]; }
#pragma unroll
        for (int j = 0; j < 32; ++j) { CH[(c0 + j) * 128 + lane] = cr; CH[(c0 + j) * 128 + 64 + lane] = ci;
            const float nr = fmaf(ar, cr, fmaf(-ai, ci, fr8[j])), ni = fmaf(ar, ci, fmaf(ai, cr, fi8[j])); cr = nr; ci = ni; }
    }
}

__device__ __forceinline__ void attn_phase(const Params& p, int layer, LAS unsigned char* lds, int bid, int tid) {
    asm volatile("" : "+v"(tid));
    const int lane = tid & 63, wave = tid >> 6, g4 = lane >> 4, cl = lane & 15;
    LAS bf16* Kl = (LAS bf16*)lds;
    LAS bf16* Vt = (LAS bf16*)(lds + 27648);
    const bf16* Qb = (const bf16*)(p.ws + WS_Q); const bf16* Kb = (const bf16*)(p.ws + WS_K); const bf16* Vb = (const bf16*)(p.ws + WS_V);
    bf16* Ob = (bf16*)(p.ws + WS_O);
    u32x4 pk[3], pv[3];
#define ATT_LOAD(TKX) do { const int tk_ = (TKX); const bool smp_ = tk_ >= 1024; \
        const int b_ = smp_ ? (tk_ - 1024) >> 1 : tk_ >> 9, n_ = smp_ ? 0 : (tk_ >> 1) & 255, kvh_ = tk_ & 1; \
        _Pragma("unroll") for (int i = 0; i < 3; ++i) { \
            const int idx = tid + NTHR * i, key = idx >> 3, c8 = idx & 7; \
            u32x4 kv = (u32x4){0u, 0u, 0u, 0u}, vv = (u32x4){0u, 0u, 0u, 0u}; \
            if (!smp_) { \
                const int pos = 64 * (n_ - 2) + key; \
                if (pos >= 0) { const size_t o = ((size_t)b_ * SEQ + pos) * 128 + kvh_ * 64 + 8 * c8; kv = *(const u32x4*)(Kb + o); vv = *(const u32x4*)(Vb + o); } \
            } else if (key < 128) { \
                const size_t o = ((((size_t)layer * 16 + b_) * 128 + key) * 2 + kvh_) * 64 + 8 * c8; \
                const f32x4 k0 = *(const f32x4*)(p.in[I_CK] + o), k1 = *(const f32x4*)(p.in[I_CK] + o + 4), v0 = *(const f32x4*)(p.in[I_CV] + o), v1 = *(const f32x4*)(p.in[I_CV] + o + 4); \
                kv.x = cvt_pk_bf16(k0.x, k0.y); kv.y = cvt_pk_bf16(k0.z, k0.w); kv.z = cvt_pk_bf16(k1.x, k1.y); kv.w = cvt_pk_bf16(k1.z, k1.w); \
                vv.x = cvt_pk_bf16(v0.x, v0.y); vv.y = cvt_pk_bf16(v0.z, v0.w); vv.z = cvt_pk_bf16(v1.x, v1.y); vv.w = cvt_pk_bf16(v1.z, v1.w); \
            } else if (key < 144) { \
                const size_t o = ((size_t)TP + b_ * 16 + (key - 128)) * 128 + kvh_ * 64 + 8 * c8; kv = *(const u32x4*)(Kb + o); vv = *(const u32x4*)(Vb + o); \
            } \
            pk[i] = kv; pv[i] = vv; } } while (0)
    ATT_LOAD(bid);
    for (int tk = bid; tk < 1024 + 32; tk += NWG) {
        const bool smp = tk >= 1024;
        const int b = smp ? (tk - 1024) >> 1 : tk >> 9, n = smp ? 0 : (tk >> 1) & 255, kvh = tk & 1;
        __syncthreads();
#pragma unroll
        for (int i = 0; i < 3; ++i) {
            const int idx = tid + NTHR * i, key = idx >> 3, c8 = idx & 7;
            const u32x4 kv = pk[i], vv = pv[i];
            *(LAS u32x4*)(Kl + key * 72 + 8 * c8) = kv;
            LAS bf16* vd = Vt + (8 * c8) * 200 + key;
            vd[0] = (bf16)(vv.x & 0xffffu); vd[200] = (bf16)(vv.x >> 16); vd[400] = (bf16)(vv.y & 0xffffu); vd[600] = (bf16)(vv.y >> 16);
            vd[800] = (bf16)(vv.z & 0xffffu); vd[1000] = (bf16)(vv.z >> 16); vd[1200] = (bf16)(vv.w & 0xffffu); vd[1400] = (bf16)(vv.w >> 16);
        }
        __syncthreads();
        if (tk + NWG < 1024 + 32) ATT_LOAD(tk + NWG);
        const int gh = wave & 3, qh = wave >> 2, h = kvh * 4 + gh;
        if (smp && qh == 1) continue;
        const int nq = smp ? 16 : 32;
        const size_t qrow0 = smp ? (size_t)TP + b * 16 : (size_t)b * SEQ + 64 * n + 32 * qh;
        bf16x8 qf[2][2];
#pragma unroll
        for (int nt = 0; nt < 2; ++nt) { int qi = 16 * nt + cl; if (qi >= nq) qi = nq - 1;
#pragma unroll
            for (int ks = 0; ks < 2; ++ks) qf[nt][ks] = *(const bf16x8*)(Qb + (qrow0 + qi) * 512 + h * 64 + 32 * ks + 8 * g4); }
        f32x4 s[12][2];
#pragma unroll
        for (int mt = 0; mt < 12; ++mt) {
            s[mt][0] = (f32x4){0.f, 0.f, 0.f, 0.f}; s[mt][1] = (f32x4){0.f, 0.f, 0.f, 0.f};
#pragma unroll
            for (int ks = 0; ks < 2; ++ks) { const bf16x8 a = *(const LAS bf16x8*)(Kl + (16 * mt + cl) * 72 + 32 * ks + 8 * g4);
                s[mt][0] = __builtin_amdgcn_mfma_f32_16x16x32_bf16(a, qf[0][ks], s[mt][0], 0, 0, 0);
                s[mt][1] = __builtin_amdgcn_mfma_f32_16x16x32_bf16(a, qf[1][ks], s[mt][1], 0, 0, 0); }
            const bool valid = smp ? (mt < 9) : (n - 2 + (mt >> 2) >= 0);
            if (!valid) { s[mt][0] = (f32x4){-1e30f, -1e30f, -1e30f, -1e30f}; s[mt][1] = s[mt][0]; }
        }
        const float sink = p.in[I_SINK][layer * 8 + h];
        float inv[2];
#pragma unroll
        for (int nt = 0; nt < 2; ++nt) {
            float mx = sink;
#pragma unroll
            for (int mt = 0; mt < 12; ++mt) mx = fmaxf(mx, fmaxf(fmaxf(s[mt][nt].x, s[mt][nt].y), fmaxf(s[mt][nt].z, s[mt][nt].w)));
            mx = fmaxf(mx, __shfl_xor(mx, 16)); mx = fmaxf(mx, __shfl_xor(mx, 32));
            float sum = 0.f;
#pragma unroll
            for (int mt = 0; mt < 12; ++mt) {
#pragma unroll
                for (int e = 0; e < 4; ++e) { const float pe = __expf(s[mt][nt][e] - mx); s[mt][nt][e] = pe; sum += pe; } }
            sum += __shfl_xor(sum, 16); sum += __shfl_xor(sum, 32);
            inv[nt] = 1.0f / (sum + __expf(sink - mx));
        }
        f32x4 o[4][2];
#pragma unroll
        for (int dt = 0; dt < 4; ++dt) { o[dt][0] = (f32x4){0.f, 0.f, 0.f, 0.f}; o[dt][1] = (f32x4){0.f, 0.f, 0.f, 0.f}; }
#pragma unroll
        for (int ks = 0; ks < 6; ++ks) {
            bf16x8 pf[2];
#pragma unroll
            for (int nt = 0; nt < 2; ++nt) { u32x4 t; t.x = cvt_pk_bf16(s[2 * ks][nt].x, s[2 * ks][nt].y); t.y = cvt_pk_bf16(s[2 * ks][nt].z, s[2 * ks][nt].w);
                t.z = cvt_pk_bf16(s[2 * ks + 1][nt].x, s[2 * ks + 1][nt].y); t.w = cvt_pk_bf16(s[2 * ks + 1][nt].z, s[2 * ks + 1][nt].w); pf[nt] = __builtin_bit_cast(bf16x8, t); }
#pragma unroll
            for (int dt = 0; dt < 4; ++dt) {
                const LAS bf16* vp = Vt + (16 * dt + cl) * 200 + 32 * ks + 4 * g4;
                const u32x2 lo = *(const LAS u32x2*)vp, hi = *(const LAS u32x2*)(vp + 16);
                const bf16x8 a = __builtin_bit_cast(bf16x8, (u32x4){lo.x, lo.y, hi.x, hi.y});
                o[dt][0] = __builtin_amdgcn_mfma_f32_16x16x32_bf16(a, pf[0], o[dt][0], 0, 0, 0);
                o[dt][1] = __builtin_amdgcn_mfma_f32_16x16x32_bf16(a, pf[1], o[dt][1], 0, 0, 0);
            }
        }
#pragma unroll
        for (int nt = 0; nt < 2; ++nt) { const int qi = 16 * nt + cl;
            if (qi < nq) {
#pragma unroll
                for (int dt = 0; dt < 4; ++dt) st_bf4(Ob + (qrow0 + qi) * 512 + h * 64 + 16 * dt + 4 * g4, o[dt][nt] * inv[nt]); } }
    }
    __syncthreads();
}

__global__ void __launch_bounds__(512, 2) fwd(Params p) {
    extern __shared__ __attribute__((aligned(16))) unsigned char lds_raw[];
    LAS unsigned char* lds = (LAS unsigned char*)lds_raw;
    cg::grid_group grid = cg::this_grid();
    const int bid = blockIdx.x, tid = threadIdx.x, G = gridDim.x;
    unsigned char* ws = p.ws;
    float* X = p.out;
    bf16* H = (bf16*)(ws + WS_H);
    const float* modall = (const float*)(ws + WS_MOD);
    if (tid < 16) ((volatile LAS unsigned*)(lds + MISC_OFF))[tid] = 0u;
    __syncthreads();
    const xb::XcdBarrier bar = xb::xcd_barrier_post((unsigned*)(ws + WS_BAR), (volatile LAS unsigned*)(lds + MISC_OFF));
#define GSYNC() xb::xcd_barrier(bar)

#if !defined(ONLY) || ONLY == 0
    REPK(10) { p0_prologue(p, lds, bid, tid); if (PROBE == 10) { asm volatile("s_waitcnt vmcnt(0) lgkmcnt(0)" ::: "memory"); __syncthreads(); } }
    if (PROBE == 7 || PROBE == 8) { float* zr = (float*)(ws + WS_ZERO); for (int i = bid * NTHR + tid; i < 18 * NADA; i += NWG * NTHR) zr[i] = 0.f; }
#endif
    grid.sync();
    for (int layer = 0; layer < DEPTH; ++layer) {
        unsigned char* wl = ws + WS_W + (size_t)layer * W_L;
        const float* modl = modall + (size_t)layer * 18 * NADA;
#if !defined(ONLY) || ONLY == 1
        REPK(4) norm_phase(p, layer, 0, bid, tid);
#endif
        GSYNC();
#if !defined(ONLY) || ONLY == 2
        REPK(1) { Gemm g{H, (const bf16*)(wl + W_IN), MT, INC, D}; StaticOrder S; S.init(MT, INC, G, bid);
          EpiWin E{(bf16*)(ws + WS_U), (bf16*)(ws + WS_Q), (bf16*)(ws + WS_K), (bf16*)(ws + WS_V), (bf16*)(ws + WS_G), (const float*)(ws + WS_ROPE), p.out, layer};
          pg8::gemm_phase<EpiWin, StaticOrder, 0>(lds, g, S, E, nullptr); }
        GSYNC();
#endif
#if !defined(ONLY) || ONLY == 3
        REPK(2) ssm_phase(p, layer, 0, lds, bid, tid);
#endif
#if !defined(ONLY) || ONLY == 4
        REPK(3) attn_phase(p, layer, lds, bid, tid);
#endif
        GSYNC();
#if !defined(ONLY) || ONLY == 5
        carry_phase(p, layer, bid, tid);
        REPK(9) { Gemm g{(const bf16*)(ws + WS_O), (const bf16*)(wl + W_O), TP, D, 512}; StaticOrder S; S.init(TP, D, G, bid);
          EpiAttnO E{(const bf16*)(ws + WS_G), (bf16*)(ws + WS_P)};
          pg8::gemm_phase<EpiAttnO, StaticOrder, 0>(lds, g, S, E, nullptr);
          small_gemm<4>(g.A + (size_t)TP * 512, g.Bt, D, 512, TP, E, lds, bid, tid); }
        GSYNC();
#endif
#if !defined(ONLY) || ONLY == 3
        REPK(2) ssm_phase(p, layer, 1, lds, bid, tid);
#endif
        GSYNC();
#if !defined(ONLY) || ONLY == 6
        { Gemm g{(const bf16*)(ws + WS_YG), (const bf16*)(wl + W_GLU), TP, 2048, 512}; StaticOrder S; S.init(TP, 2048, G, bid);
          EpiGlu E{(const bf16*)(ws + WS_G), (bf16*)(ws + WS_P)};
          pg8::gemm_phase<EpiGlu, StaticOrder, 0>(lds, g, S, E, nullptr);
          small_gemm<2>(g.A + (size_t)TP * 512, g.Bt, 2048, 512, TP, E, lds, bid, tid); }
        GSYNC();
#endif
#if !defined(ONLY) || ONLY == 7
        { Gemm g{(const bf16*)(ws + WS_P), (const bf16*)(wl + W_OUT), TP, D, D}; StaticOrder S; S.init(TP, D, G, bid);
          EpiRes E{layer == 0 ? p.in[I_XP] : X, X, modl + 2048};
          pg8::gemm_phase<EpiRes, StaticOrder, 0>(lds, g, S, E, nullptr);
          EpiRes Es{layer == 0 ? p.in[I_XS] - (size_t)TP * D : X, X, modl + 2048};
          small_gemm<4>(g.A + (size_t)TP * D, g.Bt, D, D, TP, Es, lds, bid, tid); }
        GSYNC();
#endif
#if !defined(ONLY) || ONLY == 1
        REPK(4) norm_phase(p, layer, 1, bid, tid);
#endif
        GSYNC();
#if !defined(ONLY) || ONLY == 9
        REPK(5) { Gemm g{H, (const bf16*)(wl + W_UP), UP_TILES * 256, FF2, D}; StaticOrder S; S.init(UP_TILES * 256, FF2, G, bid);
          EpiUp<false> E{(bf16*)(ws + WS_ACT), p.in[I_CW] + (size_t)layer * 3 * FF2, p.in[I_CB] + (size_t)layer * FF2, nullptr, p.out, layer};
          pg8::gemm_phase<EpiUp<false>, StaticOrder, 1>(lds, g, S, E, nullptr); }
        { Gemm g{H + (size_t)HS_SAMPLE * D, (const bf16*)(wl + W_UP), 256, FF2, D}; StaticOrder S; S.init(256, FF2, G, G - 1 - bid);
          EpiUp<true> E{(bf16*)(ws + WS_ACT), p.in[I_CW] + (size_t)layer * 3 * FF2, p.in[I_CB] + (size_t)layer * FF2, p.in[I_SCONV] + (size_t)layer * 16 * 2 * FF2, p.out, layer};
          pg8::gemm_phase<EpiUp<true>, StaticOrder, 0>(lds, g, S, E, nullptr); }
        GSYNC();
#endif
        if (PROBE == 6) { for (int i_ = 0; i_ < 10; ++i_) GSYNC(); }
#if !defined(ONLY) || ONLY == 10
        { Gemm g{(const bf16*)(ws + WS_ACT), (const bf16*)(wl + W_DN), TP, D, FF}; StaticOrder S; S.init(TP, D, G, bid);
          EpiRes E{X, X, modl + 5120};
          pg8::gemm_phase<EpiRes, StaticOrder, 0>(lds, g, S, E, nullptr);
          small_gemm<4>(g.A + (size_t)TP * FF, g.Bt, D, FF, TP, E, lds, bid, tid); }
#endif
        GSYNC();
    }
#if !defined(ONLY) || ONLY == 1
    norm_phase(p, 0, 2, bid, tid);
#endif
}
}

extern "C" void kernel_launch(void* const* d_in, const int* in_sizes, int n_in, void* d_out, int out_size, void* d_ws, size_t ws_size, hipStream_t stream) {
    static int ok = 0;
    if (ok == 0) {
        ok = 1;
        if (n_in != 31 || (size_t)out_size != mk::O_END || ws_size < mk::WS_BAR + mk::BAR_BYTES) { fprintf(stderr, "kernel_launch: unexpected shapes n_in %d out %d ws %zu (need %zu)\n", n_in, out_size, ws_size, (size_t)mk::WS_END); ok = -1; }
        if (hipFuncSetAttribute((const void*)mk::fwd, hipFuncAttributeMaxDynamicSharedMemorySize, mk::LDS_BYTES) != hipSuccess) { fprintf(stderr, "kernel_launch: hipFuncSetAttribute failed\n"); ok = -1; }
        int per_cu = 0;
        if (hipOccupancyMaxActiveBlocksPerMultiprocessor(&per_cu, (const void*)mk::fwd, mk::NTHR, mk::LDS_BYTES) != hipSuccess || per_cu < 1) fprintf(stderr, "kernel_launch: occupancy query says %d blocks per CU\n", per_cu);
        (void)hipGetLastError();
    }
    if (ok < 0) return;
    if (hipMemsetAsync((char*)d_ws + mk::WS_BAR, 0, mk::BAR_BYTES, stream) != hipSuccess) { fprintf(stderr, "kernel_launch: memset of the barrier words failed\n"); return; }
    mk::Params p{};
    for (int i = 0; i < 31; ++i) p.in[i] = (const float*)d_in[i];
    p.out = (float*)d_out; p.ws = (unsigned char*)d_ws;
    void* args[] = {&p};
    hipError_t e = hipLaunchCooperativeKernel((void*)mk::fwd, dim3(mk::NWG), dim3(mk::NTHR), args, mk::LDS_BYTES, stream);
    if (e != hipSuccess) fprintf(stderr, "kernel_launch: cooperative launch failed: %s\n", hipGetErrorString(e));
}
```

```cpp
#include <hip/hip_runtime.h>
#include <hip/hip_cooperative_groups.h>
#include <cstdio>
#include <cstdint>
namespace cg = cooperative_groups;
namespace pg8 {
#define PG8_LAS __attribute__((address_space(3)))
typedef unsigned short bf16_t;
typedef short bf16x8 __attribute__((ext_vector_type(8)));
typedef float f32x4 __attribute__((ext_vector_type(4)));
typedef unsigned u32x4 __attribute__((ext_vector_type(4)));
constexpr int BM = 256, BK = 64, HALF = 128, HTB = HALF * BK * 2  , STAGE_BYTES = 8 * HTB, NXCD = 8, WGM = 8;

__host__ __device__ __forceinline__ int lds_byte(int r, int c) { const int st = (r >> 4) * 2 + (c >> 5), rr = r & 15, cc = c & 31, ob = rr * 64 + cc * 2; return st * 1024 + (ob ^ (((ob >> 9) & 1) << 5)); }
__host__ __device__ __forceinline__ void stage_rc(int b, int& R, int& C) { const int st = b / 1024, sb = b % 1024, swz = sb ^ (((sb >> 9) & 1) << 5); R = (st >> 1) * 16 + swz / 64; C = (st & 1) * 32 + (swz % 64) / 2; }
__host__ __device__ __forceinline__ int perm32(int rho) { const int n = rho >> 4, i = rho & 15; return 8 * (i >> 2) + 4 * n + (i & 3); }

struct Unit { int pm, pn; };
struct Gemm { const bf16_t* A; const bf16_t* Bt; int M, N, K; };
struct StaticOrder {
    int nM, nN, nwg, G, c;
    __host__ __device__ void init(int M, int N, int G_, int c_) { nM = M / BM; nN = N / BM; nwg = nM * nN; G = G_; c = c_; }
    __host__ __device__ bool next(int i, Unit& u) const {
        const long L = (long)i * G + c; if (L >= nwg) return false;
        int wgid = (int)L; { const int q = nwg / NXCD, r = nwg % NXCD, xcd = wgid % NXCD, off = wgid / NXCD; wgid = (xcd < r ? xcd * (q + 1) : r * (q + 1) + (xcd - r) * q) + off; }
        const int nig = WGM * nN, gid = wgid / nig, fm = gid * WGM, gsz = (nM - fm) < WGM ? (nM - fm) : WGM;
        u.pm = fm + ((wgid % nig) % gsz); u.pn = (wgid % nig) / gsz; return true;
    }
    __device__ __forceinline__ void a_ready(const Unit&) const {}
    __device__ __forceinline__ void done(const Unit&) const {}
};
__device__ __forceinline__ unsigned cvt_pk_bf16(float lo, float hi) { unsigned r; asm volatile("v_cvt_pk_bf16_f32 %0, %1, %2" : "=v"(r) : "v"(lo), "v"(hi)); return r; }
template <class Epi, class Sched, int AMAP = 0, bool STAMP = false>
__device__ __forceinline__ void gemm_phase(PG8_LAS unsigned char* lds, const Gemm g, const Sched& S, const Epi& E, unsigned long long* stamps) {
    int tid_o = threadIdx.x; asm volatile("" : "+v"(tid_o)); const int tid = tid_o, wid = __builtin_amdgcn_readfirstlane(tid >> 6), lane = tid & 63, wr = wid >> 2, wc = wid & 3, fr = lane & 15, fq = lane >> 4;
    const int K = g.K, nt = K / BK;
    int ts_lo = 0, ts_hi = 0, nts = 0; const unsigned long long rt_entry = STAMP ? (unsigned long long)0ull : 0ull;
#define PG8_STAMP() do { if (STAMP && wid == 0 && nts < 64) { const unsigned long long _c = (unsigned long long)0ull; \
        ts_lo = (lane == nts) ? (int)(unsigned)_c : ts_lo; ts_hi = (lane == nts) ? (int)(unsigned)(_c >> 32) : ts_hi; ++nts; } } while (0)
    PG8_STAMP();
    unsigned voffA[2], voffB[2];
#pragma unroll
    for (int i = 0; i < 2; ++i) { int R, C; stage_rc(tid * 16 + i * 8192, R, C); const int Rb = Epi::PERM ? ((R & ~31) + perm32(R & 31)) : R;
        const int Ra = AMAP ? ((R >> 6) * 62 + (R & 63)) : R; voffA[i] = (unsigned)(Ra * K + C) * 2u; voffB[i] = (unsigned)(Rb * K + C) * 2u; }
    const size_t kstep = (size_t)(BK * 2);
    const size_t hstep = (size_t)HALF * K * 2;
    const size_t tstep = 2 * hstep; const size_t hstepA = AMAP ? (size_t)124 * K * 2 : hstep; const size_t tstepA = 2 * hstepA;
    const unsigned ldsw = (unsigned)wid * 1024u;
    const int aoff = lds_byte(wr * 64 + fr, fq * 8), boff = lds_byte(wc * 32 + fr, fq * 8);
#define PG8_SA(b, h) (((b) * 2 + (h)) * HTB)
#define PG8_SB(b, h) ((4 + (b) * 2 + (h)) * HTB)
#define PG8_STAGE(bufoff, gbase, voff) do { _Pragma("unroll") for (int _i = 0; _i < 2; ++_i) \
        __builtin_amdgcn_global_load_lds((const unsigned*)((const char*)(gbase) + (voff)[_i]), (PG8_LAS unsigned*)(lds + (bufoff) + ldsw + _i * 8192), 16, 0, 0); } while (0)
#define PG8_LDA(dst, b, h) do { _Pragma("unroll") for (int m = 0; m < 4; ++m) _Pragma("unroll") for (int k = 0; k < 2; ++k) dst[m][k] = *(const PG8_LAS bf16x8*)(lds + PG8_SA(b, h) + aoff + m * 2048 + k * 1024); } while (0)
#define PG8_LDB(dst, b, h) do { _Pragma("unroll") for (int n = 0; n < 2; ++n) _Pragma("unroll") for (int k = 0; k < 2; ++k) dst[n][k] = *(const PG8_LAS bf16x8*)(lds + PG8_SB(b, h) + boff + n * 2048 + k * 1024); } while (0)
#define PG8_MMA(ai, bj, At, Bt) do { __builtin_amdgcn_s_setprio(1); _Pragma("unroll") for (int m = 0; m < 4; ++m) _Pragma("unroll") for (int n = 0; n < 2; ++n) _Pragma("unroll") for (int k = 0; k < 2; ++k) \
        acc[ai][bj][m][n] = __builtin_amdgcn_mfma_f32_16x16x32_bf16(Bt[n][k], At[m][k], acc[ai][bj][m][n], 0, 0, 0); __builtin_amdgcn_s_setprio(0); } while (0)
#define PG8_WAIT_V(n) asm volatile("s_waitcnt vmcnt(" #n ")" ::: "memory")
#define PG8_WAIT_L(n) asm volatile("s_waitcnt lgkmcnt(" #n ")" ::: "memory")
#define PG8_BAR __builtin_amdgcn_s_barrier()
#define PG8_SCHED __builtin_amdgcn_sched_barrier(0)
    Unit cur, nxt; int ui = 0;
    if (!S.next(0, cur)) return;
    f32x4 acc[2][2][4][2];
#pragma unroll
    for (int a = 0; a < 2; ++a)
#pragma unroll
        for (int b = 0; b < 2; ++b)
#pragma unroll
            for (int m = 0; m < 4; ++m)
#pragma unroll
                for (int n = 0; n < 2; ++n) acc[a][b][m][n] = (f32x4){0.f, 0.f, 0.f, 0.f};
    bf16x8 At[4][2], B0[2][2], B1[2][2];
    const char* cA = (const char*)g.A + (size_t)cur.pm * tstepA; const char* cB = (const char*)g.Bt + (size_t)cur.pn * tstep;
    S.a_ready(cur);
    PG8_STAGE(PG8_SB(0, 0), cB, voffB); PG8_STAGE(PG8_SA(0, 0), cA, voffA); PG8_STAGE(PG8_SB(0, 1), cB + hstep, voffB); PG8_STAGE(PG8_SA(0, 1), cA + hstepA, voffA);
    if (wr == 1) PG8_BAR;
    PG8_WAIT_V(4); PG8_BAR;
    PG8_STAGE(PG8_SB(1, 0), cB + kstep, voffB); PG8_STAGE(PG8_SA(1, 0), cA + kstep, voffA); PG8_STAGE(PG8_SB(1, 1), cB + hstep + kstep, voffB);
    PG8_WAIT_V(6); PG8_BAR;
    PG8_STAMP();
    for (;;) {
        const bool has_next = S.next(ui + 1, nxt);
        const char* nA = has_next ? (const char*)g.A + (size_t)nxt.pm * tstepA : cA; const char* nB = has_next ? (const char*)g.Bt + (size_t)nxt.pn * tstep : cB;
        for (int t = 0; t < nt; t += 2) {
            const bool last = (t == nt - 2);
            const char* a1 = cA + (size_t)(t + 1) * kstep;
            const char* a2 = last ? nA : cA + (size_t)(t + 2) * kstep; const char* b2 = last ? nB : cB + (size_t)(t + 2) * kstep;
            const char* a3 = a2 + kstep; const char* b3 = b2 + kstep;
            if (last && has_next) S.a_ready(nxt);
            PG8_LDB(B0, 0, 0); PG8_SCHED; PG8_LDA(At, 0, 0); PG8_STAGE(PG8_SA(1, 1), a1 + hstepA, voffA);
            PG8_WAIT_L(8); PG8_BAR; PG8_WAIT_L(0); PG8_MMA(0, 0, At, B0); PG8_BAR; PG8_SCHED;
            PG8_LDB(B1, 0, 1); PG8_STAGE(PG8_SB(0, 0), b2, voffB);
            PG8_BAR; PG8_WAIT_L(0); PG8_MMA(0, 1, At, B1); PG8_BAR;
            PG8_LDA(At, 0, 1); PG8_STAGE(PG8_SA(0, 0), a2, voffA);
            PG8_BAR; PG8_WAIT_L(0); PG8_MMA(1, 0, At, B0); PG8_BAR; PG8_SCHED;
            PG8_STAGE(PG8_SB(0, 1), b2 + hstep, voffB);
            PG8_WAIT_V(6); PG8_BAR; PG8_MMA(1, 1, At, B1); PG8_BAR;
            PG8_LDB(B0, 1, 0); PG8_SCHED; PG8_LDA(At, 1, 0); PG8_STAGE(PG8_SA(0, 1), a2 + hstepA, voffA);
            PG8_WAIT_L(8); PG8_BAR; PG8_WAIT_L(0); PG8_MMA(0, 0, At, B0); PG8_BAR; PG8_SCHED;
            PG8_LDB(B1, 1, 1); PG8_STAGE(PG8_SB(1, 0), b3, voffB);
            PG8_BAR; PG8_WAIT_L(0); PG8_MMA(0, 1, At, B1); PG8_BAR;
            PG8_LDA(At, 1, 1); PG8_STAGE(PG8_SA(1, 0), a3, voffA);
            PG8_BAR; PG8_WAIT_L(0); PG8_MMA(1, 0, At, B0); PG8_BAR; PG8_SCHED;
            PG8_STAGE(PG8_SB(1, 1), b3 + hstep, voffB);
            PG8_WAIT_V(6); PG8_BAR; PG8_MMA(1, 1, At, B1); PG8_BAR;
        }
        PG8_STAMP();
        if constexpr (!Epi::AFTER_DRAIN) { E(acc, cur, wr, wc, fr, fq); S.done(cur); }
        PG8_STAMP();
        if (!has_next) break;
#pragma unroll
        for (int a = 0; a < 2; ++a)
#pragma unroll
            for (int b = 0; b < 2; ++b)
#pragma unroll
                for (int m = 0; m < 4; ++m)
#pragma unroll
                    for (int n = 0; n < 2; ++n) acc[a][b][m][n] = (f32x4){0.f, 0.f, 0.f, 0.f};
        cur = nxt; cA = nA; cB = nB; ++ui;
    }
    PG8_WAIT_V(0);
    if (wr == 0) PG8_BAR;
    PG8_BAR;
    if constexpr (Epi::AFTER_DRAIN) { E.fused(acc, cur, wr, wc, fr, fq, lds, wid, lane); S.done(cur); }
    PG8_STAMP();
    if (STAMP && wid == 0) { stamps[lane] = lane < nts ? (((unsigned long long)(unsigned)ts_hi << 32) | (unsigned)ts_lo) : 0ull;
        if (lane == 62) stamps[62] = rt_entry; if (lane == 63) stamps[63] = (unsigned long long)0ull; }
#undef PG8_STAMP
#undef PG8_SA
#undef PG8_SB
#undef PG8_STAGE
#undef PG8_LDA
#undef PG8_LDB
#undef PG8_MMA
#undef PG8_WAIT_V
#undef PG8_WAIT_L
#undef PG8_BAR
#undef PG8_SCHED
}
}
namespace xb {
#define XB_TMO      128
#define XB_XCNT(j)  (256  + 64 * (j))
#define XB_XSUB(j)  (1280 + 64 * (j))
#define XB_XGEN(j)  (2304 + 64 * (j))
#define XB_TOP      3328
#define XB_TOPGEN   3392
#define XCD_BAR_WORDS 3456
#define XB_SPIN_CAP (1u << 18)

__device__ __forceinline__ unsigned xb_ld(unsigned* p)              { return __hip_atomic_load(p, __ATOMIC_RELAXED, __HIP_MEMORY_SCOPE_AGENT); }
__device__ __forceinline__ unsigned xb_add(unsigned* p, unsigned v) { return __hip_atomic_fetch_add(p, v, __ATOMIC_RELAXED, __HIP_MEMORY_SCOPE_AGENT); }
__device__ __forceinline__ unsigned xb_xcc_id() { return (unsigned)__builtin_amdgcn_s_getreg((3 << 11) | 20) & 0xFu; }
#define XB_SPIN(cond, bar) do { unsigned _sp = 0; while (cond) { __builtin_amdgcn_s_sleep(1); \
    if ((++_sp & 255u) == 0u) { if (xb_ld(&(bar)[XB_TMO])) break; if (_sp > XB_SPIN_CAP) { atomicAdd(&(bar)[XB_TMO], 1u); break; } } } } while (0)

struct XcdBarrier {
    unsigned* bar; unsigned x;
    volatile __attribute__((address_space(3))) unsigned* st;
};

__device__ __forceinline__ XcdBarrier xcd_barrier_post(unsigned* bar, volatile __attribute__((address_space(3))) unsigned* st) {
    XcdBarrier b; b.bar = bar; b.x = xb_xcc_id(); b.st = st;
    if (threadIdx.x == 0) (void)xb_add(&bar[XB_XCNT(b.x)], 1u);
    return b;
}
__device__ __forceinline__ void xcd_barrier_complete(unsigned* bar, unsigned x, unsigned& nloc, unsigned& nx) {
    const unsigned G = gridDim.x * gridDim.y * gridDim.z;
    unsigned sum, cnt, mine, sp = 0u;
    for (;;) {
        sum = 0u; cnt = 0u; mine = 0u;
#pragma unroll
        for (unsigned j = 0; j < 16; ++j) { const unsigned c = xb_ld(&bar[XB_XCNT(j)]); sum += c; cnt += (c > 0u) ? 1u : 0u; mine = (j == x) ? c : mine; }
        if (sum == G) break;
        __builtin_amdgcn_s_sleep(1);
        if ((++sp & 255u) == 0u) { if (xb_ld(&bar[XB_TMO])) break; if (sp > XB_SPIN_CAP) { atomicAdd(&bar[XB_TMO], 1u); break; } }
    }
    nloc = mine > 0u ? mine : 1u; nx = cnt > 0u ? cnt : 1u;
}

__device__ __forceinline__ void xcd_barrier(const XcdBarrier& b) {
    asm volatile("s_waitcnt vmcnt(0)" ::: "memory");
    __syncthreads();
    if (threadIdx.x == 0) {
        unsigned* bar = b.bar;
        __builtin_amdgcn_s_waitcnt(0);
        unsigned nloc = b.st[0], nx = b.st[1];
        if (nloc == 0u) { xcd_barrier_complete(bar, b.x, nloc, nx); b.st[0] = nloc; b.st[1] = nx; }
        const unsigned old = xb_add(&bar[XB_XSUB(b.x)], 1u);
        const unsigned gen = old / nloc;
        if (old + 1u == (gen + 1u) * nloc) {
            __builtin_amdgcn_fence(__ATOMIC_RELEASE, "agent");
            asm volatile("s_waitcnt vmcnt(0)" ::: "memory");
            const unsigned og = xb_add(&bar[XB_TOP], 1u);
            const unsigned tg = og / nx;
            if (og + 1u == (tg + 1u) * nx) xb_add(&bar[XB_TOPGEN], 1u);
            else XB_SPIN(xb_ld(&bar[XB_TOPGEN]) == tg, bar);
            __builtin_amdgcn_fence(__ATOMIC_ACQUIRE, "agent");
            xb_add(&bar[XB_XGEN(b.x)], 1u);
            asm volatile("s_waitcnt vmcnt(0)" ::: "memory");
        } else {
            XB_SPIN(xb_ld(&bar[XB_XGEN(b.x)]) == gen, bar);
            __builtin_amdgcn_fence(__ATOMIC_ACQUIRE, "agent");
            asm volatile("s_waitcnt vmcnt(0)" ::: "memory");
        }
    }
    __syncthreads();
}

}
#ifndef PROBE
#define PROBE 0
#endif
#define REPK(k) _Pragma("unroll 1") for (int rep_ = 0; rep_ < ((PROBE == (k)) ? 2 : 1); ++rep_)
namespace mk {
#ifndef SCHB
#define SCHB (void)0
#endif
using pg8::Unit; using pg8::Gemm; using pg8::StaticOrder; using pg8::cvt_pk_bf16;
#define LAS __attribute__((address_space(3)))
typedef unsigned short bf16;
typedef float f32x4 __attribute__((ext_vector_type(4)));
typedef short bf16x8 __attribute__((ext_vector_type(8)));
typedef unsigned u32x2 __attribute__((ext_vector_type(2)));
typedef unsigned u32x4 __attribute__((ext_vector_type(4)));

constexpr int D = 1024, SEQ = 16384, TP = 32768, TS = 256, MT = 33024, DEPTH = 4, INC = 3328, FF = 2816, FF2 = 5632, NADA = 6144;
constexpr int HSEQ = 16386, HS_SAMPLE = 33280, H_ROWS = 33536, UP_TILES = 133;
constexpr int NWG = 256, NTHR = 512;
constexpr int LDS_BYTES = 135168;
constexpr size_t O_Y = 0, O_YS = 33554432, O_KP = 33816576, O_VP = 33947648, O_SRP = 34078720, O_SIP = 34095104, O_CP = 34111488,
                 O_KS = 34201600, O_VS = 34332672, O_SRS = 34463744, O_SIS = 34594816, O_CS = 34725888, O_END = 35446784;
constexpr size_t WS_BAR = 518586368, BAR_BYTES = 16384;
constexpr size_t WS_ZERO = 518602752;
constexpr int MISC_OFF = 131072;
constexpr size_t W_L = 29360128, W_IN = 0, W_GLU = 6815744, W_O = 8912896, W_OUT = 9961472, W_UP = 12058624, W_DN = 23592960;
constexpr size_t WS_W = 0, WS_MOD = 117440512, WS_ROPE = 119209984, WS_CH = 120258560, WS_H = 128647168, WS_O = WS_H, WS_YG = WS_H + 33816576,
                 WS_U = 197328896, WS_Q = 264962048, WS_K = 298778624, WS_V = 307232768, WS_G = 315686912, WS_P = 450953216, WS_END = 518586368, WS_ACT = WS_U;

struct Params { const float* in[31]; float* out; unsigned char* ws; };
enum { I_XP = 0, I_XS, I_CK, I_CV, I_SRE, I_SIM, I_SCONV, I_CP, I_CS, I_ADAW, I_ADAB, I_N1G, I_N2G, I_WIN, I_ARE, I_AIM, I_LDT, I_BRE, I_BIM, I_CRE, I_CIM, I_SD,
       I_WGLU, I_SINK, I_WO, I_WOUT, I_WUP, I_CW, I_CB, I_WDN, I_FG };

__device__ __forceinline__ float bf2f(unsigned h) { return __uint_as_float(h << 16); }
__device__ __forceinline__ unsigned f2bf(float f) { unsigned u = __float_as_uint(f); return (u + 0x7fffu + ((u >> 16) & 1u)) >> 16; }
__device__ __forceinline__ float sigm(float x) { return __builtin_amdgcn_rcpf(1.0f + __builtin_amdgcn_exp2f(-1.4426950409f * x)); }
__device__ __forceinline__ float gelu_tanh(float x) { const float z = 1.5957691216f * (x + 0.044715f * x * x * x); return x * sigm(z); }
__device__ __forceinline__ f32x4 ld_bf4(const bf16* p) { const u32x2 v = *(const u32x2*)p; return (f32x4){__uint_as_float(v.x << 16), __uint_as_float(v.x & 0xffff0000u), __uint_as_float(v.y << 16), __uint_as_float(v.y & 0xffff0000u)}; }
__device__ __forceinline__ void st_bf4(bf16* p, f32x4 v) { u32x2 o; o.x = cvt_pk_bf16(v.x, v.y); o.y = cvt_pk_bf16(v.z, v.w); *(u32x2*)p = o; }
__device__ __forceinline__ int modrow_of(int row) { return row < TP ? (row >> 14) : 2 + ((row - TP) >> 4); }
__device__ __forceinline__ int pos_of(int row) { return row < TP ? (row & (SEQ - 1)) : 2048 + ((row - TP) & 15); }
__device__ __forceinline__ float wave_sum(float v) {
#pragma unroll
    for (int o = 1; o < 64; o <<= 1) v += __shfl_xor(v, o);
    return v;
}
template <int CTRL> __device__ __forceinline__ float dpp_mov(float old, float src) {
    return __builtin_bit_cast(float, __builtin_amdgcn_update_dpp(__builtin_bit_cast(int, old), __builtin_bit_cast(int, src), CTRL, 0xf, 0xf, false));
}
template <int CTRL> __device__ __forceinline__ float dpp_rot(float src) {
    return __builtin_bit_cast(float, __builtin_amdgcn_mov_dpp(__builtin_bit_cast(int, src), CTRL, 0xf, 0xf, true));
}
__device__ __forceinline__ f32x4 row_prev1(f32x4 cur, f32x4 pm) { f32x4 r;
#pragma unroll
    for (int e = 0; e < 4; ++e) r[e] = dpp_mov<0x111>(dpp_rot<0x121>(pm[e]), cur[e]);
    return r; }
__device__ __forceinline__ f32x4 row_prev2(f32x4 cur, f32x4 pm) { f32x4 r;
#pragma unroll
    for (int e = 0; e < 4; ++e) r[e] = dpp_mov<0x112>(dpp_rot<0x122>(pm[e]), cur[e]);
    return r; }

typedef float f32x2 __attribute__((ext_vector_type(2)));
template <int E> __device__ __forceinline__ f32x2 conv_pair(f32x4 b, f32x4 w0, f32x4 w1, f32x4 w2, f32x4 cur, f32x4 pm) {
    const f32x2 c = (f32x2){cur[E], cur[E + 1]};
    const f32x2 p1 = (f32x2){dpp_mov<0x111>(dpp_rot<0x121>(pm[E]), cur[E]), dpp_mov<0x111>(dpp_rot<0x121>(pm[E + 1]), cur[E + 1])};
    const f32x2 p2 = (f32x2){dpp_mov<0x112>(dpp_rot<0x122>(pm[E]), cur[E]), dpp_mov<0x112>(dpp_rot<0x122>(pm[E + 1]), cur[E + 1])};
    f32x2 r = (f32x2){b[E], b[E + 1]} + (f32x2){w2[E], w2[E + 1]} * c;
    r = (f32x2){w1[E], w1[E + 1]} * p1 + r;
    r = (f32x2){w0[E], w0[E + 1]} * p2 + r;
    return r;
}
struct EpiWin {
    static constexpr bool PERM = false, AFTER_DRAIN = false;
    bf16* U; bf16* Q; bf16* Kb; bf16* Vb; bf16* G; const float* rope; float* out; int layer;
    __device__ __forceinline__ f32x4 rot(f32x4 v, f32x4 cs, f32x4 sn, int fq) const {
        f32x4 o, r;
#pragma unroll
        for (int e = 0; e < 4; ++e) o[e] = __shfl_xor(v[e], 32);
        if (fq < 2) r = v * cs - o * sn; else r = v * cs + o * sn;
        return r;
    }
    __device__ __forceinline__ void operator()(const f32x4 (&acc)[2][2][4][2], const Unit& u, int wr, int wc, int fr, int fq) const {
        const int pn = u.pn;
        const bool need_rot = (pn >= 2 && pn <= 4) && (wc & 1) == 0;
#pragma unroll
        for (int ai = 0; ai < 2; ++ai) {
            f32x4 rcs[4], rsn[4];
#pragma unroll
            for (int m = 0; m < 4; ++m) { rcs[m] = (f32x4){1.f, 1.f, 1.f, 1.f}; rsn[m] = (f32x4){0.f, 0.f, 0.f, 0.f};
                if (need_rot) { const float* rp = rope + (unsigned)(pos_of(u.pm * 256 + ai * 128 + wr * 64 + m * 16 + fr) * 16 + 4 * (fq & 1)); rcs[m] = *(const f32x4*)rp; rsn[m] = *(const f32x4*)(rp + 8); } }
#pragma unroll
            for (int m = 0; m < 4; ++m) {
                const int row = u.pm * 256 + ai * 128 + wr * 64 + m * 16 + fr;
                const int pos = pos_of(row);
                if (pn < 2) {
#pragma unroll
                    for (int bj = 0; bj < 2; ++bj)
#pragma unroll
                        for (int n = 0; n < 2; ++n) st_bf4(U + (unsigned)(row * 512 + pn * 256 + bj * 128 + wc * 32 + n * 16 + 4 * fq), acc[ai][bj][m][n]);
                } else if (pn < 4) {
#pragma unroll
                    for (int bj = 0; bj < 2; ++bj)
#pragma unroll
                        for (int n = 0; n < 2; ++n) {
                            f32x4 v = acc[ai][bj][m][n] * 0.125f;
                            if (n == 0 && (wc & 1) == 0) v = rot(v, rcs[m], rsn[m], fq);
                            st_bf4(Q + (unsigned)(row * 512 + (pn - 2) * 256 + bj * 128 + wc * 32 + n * 16 + 4 * fq), v);
                        }
                } else if (pn == 4) {
#pragma unroll
                    for (int bj = 0; bj < 2; ++bj)
#pragma unroll
                        for (int n = 0; n < 2; ++n) {
                            f32x4 v = acc[ai][bj][m][n];
                            const int c = wc * 32 + n * 16 + 4 * fq;
                            if (bj == 0 && n == 0 && (wc & 1) == 0) v = rot(v, rcs[m], rsn[m], fq);
                            st_bf4((bj == 0 ? Kb : Vb) + (unsigned)(row * 128 + c), v);
                            if (row >= TP) *(f32x4*)(out + (bj == 0 ? O_KS : O_VS) + (unsigned)((layer * 256 + (row - TP)) * 128 + c)) = v;
                            else if (pos >= SEQ - 128) *(f32x4*)(out + (bj == 0 ? O_KP : O_VP) + (unsigned)(((layer * 2 + (row >> 14)) * 128 + (pos - (SEQ - 128))) * 128 + c)) = v;
                        }
                } else {
#pragma unroll
                    for (int bj = 0; bj < 2; ++bj)
#pragma unroll
                        for (int n = 0; n < 2; ++n) {
                            const f32x4 a = acc[ai][bj][m][n]; f32x4 v;
#pragma unroll
                            for (int e = 0; e < 4; ++e) v[e] = sigm(a[e]);
                            st_bf4(G + (unsigned)(row * 2048 + (pn - 5) * 256 + bj * 128 + wc * 32 + n * 16 + 4 * fq), v);
                        }
                }
            }
        }
    }
};
struct EpiAttnO {
    static constexpr bool PERM = false, AFTER_DRAIN = false;
    const bf16* G; bf16* P;
    __device__ __forceinline__ void quad(int row, int cb, int fq, f32x4 v0, f32x4 v1) const {
        const int col = cb + 4 * fq;
        st_bf4(P + (unsigned)(row * 1024 + col), ld_bf4(G + (unsigned)(row * 2048 + 1024 + col)) * v0);
        st_bf4(P + (unsigned)(row * 1024 + col + 16), ld_bf4(G + (unsigned)(row * 2048 + 1024 + col + 16)) * v1);
    }
    __device__ __forceinline__ void operator()(const f32x4 (&acc)[2][2][4][2], const Unit& u, int wr, int wc, int fr, int fq) const {
#pragma unroll
        for (int ai = 0; ai < 2; ++ai) {
            u32x2 gq[4][2][2];
#pragma unroll
            for (int m = 0; m < 4; ++m)
#pragma unroll
                for (int bj = 0; bj < 2; ++bj)
#pragma unroll
                    for (int n = 0; n < 2; ++n) gq[m][bj][n] = *(const u32x2*)(G + (unsigned)((u.pm * 256 + ai * 128 + wr * 64 + m * 16 + fr) * 2048 + 1024 + u.pn * 256 + bj * 128 + wc * 32 + 16 * n + 4 * fq));
#pragma unroll
            for (int m = 0; m < 4; ++m)
#pragma unroll
                for (int bj = 0; bj < 2; ++bj)
#pragma unroll
                    for (int n = 0; n < 2; ++n) { const u32x2 q = gq[m][bj][n];
                        const f32x4 gb = (f32x4){__uint_as_float(q.x << 16), __uint_as_float(q.x & 0xffff0000u), __uint_as_float(q.y << 16), __uint_as_float(q.y & 0xffff0000u)};
                        st_bf4(P + (unsigned)((u.pm * 256 + ai * 128 + wr * 64 + m * 16 + fr) * 1024 + u.pn * 256 + bj * 128 + wc * 32 + 16 * n + 4 * fq), gb * acc[ai][bj][m][n]); }
        }
    }
};
struct EpiGlu {
    static constexpr bool PERM = false, AFTER_DRAIN = false;
    const bf16* G; bf16* P;
    __device__ __forceinline__ void quad(int row, int cb, int fq, f32x4 a, f32x4 b) const {
        const int j = (cb >> 1) + 4 * fq;
        const f32x4 ga = ld_bf4(G + (unsigned)(row * 2048 + j)), pb = ld_bf4(P + (unsigned)(row * 1024 + j));
        f32x4 v;
#pragma unroll
        for (int e = 0; e < 4; ++e) v[e] = ga[e] * a[e] * sigm(b[e]) + pb[e];
        st_bf4(P + (unsigned)(row * 1024 + j), v);
    }
    __device__ __forceinline__ void operator()(const f32x4 (&acc)[2][2][4][2], const Unit& u, int wr, int wc, int fr, int fq) const {
#pragma unroll
        for (int ai = 0; ai < 2; ++ai) {
            u32x2 gq[4][2], pq[4][2];
#pragma unroll
            for (int m = 0; m < 4; ++m)
#pragma unroll
                for (int bj = 0; bj < 2; ++bj) { const int row = u.pm * 256 + ai * 128 + wr * 64 + m * 16 + fr, j = ((u.pn * 256 + bj * 128 + wc * 32) >> 1) + 4 * fq;
                    gq[m][bj] = *(const u32x2*)(G + (unsigned)(row * 2048 + j)); pq[m][bj] = *(const u32x2*)(P + (unsigned)(row * 1024 + j)); }
#pragma unroll
            for (int m = 0; m < 4; ++m)
#pragma unroll
                for (int bj = 0; bj < 2; ++bj) { const int row = u.pm * 256 + ai * 128 + wr * 64 + m * 16 + fr, j = ((u.pn * 256 + bj * 128 + wc * 32) >> 1) + 4 * fq;
                    const u32x2 q = gq[m][bj], r = pq[m][bj];
                    const f32x4 ga = (f32x4){__uint_as_float(q.x << 16), __uint_as_float(q.x & 0xffff0000u), __uint_as_float(q.y << 16), __uint_as_float(q.y & 0xffff0000u)};
                    const f32x4 pb = (f32x4){__uint_as_float(r.x << 16), __uint_as_float(r.x & 0xffff0000u), __uint_as_float(r.y << 16), __uint_as_float(r.y & 0xffff0000u)};
                    const f32x4 a = acc[ai][bj][m][0], bb = acc[ai][bj][m][1]; f32x4 v;
#pragma unroll
                    for (int e2 = 0; e2 < 4; ++e2) v[e2] = ga[e2] * a[e2] * sigm(bb[e2]) + pb[e2];
                    st_bf4(P + (unsigned)(row * 1024 + j), v); }
        }
    }
};
struct EpiRes {
    static constexpr bool PERM = false, AFTER_DRAIN = false;
    const float* xb; float* X; const float* gvec;
    __device__ __forceinline__ void quad(int row, int cb, int fq, f32x4 v0, f32x4 v1) const {
        const unsigned go = (unsigned)(modrow_of(row) * NADA), o = (unsigned)(row * D + cb + 4 * fq);
        *(f32x4*)(X + o) = *(const f32x4*)(xb + o) + *(const f32x4*)(gvec + (go + cb + 4 * fq)) * v0;
        *(f32x4*)(X + o + 16) = *(const f32x4*)(xb + o + 16) + *(const f32x4*)(gvec + (go + cb + 4 * fq + 16)) * v1;
    }
    __device__ __forceinline__ void operator()(const f32x4 (&acc)[2][2][4][2], const Unit& u, int wr, int wc, int fr, int fq) const {
        const unsigned go = (unsigned)(modrow_of(u.pm * 256) * NADA);
        f32x4 gv[2][2];
#pragma unroll
        for (int bj = 0; bj < 2; ++bj)
#pragma unroll
            for (int n = 0; n < 2; ++n) gv[bj][n] = *(const f32x4*)(gvec + (go + u.pn * 256 + bj * 128 + wc * 32 + 16 * n + 4 * fq));
#pragma unroll
        for (int ai = 0; ai < 2; ++ai) {
            f32x4 xr[4][2][2];
#pragma unroll
            for (int m = 0; m < 4; ++m)
#pragma unroll
                for (int bj = 0; bj < 2; ++bj)
#pragma unroll
                    for (int n = 0; n < 2; ++n) xr[m][bj][n] = *(const f32x4*)(xb + (unsigned)((u.pm * 256 + ai * 128 + wr * 64 + m * 16 + fr) * D + u.pn * 256 + bj * 128 + wc * 32 + 16 * n + 4 * fq));
#pragma unroll
            for (int m = 0; m < 4; ++m)
#pragma unroll
                for (int bj = 0; bj < 2; ++bj)
#pragma unroll
                    for (int n = 0; n < 2; ++n) *(f32x4*)(X + (unsigned)((u.pm * 256 + ai * 128 + wr * 64 + m * 16 + fr) * D + u.pn * 256 + bj * 128 + wc * 32 + 16 * n + 4 * fq)) = xr[m][bj][n] + gv[bj][n] * acc[ai][bj][m][n];
        }
    }
};
template <int SPLIT, class Epi> __device__ __forceinline__ void small_gemm(const bf16* A, const bf16* Wt, int N, int K, int row0, const Epi& E, LAS unsigned char* lds, int bid, int tid) {
    asm volatile("" : "+v"(tid));
    const int lane = tid & 63, wave = tid >> 6, fr = lane & 15, fq = lane >> 4;
    const int nct = N >> 5, ntile = 16 * nct, tpw = 8 / SPLIT, kp = wave % SPLIT, tl = wave / SPLIT, kb = (K / SPLIT) * kp, ke = kb + K / SPLIT;
    LAS f32x4* red = (LAS f32x4*)lds;
    for (int t0 = bid * tpw; t0 < ntile; t0 += NWG * tpw) {
        const int tile = t0 + tl, rt = tile / nct, ct = tile - rt * nct;
        const bf16* ap = A + (unsigned)((16 * rt + fr) * K + 8 * fq);
        const bf16* bp0 = Wt + (unsigned)((32 * ct + fr) * K + 8 * fq);
        const bf16* bp1 = bp0 + (unsigned)(16 * K);
        f32x4 c0 = (f32x4){0.f, 0.f, 0.f, 0.f}, c1 = (f32x4){0.f, 0.f, 0.f, 0.f};
        for (int k0 = kb; k0 < ke; k0 += 256) {
            const int nst = (ke - k0) >> 5;
            bf16x8 a[8], b0[8], b1[8];
#pragma unroll
            for (int s = 0; s < 8; ++s) if (s < nst) { a[s] = *(const bf16x8*)(ap + k0 + 32 * s); b0[s] = *(const bf16x8*)(bp0 + k0 + 32 * s); b1[s] = *(const bf16x8*)(bp1 + k0 + 32 * s); }
#pragma unroll
            for (int s = 0; s < 8; ++s) if (s < nst) { c0 = __builtin_amdgcn_mfma_f32_16x16x32_bf16(b0[s], a[s], c0, 0, 0, 0); c1 = __builtin_amdgcn_mfma_f32_16x16x32_bf16(b1[s], a[s], c1, 0, 0, 0); }
        }
        if (SPLIT > 1) {
            __builtin_amdgcn_sched_barrier(0); asm volatile("s_nop 15\n\ts_nop 15" ::: "memory"); __builtin_amdgcn_sched_barrier(0);
            red[(wave * 2 + 0) * 64 + lane] = c0; red[(wave * 2 + 1) * 64 + lane] = c1;
            __syncthreads();
            if (kp == 0) {
#pragma unroll
                for (int j = 1; j < SPLIT; ++j) { c0 += red[((wave + j) * 2 + 0) * 64 + lane]; c1 += red[((wave + j) * 2 + 1) * 64 + lane]; }
            }
        }
        if (kp == 0) E.quad(row0 + 16 * rt + fr, 32 * ct, fq, c0, c1);
        if (SPLIT > 1) __syncthreads();
    }
}
template <bool SAMPLE> struct EpiUp {
    static constexpr bool PERM = false, AFTER_DRAIN = false;
    bf16* ACT; const float* cw; const float* cb; const float* sconv; float* out; int layer;
    __device__ __forceinline__ void operator()(const f32x4 (&acc)[2][2][4][2], const Unit& u, int wr, int wc, int fr, int fq) const {
        const f32x4 z = (f32x4){0.f, 0.f, 0.f, 0.f};
#pragma unroll
        for (int bj = 0; bj < 2; ++bj) {
            const int jf = 16 * (8 * u.pn + 4 * bj + wc) + 4 * fq;
            typedef const __attribute__((address_space(4))) f32x4* cptr4;
            const f32x4 wv0 = *(cptr4)(cw + jf), wv1 = *(cptr4)(cw + FF2 + jf), wv2 = *(cptr4)(cw + 2 * FF2 + jf), bv = *(cptr4)(cb + jf);
            const f32x4 wg0 = *(cptr4)(cw + FF + jf), wg1 = *(cptr4)(cw + FF2 + FF + jf), wg2 = *(cptr4)(cw + 2 * FF2 + FF + jf), bg = *(cptr4)(cb + FF + jf);
#pragma unroll
            for (int ai = 0; ai < 2; ++ai)
#pragma unroll
                for (int m = 0; m < 4; ++m) {
                    const f32x4 cv = acc[ai][bj][m][0], cg = acc[ai][bj][m][1];
                    const f32x4 pv = m > 0 ? acc[ai][bj][m > 0 ? m - 1 : 0][0] : z, pg = m > 0 ? acc[ai][bj][m > 0 ? m - 1 : 0][1] : z;
                    f32x4 val = bv + wv2 * cv, gat = bg + wg2 * cg;
                    bool valid; unsigned aoff;
                    if (SAMPLE) {
                        const int s = 8 * ai + 4 * wr + m, t = fr;
                        f32x4 p1v = row_prev1(cv, z), p2v = row_prev2(cv, z), p1g = row_prev1(cg, z), p2g = row_prev2(cg, z);
                        if (t < 2) {
                            const float* st = sconv + (unsigned)(s * 2 * FF2 + jf);
                            const f32x4 s1v = *(const f32x4*)(st + FF2), s1g = *(const f32x4*)(st + FF2 + FF);
                            if (t == 0) { p1v = s1v; p1g = s1g; p2v = *(const f32x4*)st; p2g = *(const f32x4*)(st + FF); }
                            else { p2v = s1v; p2g = s1g; }
                        }
                        val += wv0 * p2v + wv1 * p1v; gat += wg0 * p2g + wg1 * p1g;
                        valid = true; aoff = (unsigned)(TP + 16 * s + t) * FF + jf;
                        if (t >= 14) { float* o = out + O_CS + (unsigned)(((layer * 16 + s) * 2 + (t - 14)) * FF2 + jf); *(f32x4*)o = cv; *(f32x4*)(o + FF) = cg; }
                    } else {
                        { f32x2 v01 = conv_pair<0>(bv, wv0, wv1, wv2, cv, pv), v23 = conv_pair<2>(bv, wv0, wv1, wv2, cv, pv);
                          asm volatile("" : "+v"(v01), "+v"(v23));
                          const f32x2 g01 = conv_pair<0>(bg, wg0, wg1, wg2, cg, pg), g23 = conv_pair<2>(bg, wg0, wg1, wg2, cg, pg);
                          val = (f32x4){v01.x, v01.y, v23.x, v23.y}; gat = (f32x4){g01.x, g01.y, g23.x, g23.y}; }
                        const int j = 16 * m + fr, hs = 248 * u.pm + 62 * (2 * ai + wr) + j;
                        const int b = hs >= HSEQ ? 1 : 0, pos = hs - b * HSEQ - 2;
                        valid = (j >= 2) && (pos >= 0) && (hs < 2 * HSEQ);
                        aoff = (unsigned)(b * SEQ + pos) * FF + jf;
                        if (valid && pos >= SEQ - 2) { float* o = out + O_CP + (unsigned)(((layer * 2 + b) * 2 + (pos - (SEQ - 2))) * FF2 + jf); *(f32x4*)o = cv; *(f32x4*)(o + FF) = cg; }
                    }
                    if (valid) {
                        f32x4 a;
#pragma unroll
                        for (int e = 0; e < 4; ++e) a[e] = gat[e] * sigm(gat[e]) * val[e];
                        st_bf4(ACT + aoff, a);
                    }
                    SCHB;
                }
        }
    }
};

__device__ __forceinline__ int dstrow(int mode, int half, int n) { if (mode == 0) return n; const int j = n < half ? n : n - half; return 32 * (j >> 4) + (j & 15) + (n < half ? 0 : 16); }
__device__ __forceinline__ void transpose_item(const float* W, int K, int N, bf16* WT, int mode, int half, LAS float* scr, int item, int lane) {
    const int nblk = N / 32, kb = item / nblk, nb = item % nblk, k0 = 64 * kb, n0 = 32 * nb;
#pragma unroll 8
    for (int i = 0; i < 32; ++i) { const int kk = 2 * i + (lane >> 5); scr[kk * 33 + (lane & 31)] = W[(size_t)(k0 + kk) * N + n0 + (lane & 31)]; }
    asm volatile("s_waitcnt lgkmcnt(0)" ::: "memory");
    const int c = lane & 7;
#pragma unroll
    for (int j = 0; j < 4; ++j) { const int n = (lane >> 3) + 8 * j; const LAS float* s = scr + (8 * c) * 33 + n;
        u32x4 o; o.x = cvt_pk_bf16(s[0 * 33], s[1 * 33]); o.y = cvt_pk_bf16(s[2 * 33], s[3 * 33]); o.z = cvt_pk_bf16(s[4 * 33], s[5 * 33]); o.w = cvt_pk_bf16(s[6 * 33], s[7 * 33]);
        *(u32x4*)(WT + (size_t)dstrow(mode, half, n0 + n) * K + k0 + 8 * c) = o; }
    asm volatile("s_waitcnt lgkmcnt(0)" ::: "memory");
}
__device__ __forceinline__ void dsincos(double x, double& s, double& c) {
    const double k = rint(x * 0.15915494309189535);
    const double r = (x - k * 6.283185307179586) - k * 2.4492935982947064e-16;
    const double r2 = r * r;
    double ts = 1.0, tc = 1.0, ss = 1.0, cc = 1.0;
#pragma unroll
    for (int i = 1; i <= 13; ++i) { tc = -tc * r2 / (double)((2 * i - 1) * (2 * i)); cc += tc; ts = -ts * r2 / (double)((2 * i) * (2 * i + 1)); ss += ts; }
    s = ss * r; c = cc;
}
__device__ __forceinline__ void p0_prologue(const Params& p, LAS unsigned char* lds, int bid, int tid) {
    asm volatile("" : "+v"(tid));
    const int lane = tid & 63, wave = tid >> 6;
    float* mod = (float*)(p.ws + WS_MOD);
    if (bid < 192) {
        LAS float* sc = (LAS float*)lds;
        LAS float* part = (LAS float*)(lds + 81920);
        for (int idx = tid; idx < 18 * 1024; idx += NTHR) { const int bb = idx >> 10, d = idx & 1023;
            const float c = bb < 2 ? p.in[I_CP][bb * 1024 + d] : p.in[I_CS][(bb - 2) * 1024 + d]; sc[d * 20 + bb] = c / (1.0f + __expf(-c)); }
        __syncthreads();
        const int l = bid / 48, e0 = (bid % 48) * 128, col = tid & 127, dq = tid >> 7;
        float a[18];
#pragma unroll
        for (int i = 0; i < 18; ++i) a[i] = 0.f;
        const float* wp = p.in[I_ADAW] + ((size_t)l * 1024 + dq * 256) * NADA + e0 + col;
#pragma unroll 8
        for (int d = 0; d < 256; ++d) {
            const float w = wp[(size_t)d * NADA];
            const LAS f32x4* s4 = (const LAS f32x4*)(sc + (dq * 256 + d) * 20);
            const f32x4 s0 = s4[0], s1 = s4[1], s2 = s4[2], s3 = s4[3], s5 = s4[4];
            a[0] += w * s0.x; a[1] += w * s0.y; a[2] += w * s0.z; a[3] += w * s0.w; a[4] += w * s1.x; a[5] += w * s1.y; a[6] += w * s1.z; a[7] += w * s1.w;
            a[8] += w * s2.x; a[9] += w * s2.y; a[10] += w * s2.z; a[11] += w * s2.w; a[12] += w * s3.x; a[13] += w * s3.y; a[14] += w * s3.z; a[15] += w * s3.w;
            a[16] += w * s5.x; a[17] += w * s5.y;
        }
#pragma unroll
        for (int i = 0; i < 18; ++i) part[(dq * 128 + col) * 18 + i] = a[i];
        __syncthreads();
        for (int idx = tid; idx < 128 * 18; idx += NTHR) { const int c2 = idx & 127, bb = idx >> 7;
            const float v = part[(0 * 128 + c2) * 18 + bb] + part[(1 * 128 + c2) * 18 + bb] + part[(2 * 128 + c2) * 18 + bb] + part[(3 * 128 + c2) * 18 + bb] + p.in[I_ADAB][l * NADA + e0 + c2];
            mod[((size_t)l * 18 + bb) * NADA + e0 + c2] = v; }
        __syncthreads();
    }
    {
        float* rope = (float*)(p.ws + WS_ROPE);
        for (int idx = bid * NTHR + tid; idx < SEQ * 8; idx += NWG * NTHR) { const int pos = idx >> 3, i = idx & 7;
            const double f = i == 0 ? 1.0 : i == 1 ? 0.19392274474868576 : i == 2 ? 0.03760603093086393 : i == 3 ? 0.007292664737217109 : i == 4 ? 0.001414213562373095 : i == 5 ? 0.0002742481756762073 : i == 6 ? 5.318295896944988e-05 : 1.031338537721246e-05;
            double s, c; dsincos((double)pos * f, s, c); rope[pos * 16 + i] = (float)c; rope[pos * 16 + 8 + i] = (float)s; }
    }
    {
        LAS float* scr = (LAS float*)(lds + wave * 8704);
        constexpr int I_1 = 16 * 104, I_2 = 8 * 64, I_3 = 8 * 32, I_4 = 16 * 32, I_5 = 16 * 176, I_6 = 44 * 32, I_L = I_1 + I_2 + I_3 + I_4 + I_5 + I_6;
        const int gw = bid * 8 + wave;
        for (int it = gw; it < DEPTH * I_L; it += NWG * 8) {
            const int l = it / I_L; int r = it % I_L; unsigned char* wl = p.ws + WS_W + (size_t)l * W_L;
            if (r < I_1) { transpose_item(p.in[I_WIN] + (size_t)l * D * INC, D, INC, (bf16*)(wl + W_IN), 0, 0, scr, r, lane); continue; } r -= I_1;
            if (r < I_2) { transpose_item(p.in[I_WGLU] + (size_t)l * 512 * 2048, 512, 2048, (bf16*)(wl + W_GLU), 1, 1024, scr, r, lane); continue; } r -= I_2;
            if (r < I_3) { transpose_item(p.in[I_WO] + (size_t)l * 512 * 1024, 512, 1024, (bf16*)(wl + W_O), 0, 0, scr, r, lane); continue; } r -= I_3;
            if (r < I_4) { transpose_item(p.in[I_WOUT] + (size_t)l * D * D, D, D, (bf16*)(wl + W_OUT), 0, 0, scr, r, lane); continue; } r -= I_4;
            if (r < I_5) { transpose_item(p.in[I_WUP] + (size_t)l * D * FF2, D, FF2, (bf16*)(wl + W_UP), 1, FF, scr, r, lane); continue; } r -= I_5;
            transpose_item(p.in[I_WDN] + (size_t)l * FF * D, FF, D, (bf16*)(wl + W_DN), 0, 0, scr, r, lane);
        }
    }
}

__device__ __forceinline__ void norm_phase(const Params& p, int layer, int mode, int bid, int tid) {
    asm volatile("" : "+v"(tid));
    const int lane = tid & 63, wave = tid >> 6, gw = bid * 8 + wave;
    float* X = p.out; bf16* H = (bf16*)(p.ws + WS_H);
    const float* mod = (const float*)(p.ws + WS_MOD) + (size_t)layer * 18 * NADA;
    const float* gsrc = mode == 0 ? p.in[I_N1G] + layer * D : mode == 1 ? p.in[I_N2G] + layer * D : p.in[I_FG];
    f32x4 g[4];
#pragma unroll
    for (int j = 0; j < 4; ++j) g[j] = *(const f32x4*)(gsrc + 4 * lane + 256 * j);
    if (mode == 1 && gw < 4) { const int hs = (gw & 1) + (gw >> 1) * HSEQ; unsigned* o = (unsigned*)(H + (size_t)hs * D); unsigned zz = 0u; asm volatile("" : "+v"(zz));
#pragma unroll
        for (int j = 0; j < 8; ++j) o[lane + 64 * j] = zz; }
    for (int row = gw; row < MT; row += NWG * 8) {
        const float* xr = (mode == 0 && layer == 0) ? (row < TP ? p.in[I_XP] + (size_t)row * D : p.in[I_XS] + (size_t)(row - TP) * D) : X + (size_t)row * D;
        f32x4 v[4]; float s = 0.f;
#pragma unroll
        for (int j = 0; j < 4; ++j) { v[j] = *(const f32x4*)(xr + 4 * lane + 256 * j); s += (v[j].x * v[j].x + v[j].y * v[j].y) + (v[j].z * v[j].z + v[j].w * v[j].w); }
        const float rstd = 1.0f / sqrtf(wave_sum(s) * (1.0f / D) + 1e-6f);
        if (mode == 2) {
#pragma unroll
            for (int j = 0; j < 4; ++j) *(f32x4*)(X + (size_t)row * D + 4 * lane + 256 * j) = v[j] * rstd * g[j];
        } else {
            const float* mr = mod + (size_t)modrow_of(row) * NADA + (mode == 0 ? 0 : 3072);
            size_t hrow = row;
            if (mode == 1) hrow = row < TP ? (size_t)(row >> 14) * HSEQ + 2 + (row & (SEQ - 1)) : (size_t)HS_SAMPLE + (row - TP);
#pragma unroll
            for (int j = 0; j < 4; ++j) { const f32x4 sh = *(const f32x4*)(mr + 4 * lane + 256 * j), sc = *(const f32x4*)(mr + 1024 + 4 * lane + 256 * j);
                st_bf4(H + hrow * D + 4 * lane + 256 * j, (v[j] * rstd * g[j]) * (sc + 1.0f) + sh); }
        }
    }
}

struct SsmPar { float abr, abi; float bbr[16], bbi[16]; };
__device__ __forceinline__ void ssm_disc(const Params& p, int layer, int g, int lane, float& abr, float& abi, float& fr, float& fi) {
    const int gi = (layer * 32 + g) * 64 + lane;
    const float are = p.in[I_ARE][gi], aim = p.in[I_AIM][gi], dt = expf(p.in[I_LDT][layer * 32 + g]);
    const float mag = expf(are * dt); float sn, cs; sincosf(aim * dt, &sn, &cs);
    abr = mag * cs; abi = mag * sn;
    const float nr = abr - 1.0f, ni = abi, den = are * are + aim * aim;
    fr = (nr * are + ni * aim) / den; fi = (ni * are - nr * aim) / den;
}
__device__ __forceinline__ void ssm_task(const Params& p, int layer, int mode, int sq, int g, int chunk, int lane, LAS unsigned char* wl) {
    LAS float* ul = (LAS float*)wl;
    LAS bf16* Sl = (LAS bf16*)(wl + 4096);
    float abr, abi, fr, fi; ssm_disc(p, layer, g, lane, abr, abi, fr, fi);
    typedef float f32x2 __attribute__((ext_vector_type(2)));
    f32x2 bb[16];
    { const size_t bo = (((size_t)layer * 32 + g) * 64 + lane) * 16;
#pragma unroll
      for (int c4 = 0; c4 < 4; ++c4) { const f32x4 br = *(const f32x4*)(p.in[I_BRE] + bo + 4 * c4), bi = *(const f32x4*)(p.in[I_BIM] + bo + 4 * c4);
#pragma unroll
          for (int e = 0; e < 4; ++e) { bb[4 * c4 + e].x = fr * br[e] - fi * bi[e]; bb[4 * c4 + e].y = fr * bi[e] + fi * br[e]; } } }
    const bool cproj = mode != 0;
    const int g4 = lane >> 4, cl = lane & 15;
    bf16x8 cf[4];
    float dsk = 0.f;
    if (cproj) {
        const size_t co = (((size_t)layer * 32 + g) * 16 + cl) * 64;
#pragma unroll
        for (int ks = 0; ks < 4; ++ks) { const float* src = (ks < 2 ? p.in[I_CRE] : p.in[I_CIM]) + co + 32 * (ks & 1) + 8 * g4; const float sg = ks < 2 ? 1.0f : -1.0f;
            const f32x4 a = *(const f32x4*)src, b = *(const f32x4*)(src + 4);
            u32x4 o; o.x = cvt_pk_bf16(sg * a.x, sg * a.y); o.y = cvt_pk_bf16(sg * a.z, sg * a.w); o.z = cvt_pk_bf16(sg * b.x, sg * b.y); o.w = cvt_pk_bf16(sg * b.z, sg * b.w);
            cf[ks] = __builtin_bit_cast(bf16x8, o); }
        dsk = p.in[I_SD][layer * 512 + g * 16 + cl];
    }
    const int nsteps = mode == 1 ? 16 : 64;
    const size_t r0 = mode == 1 ? (size_t)TP + sq * 16 : (size_t)sq * SEQ + chunk * 64;
    const float* U = (const float*)(p.ws + WS_U);
#pragma unroll
    for (int i = 0; i < 4; ++i) { const int idx = lane + 64 * i; if (idx < nsteps * 4) { const int t = idx >> 2, c4 = idx & 3; *(LAS f32x4*)(ul + t * 16 + 4 * c4) = *(const f32x4*)(U + (r0 + t) * 512 + g * 16 + 4 * c4); } }
    float sr = 0.f, si = 0.f;
    float* CH = (float*)(p.ws + WS_CH);
    const size_t cho = (((size_t)(sq * 32 + g)) * 256 + chunk) * 128;
    if (mode == 1) { const size_t so = (((size_t)layer * 16 + sq) * 32 + g) * 64 + lane; sr = p.in[I_SRE][so]; si = p.in[I_SIM][so]; }
    else if (mode == 2) { sr = CH[cho + lane]; si = CH[cho + 64 + lane]; }
    asm volatile("s_waitcnt vmcnt(0) lgkmcnt(0)" ::: "memory"); __builtin_amdgcn_wave_barrier();
    bf16* Yg = (bf16*)(p.ws + WS_YG);
    for (int hh = 0; hh * 32 < nsteps; ++hh) {
        const int ns = nsteps - hh * 32 < 32 ? nsteps - hh * 32 : 32;
#pragma unroll 4
        for (int t = 0; t < ns; ++t) {
            const LAS f32x4* up = (const LAS f32x4*)(ul + (hh * 32 + t) * 16);
            const f32x4 u0 = up[0], u1 = up[1], u2 = up[2], u3 = up[3];
            f32x2 xa = (f32x2){0.f, 0.f}, xb = (f32x2){0.f, 0.f};
#pragma unroll
            for (int e = 0; e < 4; ++e) { xa = bb[e] * (f32x2){u0[e], u0[e]} + xa; xb = bb[4 + e] * (f32x2){u1[e], u1[e]} + xb; }
#pragma unroll
            for (int e = 0; e < 4; ++e) { xa = bb[8 + e] * (f32x2){u2[e], u2[e]} + xa; xb = bb[12 + e] * (f32x2){u3[e], u3[e]} + xb; }
            const float xr = xa.x + xb.x, xi = xa.y + xb.y;
            const float nsr = fmaf(abr, sr, fmaf(-abi, si, xr)), nsi = fmaf(abr, si, fmaf(abi, sr, xi));
            sr = nsr; si = nsi;
            if (cproj) { Sl[t * 136 + lane] = (bf16)f2bf(sr); Sl[t * 136 + 64 + lane] = (bf16)f2bf(si); }
        }
        if (cproj) {
            asm volatile("s_waitcnt lgkmcnt(0)" ::: "memory"); __builtin_amdgcn_wave_barrier();
#pragma unroll
            for (int mt = 0; mt < 2; ++mt) {
                f32x4 ya = (f32x4){0.f, 0.f, 0.f, 0.f};
#pragma unroll
                for (int ks = 0; ks < 4; ++ks) { const bf16x8 a = *(const LAS bf16x8*)(Sl + (16 * mt + cl) * 136 + 32 * ks + 8 * g4); ya = __builtin_amdgcn_mfma_f32_16x16x32_bf16(a, cf[ks], ya, 0, 0, 0); }
#pragma unroll
                for (int i = 0; i < 4; ++i) { const int t = 16 * mt + 4 * g4 + i;
                    if (t < ns) { const float y = ya[i] + dsk * ul[(hh * 32 + t) * 16 + cl]; Yg[(r0 + hh * 32 + t) * 512 + g * 16 + cl] = (bf16)f2bf(gelu_tanh(y)); } }
            }
            asm volatile("s_waitcnt lgkmcnt(0)" ::: "memory"); __builtin_amdgcn_wave_barrier();
        }
    }
    if (mode == 0) { CH[cho + lane] = sr; CH[cho + 64 + lane] = si; }
    else if (mode == 1) { const size_t so = (((size_t)layer * 16 + sq) * 32 + g) * 64 + lane; p.out[O_SRS + so] = sr; p.out[O_SIS + so] = si; }
    else if (chunk == 255) { const size_t so = (((size_t)layer * 2 + sq) * 32 + g) * 64 + lane; p.out[O_SRP + so] = sr; p.out[O_SIP + so] = si; }
    asm volatile("s_waitcnt lgkmcnt(0)" ::: "memory"); __builtin_amdgcn_wave_barrier();
}
__device__ __forceinline__ void split_hl(f32x4 a, f32x4 c, u32x4& hi, u32x4& lo) {
    hi.x = cvt_pk_bf16(a.x, a.y); hi.y = cvt_pk_bf16(a.z, a.w); hi.z = cvt_pk_bf16(c.x, c.y); hi.w = cvt_pk_bf16(c.z, c.w);
    lo.x = cvt_pk_bf16(a.x - __uint_as_float(hi.x << 16), a.y - __uint_as_float(hi.x & 0xffff0000u)); lo.y = cvt_pk_bf16(a.z - __uint_as_float(hi.y << 16), a.w - __uint_as_float(hi.y & 0xffff0000u));
    lo.z = cvt_pk_bf16(c.x - __uint_as_float(hi.z << 16), c.y - __uint_as_float(hi.z & 0xffff0000u)); lo.w = cvt_pk_bf16(c.z - __uint_as_float(hi.w << 16), c.w - __uint_as_float(hi.w & 0xffff0000u));
}
__device__ __forceinline__ void ssm_task_v2(const Params& p, int layer, int mode, int sq, int g, int chunk0, int nchunk, int cstride, int lane, LAS unsigned char* wl) {
    LAS float* Xl = (LAS float*)wl;
    LAS bf16* Sl = (LAS bf16*)(wl + 8448);
    const int g4 = lane >> 4, cl = lane & 15;
    float abr, abi, fr, fi; ssm_disc(p, layer, g, lane, abr, abi, fr, fi);
    bf16x8 bfr[8];
    const int gg = g4 & 1;
#pragma unroll
    for (int q = 0; q < 4; ++q) {
        const int st = 16 * q + cl;
        const float frs = __shfl(fr, st), fis = __shfl(fi, st);
        const size_t bo = (((size_t)layer * 32 + g) * 64 + st) * 16 + 8 * gg;
        const f32x4 r0 = *(const f32x4*)(p.in[I_BRE] + bo), r1 = *(const f32x4*)(p.in[I_BRE] + bo + 4), i0 = *(const f32x4*)(p.in[I_BIM] + bo), i1 = *(const f32x4*)(p.in[I_BIM] + bo + 4);
        const f32x4 a0 = frs * r0 - fis * i0, a1 = frs * r1 - fis * i1, c0 = frs * i0 + fis * r0, c1 = frs * i1 + fis * r1;
        u32x4 hre, him;
        hre.x = cvt_pk_bf16(a0.x, a0.y); hre.y = cvt_pk_bf16(a0.z, a0.w); hre.z = cvt_pk_bf16(a1.x, a1.y); hre.w = cvt_pk_bf16(a1.z, a1.w);
        him.x = cvt_pk_bf16(c0.x, c0.y); him.y = cvt_pk_bf16(c0.z, c0.w); him.z = cvt_pk_bf16(c1.x, c1.y); him.w = cvt_pk_bf16(c1.z, c1.w);
        if (g4 >= 2) { hre = (u32x4){0u, 0u, 0u, 0u}; him = hre; }
        bfr[q] = __builtin_bit_cast(bf16x8, hre); bfr[4 + q] = __builtin_bit_cast(bf16x8, him);
    }
    const bool cproj = mode != 0;
    bf16x8 cf[4];
    float dsk = 0.f;
    if (cproj) {
        const size_t co = (((size_t)layer * 32 + g) * 16 + cl) * 64;
#pragma unroll
        for (int ks = 0; ks < 4; ++ks) { const float* src = (ks < 2 ? p.in[I_CRE] : p.in[I_CIM]) + co + 32 * (ks & 1) + 8 * g4; const float sg = ks < 2 ? 1.0f : -1.0f;
            const f32x4 a = *(const f32x4*)src, c = *(const f32x4*)(src + 4);
            u32x4 o; o.x = cvt_pk_bf16(sg * a.x, sg * a.y); o.y = cvt_pk_bf16(sg * a.z, sg * a.w); o.z = cvt_pk_bf16(sg * c.x, sg * c.y); o.w = cvt_pk_bf16(sg * c.z, sg * c.w);
            cf[ks] = __builtin_bit_cast(bf16x8, o); }
        dsk = p.in[I_SD][layer * 512 + g * 16 + cl];
    }
    const int nblk = mode == 1 ? 1 : 4;
    bf16* Yg = (bf16*)(p.ws + WS_YG);
    const bf16* U = (const bf16*)(p.ws + WS_U);
    float* CH = (float*)(p.ws + WS_CH);
    for (int ci = 0; ci < nchunk; ++ci) {
    const int chunk = chunk0 + ci * cstride;
    const unsigned r0 = mode == 1 ? (unsigned)(TP + sq * 16) : (unsigned)(sq * SEQ + chunk * 64);
    float sr = 0.f, si = 0.f;
    const size_t cho = (((size_t)(sq * 32 + g)) * 256 + chunk) * 128;
    if (mode == 1) { const size_t so = (((size_t)layer * 16 + sq) * 32 + g) * 64 + lane; sr = p.in[I_SRE][so]; si = p.in[I_SIM][so]; }
    else if (mode == 2) { sr = CH[cho + lane]; si = CH[cho + 64 + lane]; }
    u32x4 ulq[4];
#pragma unroll
    for (int blk = 0; blk < 4; ++blk) if (blk < nblk) {
        ulq[blk] = *(const u32x4*)(U + (r0 + 16 * blk + cl) * 512u + g * 16 + 8 * gg);
    }
#pragma unroll
    for (int blk = 0; blk < 4; ++blk) if (blk < nblk) {
        u32x4 ua;
        ua = g4 < 2 ? ulq[blk] : (u32x4){0u, 0u, 0u, 0u};
        float ud[4];
        if (cproj) {
#pragma unroll
            for (int i = 0; i < 4; ++i) ud[i] = bf2f(U[(r0 + 16 * blk + 4 * g4 + i) * 512u + g * 16 + cl]);
        }
        const bf16x8 uf = __builtin_bit_cast(bf16x8, ua);
        f32x4 xs[8];
#pragma unroll
        for (int nt = 0; nt < 8; ++nt) {
            xs[nt] = __builtin_amdgcn_mfma_f32_16x16x32_bf16(uf, bfr[nt], (f32x4){0.f, 0.f, 0.f, 0.f}, 0, 0, 0);
        }
        __builtin_amdgcn_sched_barrier(0); asm volatile("s_nop 15\n\ts_nop 15" ::: "memory"); __builtin_amdgcn_sched_barrier(0);
#pragma unroll
        for (int nt = 0; nt < 8; ++nt) {
#pragma unroll
            for (int i = 0; i < 4; ++i) Xl[(4 * g4 + i) * 132 + 16 * nt + cl] = xs[nt][i];
        }
        asm volatile("s_waitcnt lgkmcnt(0)" ::: "memory"); __builtin_amdgcn_wave_barrier();
        float xrv[16], xiv[16];
#pragma unroll
        for (int t = 0; t < 16; ++t) { xrv[t] = Xl[t * 132 + lane]; xiv[t] = Xl[t * 132 + 64 + lane]; }
        asm volatile("s_waitcnt lgkmcnt(0)" ::: "memory");
#pragma unroll
        for (int t = 0; t < 16; ++t) {
            const float nsr = fmaf(abr, sr, fmaf(-abi, si, xrv[t])), nsi = fmaf(abr, si, fmaf(abi, sr, xiv[t]));
            sr = nsr; si = nsi;
            if (cproj) { const unsigned pk = cvt_pk_bf16(sr, si); Sl[t * 136 + lane] = (bf16)(pk & 0xffffu); Sl[t * 136 + 64 + lane] = (bf16)(pk >> 16); }
        }
        if (cproj) {
            asm volatile("s_waitcnt lgkmcnt(0)" ::: "memory"); __builtin_amdgcn_wave_barrier();
            f32x4 ya = (f32x4){0.f, 0.f, 0.f, 0.f};
#pragma unroll
            for (int ks = 0; ks < 4; ++ks) { const bf16x8 a = *(const LAS bf16x8*)(Sl + cl * 136 + 32 * ks + 8 * g4); ya = __builtin_amdgcn_mfma_f32_16x16x32_bf16(a, cf[ks], ya, 0, 0, 0); }
#pragma unroll
            for (int i = 0; i < 4; ++i) { const float y = ya[i] + dsk * ud[i]; Yg[(r0 + 16 * blk + 4 * g4 + i) * 512u + g * 16 + cl] = (bf16)f2bf(gelu_tanh(y)); }
        }
        asm volatile("s_waitcnt lgkmcnt(0)" ::: "memory"); __builtin_amdgcn_wave_barrier();
    }
    if (mode == 0) { CH[cho + lane] = sr; CH[cho + 64 + lane] = si; }
    else if (mode == 1) { const size_t so = (((size_t)layer * 16 + sq) * 32 + g) * 64 + lane; p.out[O_SRS + so] = sr; p.out[O_SIS + so] = si; }
    else if (chunk == 255) { const size_t so = (((size_t)layer * 2 + sq) * 32 + g) * 64 + lane; p.out[O_SRP + so] = sr; p.out[O_SIP + so] = si; }
    }
}
__device__ __forceinline__ void ssm_pass1_fast(const Params& p, int layer, int sq, int g, int chunk0, int nchunk, int cstride, int lane) {
    const int g4 = lane >> 4, cl = lane & 15, gg = g4 & 1;
    float abr, abi, fr, fi; ssm_disc(p, layer, g, lane, abr, abi, fr, fi);
    bf16x8 bfr[8];
    float ar[4], ai[4], Ar[4], Ai[4], wr_[4], wi_[4];
#pragma unroll
    for (int q = 0; q < 4; ++q) {
        const int st = 16 * q + cl;
        const float frs = __shfl(fr, st), fis = __shfl(fi, st);
        ar[q] = __shfl(abr, st); ai[q] = __shfl(abi, st);
        const size_t bo = (((size_t)layer * 32 + g) * 64 + st) * 16 + 8 * gg;
        const f32x4 r0 = *(const f32x4*)(p.in[I_BRE] + bo), r1 = *(const f32x4*)(p.in[I_BRE] + bo + 4), i0 = *(const f32x4*)(p.in[I_BIM] + bo), i1 = *(const f32x4*)(p.in[I_BIM] + bo + 4);
        const f32x4 a0 = frs * r0 - fis * i0, a1 = frs * r1 - fis * i1, c0 = frs * i0 + fis * r0, c1 = frs * i1 + fis * r1;
        u32x4 hre, him;
        hre.x = cvt_pk_bf16(a0.x, a0.y); hre.y = cvt_pk_bf16(a0.z, a0.w); hre.z = cvt_pk_bf16(a1.x, a1.y); hre.w = cvt_pk_bf16(a1.z, a1.w);
        him.x = cvt_pk_bf16(c0.x, c0.y); him.y = cvt_pk_bf16(c0.z, c0.w); him.z = cvt_pk_bf16(c1.x, c1.y); him.w = cvt_pk_bf16(c1.z, c1.w);
        if (g4 >= 2) { hre = (u32x4){0u, 0u, 0u, 0u}; him = hre; }
        bfr[q] = __builtin_bit_cast(bf16x8, hre); bfr[4 + q] = __builtin_bit_cast(bf16x8, him);
        const float a2r = ar[q] * ar[q] - ai[q] * ai[q], a2i = 2.0f * ar[q] * ai[q];
        const float a4r = a2r * a2r - a2i * a2i, a4i = 2.0f * a2r * a2i;
        const float a8r = a4r * a4r - a4i * a4i, a8i = 2.0f * a4r * a4i;
        Ar[q] = a8r * a8r - a8i * a8i; Ai[q] = 2.0f * a8r * a8i;
        const float a12r = a8r * a4r - a8i * a4i, a12i = a8r * a4i + a8i * a4r;
        wr_[q] = g4 == 3 ? 1.0f : g4 == 2 ? a4r : g4 == 1 ? a8r : a12r;
        wi_[q] = g4 == 3 ? 0.0f : g4 == 2 ? a4i : g4 == 1 ? a8i : a12i;
    }
    const bf16* U = (const bf16*)(p.ws + WS_U);
    float* CH = (float*)(p.ws + WS_CH);
    u32x4 unx[4];
#pragma unroll
    for (int blk = 0; blk < 4; ++blk) unx[blk] = *(const u32x4*)(U + ((unsigned)(sq * SEQ + chunk0 * 64) + 16 * blk + cl) * 512u + g * 16 + 8 * gg);
    for (int ci = 0; ci < nchunk; ++ci) {
        const int chunk = chunk0 + ci * cstride;
        u32x4 ulq[4];
#pragma unroll
        for (int blk = 0; blk < 4; ++blk) ulq[blk] = unx[blk];
        if (ci + 1 < nchunk) {
#pragma unroll
            for (int blk = 0; blk < 4; ++blk) unx[blk] = *(const u32x4*)(U + ((unsigned)(sq * SEQ + (chunk + cstride) * 64) + 16 * blk + cl) * 512u + g * 16 + 8 * gg);
        }
        float accr[4] = {0.f, 0.f, 0.f, 0.f}, acci[4] = {0.f, 0.f, 0.f, 0.f};
#pragma unroll
        for (int blk = 0; blk < 4; ++blk) {
            const bf16x8 uf = __builtin_bit_cast(bf16x8, g4 < 2 ? ulq[blk] : (u32x4){0u, 0u, 0u, 0u});
#pragma unroll
            for (int q = 0; q < 4; ++q) {
                const f32x4 xr = __builtin_amdgcn_mfma_f32_16x16x32_bf16(uf, bfr[q], (f32x4){0.f, 0.f, 0.f, 0.f}, 0, 0, 0);
                const f32x4 xi = __builtin_amdgcn_mfma_f32_16x16x32_bf16(uf, bfr[4 + q], (f32x4){0.f, 0.f, 0.f, 0.f}, 0, 0, 0);
                float er = xr[0], ei = xi[0];
#pragma unroll
                for (int i = 1; i < 4; ++i) { const float nr = fmaf(ar[q], er, fmaf(-ai[q], ei, xr[i])), ni = fmaf(ar[q], ei, fmaf(ai[q], er, xi[i])); er = nr; ei = ni; }
                const float nr = fmaf(Ar[q], accr[q], fmaf(-Ai[q], acci[q], er)), ni = fmaf(Ar[q], acci[q], fmaf(Ai[q], accr[q], ei));
                accr[q] = nr; acci[q] = ni;
            }
        }
        float outr = 0.f, outi = 0.f;
#pragma unroll
        for (int q = 0; q < 4; ++q) {
            float zr = wr_[q] * accr[q] - wi_[q] * acci[q], zi = wr_[q] * acci[q] + wi_[q] * accr[q];
            zr += __shfl_xor(zr, 16); zr += __shfl_xor(zr, 32); zi += __shfl_xor(zi, 16); zi += __shfl_xor(zi, 32);
            if (g4 == q) { outr = zr; outi = zi; }
        }
        const size_t cho = (((size_t)(sq * 32 + g)) * 256 + chunk) * 128;
        CH[cho + lane] = outr; CH[cho + 64 + lane] = outi;
    }
}
__device__ __forceinline__ void ssm_phase(const Params& p, int layer, int pass3, LAS unsigned char* lds, int bid, int tid) {
    asm volatile("" : "+v"(tid));
    const int lane = tid & 63, wave = tid >> 6; LAS unsigned char* wl = lds + wave * 12800;
    const int gw = bid * 8 + wave;
    { const int sqg = gw >> 5;
      if (pass3) ssm_task_v2(p, layer, 2, sqg >> 5, sqg & 31, gw & 31, 8, 32, lane, wl);
      else ssm_pass1_fast(p, layer, sqg >> 5, sqg & 31, gw & 31, 8, 32, lane); }
    if (!pass3 && gw >= 1536) { const int sg = gw - 1536; ssm_task_v2(p, layer, 1, sg >> 5, sg & 31, 0, 1, 1, lane, wl); }
}
__device__ __forceinline__ void carry_phase(const Params& p, int layer, int bid, int tid) {
    asm volatile("" : "+v"(tid));
    const int lane = tid & 63, wave = tid >> 6, gw = bid * 8 + wave;
    if (gw >= 64) return;
    float abr, abi, fr, fi; ssm_disc(p, layer, gw & 31, lane, abr, abi, fr, fi);
    float ar = abr, ai = abi;
#pragma unroll
    for (int i = 0; i < 6; ++i) { const float nr = ar * ar - ai * ai, ni = 2.0f * ar * ai; ar = nr; ai = ni; }
    float* CH = (float*)(p.ws + WS_CH) + (size_t)gw * 256 * 128;
    float cr = 0.f, ci = 0.f;
    for (int c0 = 0; c0 < 256; c0 += 32) {
        float fr8[32], fi8[32];
#pragma unroll
        for (int j = 0; j < 32; ++j) { fr8[j] = CH[(c0 + j) * 128 + lane]; fi8[j] = CH[(c0 + j) * 128 + 64 + lane]; }
#pragma unroll
        for (int j = 0; j < 32; ++j) { CH[(c0 + j) * 128 + lane] = cr; CH[(c0 + j) * 128 + 64 + lane] = ci;
            const float nr = fmaf(ar, cr, fmaf(-ai, ci, fr8[j])), ni = fmaf(ar, ci, fmaf(ai, cr, fi8[j])); cr = nr; ci = ni; }
    }
}

__device__ __forceinline__ void attn_phase(const Params& p, int layer, LAS unsigned char* lds, int bid, int tid) {
    asm volatile("" : "+v"(tid));
    const int lane = tid & 63, wave = tid >> 6, g4 = lane >> 4, cl = lane & 15;
    LAS bf16* Kl = (LAS bf16*)lds;
    LAS bf16* Vt = (LAS bf16*)(lds + 27648);
    const bf16* Qb = (const bf16*)(p.ws + WS_Q); const bf16* Kb = (const bf16*)(p.ws + WS_K); const bf16* Vb = (const bf16*)(p.ws + WS_V);
    bf16* Ob = (bf16*)(p.ws + WS_O);
    u32x4 pk[3], pv[3];
#define ATT_LOAD(TKX) do { const int tk_ = (TKX); const bool smp_ = tk_ >= 1024; \
        const int b_ = smp_ ? (tk_ - 1024) >> 1 : tk_ >> 9, n_ = smp_ ? 0 : (tk_ >> 1) & 255, kvh_ = tk_ & 1; \
        _Pragma("unroll") for (int i = 0; i < 3; ++i) { \
            const int idx = tid + NTHR * i, key = idx >> 3, c8 = idx & 7; \
            u32x4 kv = (u32x4){0u, 0u, 0u, 0u}, vv = (u32x4){0u, 0u, 0u, 0u}; \
            if (!smp_) { \
                const int pos = 64 * (n_ - 2) + key; \
                if (pos >= 0) { const size_t o = ((size_t)b_ * SEQ + pos) * 128 + kvh_ * 64 + 8 * c8; kv = *(const u32x4*)(Kb + o); vv = *(const u32x4*)(Vb + o); } \
            } else if (key < 128) { \
                const size_t o = ((((size_t)layer * 16 + b_) * 128 + key) * 2 + kvh_) * 64 + 8 * c8; \
                const f32x4 k0 = *(const f32x4*)(p.in[I_CK] + o), k1 = *(const f32x4*)(p.in[I_CK] + o + 4), v0 = *(const f32x4*)(p.in[I_CV] + o), v1 = *(const f32x4*)(p.in[I_CV] + o + 4); \
                kv.x = cvt_pk_bf16(k0.x, k0.y); kv.y = cvt_pk_bf16(k0.z, k0.w); kv.z = cvt_pk_bf16(k1.x, k1.y); kv.w = cvt_pk_bf16(k1.z, k1.w); \
                vv.x = cvt_pk_bf16(v0.x, v0.y); vv.y = cvt_pk_bf16(v0.z, v0.w); vv.z = cvt_pk_bf16(v1.x, v1.y); vv.w = cvt_pk_bf16(v1.z, v1.w); \
            } else if (key < 144) { \
                const size_t o = ((size_t)TP + b_ * 16 + (key - 128)) * 128 + kvh_ * 64 + 8 * c8; kv = *(const u32x4*)(Kb + o); vv = *(const u32x4*)(Vb + o); \
            } \
            pk[i] = kv; pv[i] = vv; } } while (0)
    ATT_LOAD(bid);
    for (int tk = bid; tk < 1024 + 32; tk += NWG) {
        const bool smp = tk >= 1024;
        const int b = smp ? (tk - 1024) >> 1 : tk >> 9, n = smp ? 0 : (tk >> 1) & 255, kvh = tk & 1;
        __syncthreads();
#pragma unroll
        for (int i = 0; i < 3; ++i) {
            const int idx = tid + NTHR * i, key = idx >> 3, c8 = idx & 7;
            const u32x4 kv = pk[i], vv = pv[i];
            *(LAS u32x4*)(Kl + key * 72 + 8 * c8) = kv;
            LAS bf16* vd = Vt + (8 * c8) * 200 + key;
            vd[0] = (bf16)(vv.x & 0xffffu); vd[200] = (bf16)(vv.x >> 16); vd[400] = (bf16)(vv.y & 0xffffu); vd[600] = (bf16)(vv.y >> 16);
            vd[800] = (bf16)(vv.z & 0xffffu); vd[1000] = (bf16)(vv.z >> 16); vd[1200] = (bf16)(vv.w & 0xffffu); vd[1400] = (bf16)(vv.w >> 16);
        }
        __syncthreads();
        if (tk + NWG < 1024 + 32) ATT_LOAD(tk + NWG);
        const int gh = wave & 3, qh = wave >> 2, h = kvh * 4 + gh;
        if (smp && qh == 1) continue;
        const int nq = smp ? 16 : 32;
        const size_t qrow0 = smp ? (size_t)TP + b * 16 : (size_t)b * SEQ + 64 * n + 32 * qh;
        bf16x8 qf[2][2];
#pragma unroll
        for (int nt = 0; nt < 2; ++nt) { int qi = 16 * nt + cl; if (qi >= nq) qi = nq - 1;
#pragma unroll
            for (int ks = 0; ks < 2; ++ks) qf[nt][ks] = *(const bf16x8*)(Qb + (qrow0 + qi) * 512 + h * 64 + 32 * ks + 8 * g4); }
        f32x4 s[12][2];
#pragma unroll
        for (int mt = 0; mt < 12; ++mt) {
            s[mt][0] = (f32x4){0.f, 0.f, 0.f, 0.f}; s[mt][1] = (f32x4){0.f, 0.f, 0.f, 0.f};
#pragma unroll
            for (int ks = 0; ks < 2; ++ks) { const bf16x8 a = *(const LAS bf16x8*)(Kl + (16 * mt + cl) * 72 + 32 * ks + 8 * g4);
                s[mt][0] = __builtin_amdgcn_mfma_f32_16x16x32_bf16(a, qf[0][ks], s[mt][0], 0, 0, 0);
                s[mt][1] = __builtin_amdgcn_mfma_f32_16x16x32_bf16(a, qf[1][ks], s[mt][1], 0, 0, 0); }
            const bool valid = smp ? (mt < 9) : (n - 2 + (mt >> 2) >= 0);
            if (!valid) { s[mt][0] = (f32x4){-1e30f, -1e30f, -1e30f, -1e30f}; s[mt][1] = s[mt][0]; }
        }
        const float sink = p.in[I_SINK][layer * 8 + h];
        float inv[2];
#pragma unroll
        for (int nt = 0; nt < 2; ++nt) {
            float mx = sink;
#pragma unroll
            for (int mt = 0; mt < 12; ++mt) mx = fmaxf(mx, fmaxf(fmaxf(s[mt][nt].x, s[mt][nt].y), fmaxf(s[mt][nt].z, s[mt][nt].w)));
            mx = fmaxf(mx, __shfl_xor(mx, 16)); mx = fmaxf(mx, __shfl_xor(mx, 32));
            float sum = 0.f;
#pragma unroll
            for (int mt = 0; mt < 12; ++mt) {
#pragma unroll
                for (int e = 0; e < 4; ++e) { const float pe = __expf(s[mt][nt][e] - mx); s[mt][nt][e] = pe; sum += pe; } }
            sum += __shfl_xor(sum, 16); sum += __shfl_xor(sum, 32);
            inv[nt] = 1.0f / (sum + __expf(sink - mx));
        }
        f32x4 o[4][2];
#pragma unroll
        for (int dt = 0; dt < 4; ++dt) { o[dt][0] = (f32x4){0.f, 0.f, 0.f, 0.f}; o[dt][1] = (f32x4){0.f, 0.f, 0.f, 0.f}; }
#pragma unroll
        for (int ks = 0; ks < 6; ++ks) {
            bf16x8 pf[2];
#pragma unroll
            for (int nt = 0; nt < 2; ++nt) { u32x4 t; t.x = cvt_pk_bf16(s[2 * ks][nt].x, s[2 * ks][nt].y); t.y = cvt_pk_bf16(s[2 * ks][nt].z, s[2 * ks][nt].w);
                t.z = cvt_pk_bf16(s[2 * ks + 1][nt].x, s[2 * ks + 1][nt].y); t.w = cvt_pk_bf16(s[2 * ks + 1][nt].z, s[2 * ks + 1][nt].w); pf[nt] = __builtin_bit_cast(bf16x8, t); }
#pragma unroll
            for (int dt = 0; dt < 4; ++dt) {
                const LAS bf16* vp = Vt + (16 * dt + cl) * 200 + 32 * ks + 4 * g4;
                const u32x2 lo = *(const LAS u32x2*)vp, hi = *(const LAS u32x2*)(vp + 16);
                const bf16x8 a = __builtin_bit_cast(bf16x8, (u32x4){lo.x, lo.y, hi.x, hi.y});
                o[dt][0] = __builtin_amdgcn_mfma_f32_16x16x32_bf16(a, pf[0], o[dt][0], 0, 0, 0);
                o[dt][1] = __builtin_amdgcn_mfma_f32_16x16x32_bf16(a, pf[1], o[dt][1], 0, 0, 0);
            }
        }
#pragma unroll
        for (int nt = 0; nt < 2; ++nt) { const int qi = 16 * nt + cl;
            if (qi < nq) {
#pragma unroll
                for (int dt = 0; dt < 4; ++dt) st_bf4(Ob + (qrow0 + qi) * 512 + h * 64 + 16 * dt + 4 * g4, o[dt][nt] * inv[nt]); } }
    }
    __syncthreads();
}

__global__ void __launch_bounds__(512, 2) fwd(Params p) {
    extern __shared__ __attribute__((aligned(16))) unsigned char lds_raw[];
    LAS unsigned char* lds = (LAS unsigned char*)lds_raw;
    cg::grid_group grid = cg::this_grid();
    const int bid = blockIdx.x, tid = threadIdx.x, G = gridDim.x;
    unsigned char* ws = p.ws;
    float* X = p.out;
    bf16* H = (bf16*)(ws + WS_H);
    const float* modall = (const float*)(ws + WS_MOD);
    if (tid < 16) ((volatile LAS unsigned*)(lds + MISC_OFF))[tid] = 0u;
    __syncthreads();
    const xb::XcdBarrier bar = xb::xcd_barrier_post((unsigned*)(ws + WS_BAR), (volatile LAS unsigned*)(lds + MISC_OFF));
#define GSYNC() xb::xcd_barrier(bar)

#if !defined(ONLY) || ONLY == 0
    REPK(10) { p0_prologue(p, lds, bid, tid); if (PROBE == 10) { asm volatile("s_waitcnt vmcnt(0) lgkmcnt(0)" ::: "memory"); __syncthreads(); } }
    if (PROBE == 7 || PROBE == 8) { float* zr = (float*)(ws + WS_ZERO); for (int i = bid * NTHR + tid; i < 18 * NADA; i += NWG * NTHR) zr[i] = 0.f; }
#endif
    grid.sync();
    for (int layer = 0; layer < DEPTH; ++layer) {
        unsigned char* wl = ws + WS_W + (size_t)layer * W_L;
        const float* modl = modall + (size_t)layer * 18 * NADA;
#if !defined(ONLY) || ONLY == 1
        REPK(4) norm_phase(p, layer, 0, bid, tid);
#endif
        GSYNC();
#if !defined(ONLY) || ONLY == 2
        REPK(1) { Gemm g{H, (const bf16*)(wl + W_IN), MT, INC, D}; StaticOrder S; S.init(MT, INC, G, bid);
          EpiWin E{(bf16*)(ws + WS_U), (bf16*)(ws + WS_Q), (bf16*)(ws + WS_K), (bf16*)(ws + WS_V), (bf16*)(ws + WS_G), (const float*)(ws + WS_ROPE), p.out, layer};
          pg8::gemm_phase<EpiWin, StaticOrder, 0>(lds, g, S, E, nullptr); }
        GSYNC();
#endif
#if !defined(ONLY) || ONLY == 3
        REPK(2) ssm_phase(p, layer, 0, lds, bid, tid);
#endif
#if !defined(ONLY) || ONLY == 4
        REPK(3) attn_phase(p, layer, lds, bid, tid);
#endif
        GSYNC();
#if !defined(ONLY) || ONLY == 5
        carry_phase(p, layer, bid, tid);
        REPK(9) { Gemm g{(const bf16*)(ws + WS_O), (const bf16*)(wl + W_O), TP, D, 512}; StaticOrder S; S.init(TP, D, G, bid);
          EpiAttnO E{(const bf16*)(ws + WS_G), (bf16*)(ws + WS_P)};
          pg8::gemm_phase<EpiAttnO, StaticOrder, 0>(lds, g, S, E, nullptr);
          small_gemm<4>(g.A + (size_t)TP * 512, g.Bt, D, 512, TP, E, lds, bid, tid); }
        GSYNC();
#endif
#if !defined(ONLY) || ONLY == 3
        REPK(2) ssm_phase(p, layer, 1, lds, bid, tid);
#endif
        GSYNC();
#if !defined(ONLY) || ONLY == 6
        { Gemm g{(const bf16*)(ws + WS_YG), (const bf16*)(wl + W_GLU), TP, 2048, 512}; StaticOrder S; S.init(TP, 2048, G, bid);
          EpiGlu E{(const bf16*)(ws + WS_G), (bf16*)(ws + WS_P)};
          pg8::gemm_phase<EpiGlu, StaticOrder, 0>(lds, g, S, E, nullptr);
          small_gemm<2>(g.A + (size_t)TP * 512, g.Bt, 2048, 512, TP, E, lds, bid, tid); }
        GSYNC();
#endif
#if !defined(ONLY) || ONLY == 7
        { Gemm g{(const bf16*)(ws + WS_P), (const bf16*)(wl + W_OUT), TP, D, D}; StaticOrder S; S.init(TP, D, G, bid);
          EpiRes E{layer == 0 ? p.in[I_XP] : X, X, modl + 2048};
          pg8::gemm_phase<EpiRes, StaticOrder, 0>(lds, g, S, E, nullptr);
          EpiRes Es{layer == 0 ? p.in[I_XS] - (size_t)TP * D : X, X, modl + 2048};
          small_gemm<4>(g.A + (size_t)TP * D, g.Bt, D, D, TP, Es, lds, bid, tid); }
        GSYNC();
#endif
#if !defined(ONLY) || ONLY == 1
        REPK(4) norm_phase(p, layer, 1, bid, tid);
#endif
        GSYNC();
#if !defined(ONLY) || ONLY == 9
        REPK(5) { Gemm g{H, (const bf16*)(wl + W_UP), UP_TILES * 256, FF2, D}; StaticOrder S; S.init(UP_TILES * 256, FF2, G, bid);
          EpiUp<false> E{(bf16*)(ws + WS_ACT), p.in[I_CW] + (size_t)layer * 3 * FF2, p.in[I_CB] + (size_t)layer * FF2, nullptr, p.out, layer};
          pg8::gemm_phase<EpiUp<false>, StaticOrder, 1>(lds, g, S, E, nullptr); }
        { Gemm g{H + (size_t)HS_SAMPLE * D, (const bf16*)(wl + W_UP), 256, FF2, D}; StaticOrder S; S.init(256, FF2, G, G - 1 - bid);
          EpiUp<true> E{(bf16*)(ws + WS_ACT), p.in[I_CW] + (size_t)layer * 3 * FF2, p.in[I_CB] + (size_t)layer * FF2, p.in[I_SCONV] + (size_t)layer * 16 * 2 * FF2, p.out, layer};
          pg8::gemm_phase<EpiUp<true>, StaticOrder, 0>(lds, g, S, E, nullptr); }
        GSYNC();
#endif
        if (PROBE == 6) { for (int i_ = 0; i_ < 10; ++i_) GSYNC(); }
#if !defined(ONLY) || ONLY == 10
        { Gemm g{(const bf16*)(ws + WS_ACT), (const bf16*)(wl + W_DN), TP, D, FF}; StaticOrder S; S.init(TP, D, G, bid);
          EpiRes E{X, X, modl + 5120};
          pg8::gemm_phase<EpiRes, StaticOrder, 0>(lds, g, S, E, nullptr);
          small_gemm<4>(g.A + (size_t)TP * FF, g.Bt, D, FF, TP, E, lds, bid, tid); }
#endif
        GSYNC();
    }
#if !defined(ONLY) || ONLY == 1
    norm_phase(p, 0, 2, bid, tid);
#endif
}
}

extern "C" void kernel_launch(void* const* d_in, const int* in_sizes, int n_in, void* d_out, int out_size, void* d_ws, size_t ws_size, hipStream_t stream) {
    static int ok = 0;
    if (ok == 0) {
        ok = 1;
        if (n_in != 31 || (size_t)out_size != mk::O_END || ws_size < mk::WS_BAR + mk::BAR_BYTES) { fprintf(stderr, "kernel_launch: unexpected shapes n_in %d out %d ws %zu (need %zu)\n", n_in, out_size, ws_size, (size_t)mk::WS_END); ok = -1; }
        if (hipFuncSetAttribute((const void*)mk::fwd, hipFuncAttributeMaxDynamicSharedMemorySize, mk::LDS_BYTES) != hipSuccess) { fprintf(stderr, "kernel_launch: hipFuncSetAttribute failed\n"); ok = -1; }
        int per_cu = 0;
        if (hipOccupancyMaxActiveBlocksPerMultiprocessor(&per_cu, (const void*)mk::fwd, mk::NTHR, mk::LDS_BYTES) != hipSuccess || per_cu < 1) fprintf(stderr, "kernel_launch: occupancy query says %d blocks per CU\n", per_cu);
        (void)hipGetLastError();
    }
    if (ok < 0) return;
    if (hipMemsetAsync((char*)d_ws + mk::WS_BAR, 0, mk::BAR_BYTES, stream) != hipSuccess) { fprintf(stderr, "kernel_launch: memset of the barrier words failed\n"); return; }
    mk::Params p{};
    for (int i = 0; i < 31; ++i) p.in[i] = (const float*)d_in[i];
    p.out = (float*)d_out; p.ws = (unsigned char*)d_ws;
    void* args[] = {&p};
    hipError_t e = hipLaunchCooperativeKernel((void*)mk::fwd, dim3(mk::NWG), dim3(mk::NTHR), args, mk::LDS_BYTES, stream);
    if (e != hipSuccess) fprintf(stderr, "kernel_launch: cooperative launch failed: %s\n", hipGetErrorString(e));
}
```

```cpp
#include <hip/hip_runtime.h>
#include <hip/hip_cooperative_groups.h>
#include <cstdio>
#include <cstdint>
namespace cg = cooperative_groups;
namespace pg8 {
#define PG8_LAS __attribute__((address_space(3)))
typedef unsigned short bf16_t;
typedef short bf16x8 __attribute__((ext_vector_type(8)));
typedef float f32x4 __attribute__((ext_vector_type(4)));
typedef unsigned u32x4 __attribute__((ext_vector_type(4)));
constexpr int BM = 256, BK = 64, HALF = 128, HTB = HALF * BK * 2  , STAGE_BYTES = 8 * HTB, NXCD = 8, WGM = 8;

__host__ __device__ __forceinline__ int lds_byte(int r, int c) { const int st = (r >> 4) * 2 + (c >> 5), rr = r & 15, cc = c & 31, ob = rr * 64 + cc * 2; return st * 1024 + (ob ^ (((ob >> 9) & 1) << 5)); }
__host__ __device__ __forceinline__ void stage_rc(int b, int& R, int& C) { const int st = b / 1024, sb = b % 1024, swz = sb ^ (((sb >> 9) & 1) << 5); R = (st >> 1) * 16 + swz / 64; C = (st & 1) * 32 + (swz % 64) / 2; }
__host__ __device__ __forceinline__ int perm32(int rho) { const int n = rho >> 4, i = rho & 15; return 8 * (i >> 2) + 4 * n + (i & 3); }

struct Unit { int pm, pn; };
struct Gemm { const bf16_t* A; const bf16_t* Bt; int M, N, K; };
struct StaticOrder {
    int nM, nN, nwg, G, c;
    __host__ __device__ void init(int M, int N, int G_, int c_) { nM = M / BM; nN = N / BM; nwg = nM * nN; G = G_; c = c_; }
    __host__ __device__ bool next(int i, Unit& u) const {
        const long L = (long)i * G + c; if (L >= nwg) return false;
        int wgid = (int)L; { const int q = nwg / NXCD, r = nwg % NXCD, xcd = wgid % NXCD, off = wgid / NXCD; wgid = (xcd < r ? xcd * (q + 1) : r * (q + 1) + (xcd - r) * q) + off; }
        const int nig = WGM * nN, gid = wgid / nig, fm = gid * WGM, gsz = (nM - fm) < WGM ? (nM - fm) : WGM;
        u.pm = fm + ((wgid % nig) % gsz); u.pn = (wgid % nig) / gsz; return true;
    }
    __device__ __forceinline__ void a_ready(const Unit&) const {}
    __device__ __forceinline__ void done(const Unit&) const {}
};
__device__ __forceinline__ unsigned cvt_pk_bf16(float lo, float hi) { unsigned r; asm volatile("v_cvt_pk_bf16_f32 %0, %1, %2" : "=v"(r) : "v"(lo), "v"(hi)); return r; }
template <class Epi, class Sched, int AMAP = 0, bool STAMP = false>
__device__ __forceinline__ void gemm_phase(PG8_LAS unsigned char* lds, const Gemm g, const Sched& S, const Epi& E, unsigned long long* stamps) {
    int tid_o = threadIdx.x; asm volatile("" : "+v"(tid_o)); const int tid = tid_o, wid = __builtin_amdgcn_readfirstlane(tid >> 6), lane = tid & 63, wr = wid >> 2, wc = wid & 3, fr = lane & 15, fq = lane >> 4;
    const int K = g.K, nt = K / BK;
    int ts_lo = 0, ts_hi = 0, nts = 0; const unsigned long long rt_entry = STAMP ? (unsigned long long)0ull : 0ull;
#define PG8_STAMP() do { if (STAMP && wid == 0 && nts < 64) { const unsigned long long _c = (unsigned long long)0ull; \
        ts_lo = (lane == nts) ? (int)(unsigned)_c : ts_lo; ts_hi = (lane == nts) ? (int)(unsigned)(_c >> 32) : ts_hi; ++nts; } } while (0)
    PG8_STAMP();
    unsigned voffA[2], voffB[2];
#pragma unroll
    for (int i = 0; i < 2; ++i) { int R, C; stage_rc(tid * 16 + i * 8192, R, C); const int Rb = Epi::PERM ? ((R & ~31) + perm32(R & 31)) : R;
        const int Ra = AMAP ? ((R >> 6) * 62 + (R & 63)) : R; voffA[i] = (unsigned)(Ra * K + C) * 2u; voffB[i] = (unsigned)(Rb * K + C) * 2u; }
    const size_t kstep = (size_t)(BK * 2);
    const size_t hstep = (size_t)HALF * K * 2;
    const size_t tstep = 2 * hstep; const size_t hstepA = AMAP ? (size_t)124 * K * 2 : hstep; const size_t tstepA = 2 * hstepA;
    const unsigned ldsw = (unsigned)wid * 1024u;
    const int aoff = lds_byte(wr * 64 + fr, fq * 8), boff = lds_byte(wc * 32 + fr, fq * 8);
#define PG8_SA(b, h) (((b) * 2 + (h)) * HTB)
#define PG8_SB(b, h) ((4 + (b) * 2 + (h)) * HTB)
#define PG8_STAGE(bufoff, gbase, voff) do { _Pragma("unroll") for (int _i = 0; _i < 2; ++_i) \
        __builtin_amdgcn_global_load_lds((const unsigned*)((const char*)(gbase) + (voff)[_i]), (PG8_LAS unsigned*)(lds + (bufoff) + ldsw + _i * 8192), 16, 0, 0); } while (0)
#define PG8_LDA(dst, b, h) do { _Pragma("unroll") for (int m = 0; m < 4; ++m) _Pragma("unroll") for (int k = 0; k < 2; ++k) dst[m][k] = *(const PG8_LAS bf16x8*)(lds + PG8_SA(b, h) + aoff + m * 2048 + k * 1024); } while (0)
#define PG8_LDB(dst, b, h) do { _Pragma("unroll") for (int n = 0; n < 2; ++n) _Pragma("unroll") for (int k = 0; k < 2; ++k) dst[n][k] = *(const PG8_LAS bf16x8*)(lds + PG8_SB(b, h) + boff + n * 2048 + k * 1024); } while (0)
#define PG8_MMA(ai, bj, At, Bt) do { __builtin_amdgcn_s_setprio(1); _Pragma("unroll") for (int m = 0; m < 4; ++m) _Pragma("unroll") for (int n = 0; n < 2; ++n) _Pragma("unroll") for (int k = 0; k < 2; ++k) \
        acc[ai][bj][m][n] = __builtin_amdgcn_mfma_f32_16x16x32_bf16(Bt[n][k], At[m][k], acc[ai][bj][m][n], 0, 0, 0); __builtin_amdgcn_s_setprio(0); } while (0)
#define PG8_WAIT_V(n) asm volatile("s_waitcnt vmcnt(" #n ")" ::: "memory")
#define PG8_WAIT_L(n) asm volatile("s_waitcnt lgkmcnt(" #n ")" ::: "memory")
#define PG8_BAR __builtin_amdgcn_s_barrier()
#define PG8_SCHED __builtin_amdgcn_sched_barrier(0)
    Unit cur, nxt; int ui = 0;
    if (!S.next(0, cur)) return;
    f32x4 acc[2][2][4][2];
#pragma unroll
    for (int a = 0; a < 2; ++a)
#pragma unroll
        for (int b = 0; b < 2; ++b)
#pragma unroll
            for (int m = 0; m < 4; ++m)
#pragma unroll
                for (int n = 0; n < 2; ++n) acc[a][b][m][n] = (f32x4){0.f, 0.f, 0.f, 0.f};
    bf16x8 At[4][2], B0[2][2], B1[2][2];
    const char* cA = (const char*)g.A + (size_t)cur.pm * tstepA; const char* cB = (const char*)g.Bt + (size_t)cur.pn * tstep;
    S.a_ready(cur);
    PG8_STAGE(PG8_SB(0, 0), cB, voffB); PG8_STAGE(PG8_SA(0, 0), cA, voffA); PG8_STAGE(PG8_SB(0, 1), cB + hstep, voffB); PG8_STAGE(PG8_SA(0, 1), cA + hstepA, voffA);
    if (wr == 1) PG8_BAR;
    PG8_WAIT_V(4); PG8_BAR;
    PG8_STAGE(PG8_SB(1, 0), cB + kstep, voffB); PG8_STAGE(PG8_SA(1, 0), cA + kstep, voffA); PG8_STAGE(PG8_SB(1, 1), cB + hstep + kstep, voffB);
    PG8_WAIT_V(6); PG8_BAR;
    PG8_STAMP();
    for (;;) {
        const bool has_next = S.next(ui + 1, nxt);
        const char* nA = has_next ? (const char*)g.A + (size_t)nxt.pm * tstepA : cA; const char* nB = has_next ? (const char*)g.Bt + (size_t)nxt.pn * tstep : cB;
        for (int t = 0; t < nt; t += 2) {
            const bool last = (t == nt - 2);
            const char* a1 = cA + (size_t)(t + 1) * kstep;
            const char* a2 = last ? nA : cA + (size_t)(t + 2) * kstep; const char* b2 = last ? nB : cB + (size_t)(t + 2) * kstep;
            const char* a3 = a2 + kstep; const char* b3 = b2 + kstep;
            if (last && has_next) S.a_ready(nxt);
            PG8_LDB(B0, 0, 0); PG8_SCHED; PG8_LDA(At, 0, 0); PG8_STAGE(PG8_SA(1, 1), a1 + hstepA, voffA);
            PG8_WAIT_L(8); PG8_BAR; PG8_WAIT_L(0); PG8_MMA(0, 0, At, B0); PG8_BAR; PG8_SCHED;
            PG8_LDB(B1, 0, 1); PG8_STAGE(PG8_SB(0, 0), b2, voffB);
            PG8_BAR; PG8_WAIT_L(0); PG8_MMA(0, 1, At, B1); PG8_BAR;
            PG8_LDA(At, 0, 1); PG8_STAGE(PG8_SA(0, 0), a2, voffA);
            PG8_BAR; PG8_WAIT_L(0); PG8_MMA(1, 0, At, B0); PG8_BAR; PG8_SCHED;
            PG8_STAGE(PG8_SB(0, 1), b2 + hstep, voffB);
            PG8_WAIT_V(6); PG8_BAR; PG8_MMA(1, 1, At, B1); PG8_BAR;
            PG8_LDB(B0, 1, 0); PG8_SCHED; PG8_LDA(At, 1, 0); PG8_STAGE(PG8_SA(0, 1), a2 + hstepA, voffA);
            PG8_WAIT_L(8); PG8_BAR; PG8_WAIT_L(0); PG8_MMA(0, 0, At, B0); PG8_BAR; PG8_SCHED;
            PG8_LDB(B1, 1, 1); PG8_STAGE(PG8_SB(1, 0), b3, voffB);
            PG8_BAR; PG8_WAIT_L(0); PG8_MMA(0, 1, At, B1); PG8_BAR;
            PG8_LDA(At, 1, 1); PG8_STAGE(PG8_SA(1, 0), a3, voffA);
            PG8_BAR; PG8_WAIT_L(0); PG8_MMA(1, 0, At, B0); PG8_BAR; PG8_SCHED;
            PG8_STAGE(PG8_SB(1, 1), b3 + hstep, voffB);
            PG8_WAIT_V(6); PG8_BAR; PG8_MMA(1, 1, At, B1); PG8_BAR;
        }
        PG8_STAMP();
        if constexpr (!Epi::AFTER_DRAIN) { E(acc, cur, wr, wc, fr, fq); S.done(cur); }
        PG8_STAMP();
        if (!has_next) break;
#pragma unroll
        for (int a = 0; a < 2; ++a)
#pragma unroll
            for (int b = 0; b < 2; ++b)
#pragma unroll
                for (int m = 0; m < 4; ++m)
#pragma unroll
                    for (int n = 0; n < 2; ++n) acc[a][b][m][n] = (f32x4){0.f, 0.f, 0.f, 0.f};
        cur = nxt; cA = nA; cB = nB; ++ui;
    }
    PG8_WAIT_V(0);
    if (wr == 0) PG8_BAR;
    PG8_BAR;
    if constexpr (Epi::AFTER_DRAIN) { E.fused(acc, cur, wr, wc, fr, fq, lds, wid, lane); S.done(cur); }
    PG8_STAMP();
    if (STAMP && wid == 0) { stamps[lane] = lane < nts ? (((unsigned long long)(unsigned)ts_hi << 32) | (unsigned)ts_lo) : 0ull;
        if (lane == 62) stamps[62] = rt_entry; if (lane == 63) stamps[63] = (unsigned long long)0ull; }
#undef PG8_STAMP
#undef PG8_SA
#undef PG8_SB
#undef PG8_STAGE
#undef PG8_LDA
#undef PG8_LDB
#undef PG8_MMA
#undef PG8_WAIT_V
#undef PG8_WAIT_L
#undef PG8_BAR
#undef PG8_SCHED
}
}
namespace xb {
#define XB_TMO      128
#define XB_XCNT(j)  (256  + 64 * (j))
#define XB_XSUB(j)  (1280 + 64 * (j))
#define XB_XGEN(j)  (2304 + 64 * (j))
#define XB_TOP      3328
#define XB_TOPGEN   3392
#define XCD_BAR_WORDS 3456
#define XB_SPIN_CAP (1u << 18)

__device__ __forceinline__ unsigned xb_ld(unsigned* p)              { return __hip_atomic_load(p, __ATOMIC_RELAXED, __HIP_MEMORY_SCOPE_AGENT); }
__device__ __forceinline__ unsigned xb_add(unsigned* p, unsigned v) { return __hip_atomic_fetch_add(p, v, __ATOMIC_RELAXED, __HIP_MEMORY_SCOPE_AGENT); }
__device__ __forceinline__ unsigned xb_xcc_id() { return (unsigned)__builtin_amdgcn_s_getreg((3 << 11) | 20) & 0xFu; }
#define XB_SPIN(cond, bar) do { unsigned _sp = 0; while (cond) { __builtin_amdgcn_s_sleep(1); \
    if ((++_sp & 255u) == 0u) { if (xb_ld(&(bar)[XB_TMO])) break; if (_sp > XB_SPIN_CAP) { atomicAdd(&(bar)[XB_TMO], 1u); break; } } } } while (0)

struct XcdBarrier {
    unsigned* bar; unsigned x;
    volatile __attribute__((address_space(3))) unsigned* st;
};

__device__ __forceinline__ XcdBarrier xcd_barrier_post(unsigned* bar, volatile __attribute__((address_space(3))) unsigned* st) {
    XcdBarrier b; b.bar = bar; b.x = xb_xcc_id(); b.st = st;
    if (threadIdx.x == 0) (void)xb_add(&bar[XB_XCNT(b.x)], 1u);
    return b;
}
__device__ __forceinline__ void xcd_barrier_complete(unsigned* bar, unsigned x, unsigned& nloc, unsigned& nx) {
    const unsigned G = gridDim.x * gridDim.y * gridDim.z;
    unsigned sum, cnt, mine, sp = 0u;
    for (;;) {
        sum = 0u; cnt = 0u; mine = 0u;
#pragma unroll
        for (unsigned j = 0; j < 16; ++j) { const unsigned c = xb_ld(&bar[XB_XCNT(j)]); sum += c; cnt += (c > 0u) ? 1u : 0u; mine = (j == x) ? c : mine; }
        if (sum == G) break;
        __builtin_amdgcn_s_sleep(1);
        if ((++sp & 255u) == 0u) { if (xb_ld(&bar[XB_TMO])) break; if (sp > XB_SPIN_CAP) { atomicAdd(&bar[XB_TMO], 1u); break; } }
    }
    nloc = mine > 0u ? mine : 1u; nx = cnt > 0u ? cnt : 1u;
}

__device__ __forceinline__ void xcd_barrier(const XcdBarrier& b) {
    asm volatile("s_waitcnt vmcnt(0)" ::: "memory");
    __syncthreads();
    if (threadIdx.x == 0) {
        unsigned* bar = b.bar;
        __builtin_amdgcn_s_waitcnt(0);
        unsigned nloc = b.st[0], nx = b.st[1];
        if (nloc == 0u) { xcd_barrier_complete(bar, b.x, nloc, nx); b.st[0] = nloc; b.st[1] = nx; }
        const unsigned old = xb_add(&bar[XB_XSUB(b.x)], 1u);
        const unsigned gen = old / nloc;
        if (old + 1u == (gen + 1u) * nloc) {
            __builtin_amdgcn_fence(__ATOMIC_RELEASE, "agent");
            asm volatile("s_waitcnt vmcnt(0)" ::: "memory");
            const unsigned og = xb_add(&bar[XB_TOP], 1u);
            const unsigned tg = og / nx;
            if (og + 1u == (tg + 1u) * nx) xb_add(&bar[XB_TOPGEN], 1u);
            else XB_SPIN(xb_ld(&bar[XB_TOPGEN]) == tg, bar);
            __builtin_amdgcn_fence(__ATOMIC_ACQUIRE, "agent");
            xb_add(&bar[XB_XGEN(b.x)], 1u);
            asm volatile("s_waitcnt vmcnt(0)" ::: "memory");
        } else {
            XB_SPIN(xb_ld(&bar[XB_XGEN(b.x)]) == gen, bar);
            __builtin_amdgcn_fence(__ATOMIC_ACQUIRE, "agent");
            asm volatile("s_waitcnt vmcnt(0)" ::: "memory");
        }
    }
    __syncthreads();
}

}
#ifndef PROBE
#define PROBE 0
#endif
#define REPK(k) _Pragma("unroll 1") for (int rep_ = 0; rep_ < ((PROBE == (k)) ? 2 : 1); ++rep_)
namespace mk {
#ifndef SCHB
#define SCHB (void)0
#endif
using pg8::Unit; using pg8::Gemm; using pg8::StaticOrder; using pg8::cvt_pk_bf16;
#define LAS __attribute__((address_space(3)))
typedef unsigned short bf16;
typedef float f32x4 __attribute__((ext_vector_type(4)));
typedef short bf16x8 __attribute__((ext_vector_type(8)));
typedef unsigned u32x2 __attribute__((ext_vector_type(2)));
typedef unsigned u32x4 __attribute__((ext_vector_type(4)));

constexpr int D = 1024, SEQ = 16384, TP = 32768, TS = 256, MT = 33024, DEPTH = 4, INC = 3328, FF = 2816, FF2 = 5632, NADA = 6144;
constexpr int HSEQ = 16386, HS_SAMPLE = 33280, H_ROWS = 33536, UP_TILES = 133;
constexpr int NWG = 256, NTHR = 512;
constexpr int LDS_BYTES = 135168;
constexpr size_t O_Y = 0, O_YS = 33554432, O_KP = 33816576, O_VP = 33947648, O_SRP = 34078720, O_SIP = 34095104, O_CP = 34111488,
                 O_KS = 34201600, O_VS = 34332672, O_SRS = 34463744, O_SIS = 34594816, O_CS = 34725888, O_END = 35446784;
constexpr size_t WS_BAR = 518586368, BAR_BYTES = 16384;
constexpr size_t WS_ZERO = 518602752;
constexpr int MISC_OFF = 131072;
constexpr size_t W_L = 29360128, W_IN = 0, W_GLU = 6815744, W_O = 8912896, W_OUT = 9961472, W_UP = 12058624, W_DN = 23592960;
constexpr size_t WS_W = 0, WS_MOD = 117440512, WS_ROPE = 119209984, WS_CH = 120258560, WS_H = 128647168, WS_O = WS_H, WS_YG = WS_H + 33816576,
                 WS_U = 197328896, WS_Q = 264962048, WS_K = 298778624, WS_V = 307232768, WS_G = 315686912, WS_P = 450953216, WS_END = 518586368, WS_ACT = WS_U;

struct Params { const float* in[31]; float* out; unsigned char* ws; };
enum { I_XP = 0, I_XS, I_CK, I_CV, I_SRE, I_SIM, I_SCONV, I_CP, I_CS, I_ADAW, I_ADAB, I_N1G, I_N2G, I_WIN, I_ARE, I_AIM, I_LDT, I_BRE, I_BIM, I_CRE, I_CIM, I_SD,
       I_WGLU, I_SINK, I_WO, I_WOUT, I_WUP, I_CW, I_CB, I_WDN, I_FG };

__device__ __forceinline__ float bf2f(unsigned h) { return __uint_as_float(h << 16); }
__device__ __forceinline__ unsigned f2bf(float f) { unsigned u = __float_as_uint(f); return (u + 0x7fffu + ((u >> 16) & 1u)) >> 16; }
__device__ __forceinline__ float sigm(float x) { return __builtin_amdgcn_rcpf(1.0f + __builtin_amdgcn_exp2f(-1.4426950409f * x)); }
__device__ __forceinline__ float gelu_tanh(float x) { const float z = 1.5957691216f * (x + 0.044715f * x * x * x); return x * sigm(z); }
__device__ __forceinline__ f32x4 ld_bf4(const bf16* p) { const u32x2 v = *(const u32x2*)p; return (f32x4){__uint_as_float(v.x << 16), __uint_as_float(v.x & 0xffff0000u), __uint_as_float(v.y << 16), __uint_as_float(v.y & 0xffff0000u)}; }
__device__ __forceinline__ void st_bf4(bf16* p, f32x4 v) { u32x2 o; o.x = cvt_pk_bf16(v.x, v.y); o.y = cvt_pk_bf16(v.z, v.w); *(u32x2*)p = o; }
__device__ __forceinline__ int modrow_of(int row) { return row < TP ? (row >> 14) : 2 + ((row - TP) >> 4); }
__device__ __forceinline__ int pos_of(int row) { return row < TP ? (row & (SEQ - 1)) : 2048 + ((row - TP) & 15); }
__device__ __forceinline__ float wave_sum(float v) {
#pragma unroll
    for (int o = 1; o < 64; o <<= 1) v += __shfl_xor(v, o);
    return v;
}
template <int CTRL> __device__ __forceinline__ float dpp_mov(float old, float src) {
    return __builtin_bit_cast(float, __builtin_amdgcn_update_dpp(__builtin_bit_cast(int, old), __builtin_bit_cast(int, src), CTRL, 0xf, 0xf, false));
}
template <int CTRL> __device__ __forceinline__ float dpp_rot(float src) {
    return __builtin_bit_cast(float, __builtin_amdgcn_mov_dpp(__builtin_bit_cast(int, src), CTRL, 0xf, 0xf, true));
}
__device__ __forceinline__ f32x4 row_prev1(f32x4 cur, f32x4 pm) { f32x4 r;
#pragma unroll
    for (int e = 0; e < 4; ++e) r[e] = dpp_mov<0x111>(dpp_rot<0x121>(pm[e]), cur[e]);
    return r; }
__device__ __forceinline__ f32x4 row_prev2(f32x4 cur, f32x4 pm) { f32x4 r;
#pragma unroll
    for (int e = 0; e < 4; ++e) r[e] = dpp_mov<0x112>(dpp_rot<0x122>(pm[e]), cur[e]);
    return r; }

typedef float f32x2 __attribute__((ext_vector_type(2)));
template <int E> __device__ __forceinline__ f32x2 conv_pair(f32x4 b, f32x4 w0, f32x4 w1, f32x4 w2, f32x4 cur, f32x4 pm) {
    const f32x2 c = (f32x2){cur[E], cur[E + 1]};
    const f32x2 p1 = (f32x2){dpp_mov<0x111>(dpp_rot<0x121>(pm[E]), cur[E]), dpp_mov<0x111>(dpp_rot<0x121>(pm[E + 1]), cur[E + 1])};
    const f32x2 p2 = (f32x2){dpp_mov<0x112>(dpp_rot<0x122>(pm[E]), cur[E]), dpp_mov<0x112>(dpp_rot<0x122>(pm[E + 1]), cur[E + 1])};
    f32x2 r = (f32x2){b[E], b[E + 1]} + (f32x2){w2[E], w2[E + 1]} * c;
    r = (f32x2){w1[E], w1[E + 1]} * p1 + r;
    r = (f32x2){w0[E], w0[E + 1]} * p2 + r;
    return r;
}
struct EpiWin {
    static constexpr bool PERM = false, AFTER_DRAIN = false;
    bf16* U; bf16* Q; bf16* Kb; bf16* Vb; bf16* G; const float* rope; float* out; int layer;
    __device__ __forceinline__ f32x4 rot(f32x4 v, f32x4 cs, f32x4 sn, int fq) const {
        f32x4 o, r;
#pragma unroll
        for (int e = 0; e < 4; ++e) o[e] = __shfl_xor(v[e], 32);
        if (fq < 2) r = v * cs - o * sn; else r = v * cs + o * sn;
        return r;
    }
    __device__ __forceinline__ void operator()(const f32x4 (&acc)[2][2][4][2], const Unit& u, int wr, int wc, int fr, int fq) const {
        const int pn = u.pn;
        const bool need_rot = (pn >= 2 && pn <= 4) && (wc & 1) == 0;
#pragma unroll
        for (int ai = 0; ai < 2; ++ai) {
            f32x4 rcs[4], rsn[4];
#pragma unroll
            for (int m = 0; m < 4; ++m) { rcs[m] = (f32x4){1.f, 1.f, 1.f, 1.f}; rsn[m] = (f32x4){0.f, 0.f, 0.f, 0.f};
                if (need_rot) { const float* rp = rope + (unsigned)(pos_of(u.pm * 256 + ai * 128 + wr * 64 + m * 16 + fr) * 16 + 4 * (fq & 1)); rcs[m] = *(const f32x4*)rp; rsn[m] = *(const f32x4*)(rp + 8); } }
#pragma unroll
            for (int m = 0; m < 4; ++m) {
                const int row = u.pm * 256 + ai * 128 + wr * 64 + m * 16 + fr;
                const int pos = pos_of(row);
                if (pn < 2) {
#pragma unroll
                    for (int bj = 0; bj < 2; ++bj)
#pragma unroll
                        for (int n = 0; n < 2; ++n) st_bf4(U + (unsigned)(row * 512 + pn * 256 + bj * 128 + wc * 32 + n * 16 + 4 * fq), acc[ai][bj][m][n]);
                } else if (pn < 4) {
#pragma unroll
                    for (int bj = 0; bj < 2; ++bj)
#pragma unroll
                        for (int n = 0; n < 2; ++n) {
                            f32x4 v = acc[ai][bj][m][n] * 0.125f;
                            if (n == 0 && (wc & 1) == 0) v = rot(v, rcs[m], rsn[m], fq);
                            st_bf4(Q + (unsigned)(row * 512 + (pn - 2) * 256 + bj * 128 + wc * 32 + n * 16 + 4 * fq), v);
                        }
                } else if (pn == 4) {
#pragma unroll
                    for (int bj = 0; bj < 2; ++bj)
#pragma unroll
                        for (int n = 0; n < 2; ++n) {
                            f32x4 v = acc[ai][bj][m][n];
                            const int c = wc * 32 + n * 16 + 4 * fq;
                            if (bj == 0 && n == 0 && (wc & 1) == 0) v = rot(v, rcs[m], rsn[m], fq);
                            st_bf4((bj == 0 ? Kb : Vb) + (unsigned)(row * 128 + c), v);
                            if (row >= TP) *(f32x4*)(out + (bj == 0 ? O_KS : O_VS) + (unsigned)((layer * 256 + (row - TP)) * 128 + c)) = v;
                            else if (pos >= SEQ - 128) *(f32x4*)(out + (bj == 0 ? O_KP : O_VP) + (unsigned)(((layer * 2 + (row >> 14)) * 128 + (pos - (SEQ - 128))) * 128 + c)) = v;
                        }
                } else {
#pragma unroll
                    for (int bj = 0; bj < 2; ++bj)
#pragma unroll
                        for (int n = 0; n < 2; ++n) {
                            const f32x4 a = acc[ai][bj][m][n]; f32x4 v;
#pragma unroll
                            for (int e = 0; e < 4; ++e) v[e] = sigm(a[e]);
                            st_bf4(G + (unsigned)(row * 2048 + (pn - 5) * 256 + bj * 128 + wc * 32 + n * 16 + 4 * fq), v);
                        }
                }
            }
        }
    }
};
struct EpiAttnO {
    static constexpr bool PERM = false, AFTER_DRAIN = false;
    const bf16* G; bf16* P;
    __device__ __forceinline__ void quad(int row, int cb, int fq, f32x4 v0, f32x4 v1) const {
        const int col = cb + 4 * fq;
        st_bf4(P + (unsigned)(row * 1024 + col), ld_bf4(G + (unsigned)(row * 2048 + 1024 + col)) * v0);
        st_bf4(P + (unsigned)(row * 1024 + col + 16), ld_bf4(G + (unsigned)(row * 2048 + 1024 + col + 16)) * v1);
    }
    __device__ __forceinline__ void operator()(const f32x4 (&acc)[2][2][4][2], const Unit& u, int wr, int wc, int fr, int fq) const {
#pragma unroll
        for (int ai = 0; ai < 2; ++ai) {
            u32x2 gq[4][2][2];
#pragma unroll
            for (int m = 0; m < 4; ++m)
#pragma unroll
                for (int bj = 0; bj < 2; ++bj)
#pragma unroll
                    for (int n = 0; n < 2; ++n) gq[m][bj][n] = *(const u32x2*)(G + (unsigned)((u.pm * 256 + ai * 128 + wr * 64 + m * 16 + fr) * 2048 + 1024 + u.pn * 256 + bj * 128 + wc * 32 + 16 * n + 4 * fq));
#pragma unroll
            for (int m = 0; m < 4; ++m)
#pragma unroll
                for (int bj = 0; bj < 2; ++bj)
#pragma unroll
                    for (int n = 0; n < 2; ++n) { const u32x2 q = gq[m][bj][n];
                        const f32x4 gb = (f32x4){__uint_as_float(q.x << 16), __uint_as_float(q.x & 0xffff0000u), __uint_as_float(q.y << 16), __uint_as_float(q.y & 0xffff0000u)};
                        st_bf4(P + (unsigned)((u.pm * 256 + ai * 128 + wr * 64 + m * 16 + fr) * 1024 + u.pn * 256 + bj * 128 + wc * 32 + 16 * n + 4 * fq), gb * acc[ai][bj][m][n]); }
        }
    }
};
struct EpiGlu {
    static constexpr bool PERM = false, AFTER_DRAIN = false;
    const bf16* G; bf16* P;
    __device__ __forceinline__ void quad(int row, int cb, int fq, f32x4 a, f32x4 b) const {
        const int j = (cb >> 1) + 4 * fq;
        const f32x4 ga = ld_bf4(G + (unsigned)(row * 2048 + j)), pb = ld_bf4(P + (unsigned)(row * 1024 + j));
        f32x4 v;
#pragma unroll
        for (int e = 0; e < 4; ++e) v[e] = ga[e] * a[e] * sigm(b[e]) + pb[e];
        st_bf4(P + (unsigned)(row * 1024 + j), v);
    }
    __device__ __forceinline__ void operator()(const f32x4 (&acc)[2][2][4][2], const Unit& u, int wr, int wc, int fr, int fq) const {
#pragma unroll
        for (int ai = 0; ai < 2; ++ai) {
            u32x2 gq[4][2], pq[4][2];
#pragma unroll
            for (int m = 0; m < 4; ++m)
#pragma unroll
                for (int bj = 0; bj < 2; ++bj) { const int row = u.pm * 256 + ai * 128 + wr * 64 + m * 16 + fr, j = ((u.pn * 256 + bj * 128 + wc * 32) >> 1) + 4 * fq;
                    gq[m][bj] = *(const u32x2*)(G + (unsigned)(row * 2048 + j)); pq[m][bj] = *(const u32x2*)(P + (unsigned)(row * 1024 + j)); }
#pragma unroll
            for (int m = 0; m < 4; ++m)
#pragma unroll
                for (int bj = 0; bj < 2; ++bj) { const int row = u.pm * 256 + ai * 128 + wr * 64 + m * 16 + fr, j = ((u.pn * 256 + bj * 128 + wc * 32) >> 1) + 4 * fq;
                    const u32x2 q = gq[m][bj], r = pq[m][bj];
                    const f32x4 ga = (f32x4){__uint_as_float(q.x << 16), __uint_as_float(q.x & 0xffff0000u), __uint_as_float(q.y << 16), __uint_as_float(q.y & 0xffff0000u)};
                    const f32x4 pb = (f32x4){__uint_as_float(r.x << 16), __uint_as_float(r.x & 0xffff0000u), __uint_as_float(r.y << 16), __uint_as_float(r.y & 0xffff0000u)};
                    const f32x4 a = acc[ai][bj][m][0], bb = acc[ai][bj][m][1]; f32x4 v;
#pragma unroll
                    for (int e2 = 0; e2 < 4; ++e2) v[e2] = ga[e2] * a[e2] * sigm(bb[e2]) + pb[e2];
                    st_bf4(P + (unsigned)(row * 1024 + j), v); }
        }
    }
};
struct EpiRes {
    static constexpr bool PERM = false, AFTER_DRAIN = false;
    const float* xb; float* X; const float* gvec;
    __device__ __forceinline__ void quad(int row, int cb, int fq, f32x4 v0, f32x4 v1) const {
        const unsigned go = (unsigned)(modrow_of(row) * NADA), o = (unsigned)(row * D + cb + 4 * fq);
        *(f32x4*)(X + o) = *(const f32x4*)(xb + o) + *(const f32x4*)(gvec + (go + cb + 4 * fq)) * v0;
        *(f32x4*)(X + o + 16) = *(const f32x4*)(xb + o + 16) + *(const f32x4*)(gvec + (go + cb + 4 * fq + 16)) * v1;
    }
    __device__ __forceinline__ void operator()(const f32x4 (&acc)[2][2][4][2], const Unit& u, int wr, int wc, int fr, int fq) const {
        const unsigned go = (unsigned)(modrow_of(u.pm * 256) * NADA);
        f32x4 gv[2][2];
#pragma unroll
        for (int bj = 0; bj < 2; ++bj)
#pragma unroll
            for (int n = 0; n < 2; ++n) gv[bj][n] = *(const f32x4*)(gvec + (go + u.pn * 256 + bj * 128 + wc * 32 + 16 * n + 4 * fq));
#pragma unroll
        for (int ai = 0; ai < 2; ++ai) {
            f32x4 xr[4][2][2];
#pragma unroll
            for (int m = 0; m < 4; ++m)
#pragma unroll
                for (int bj = 0; bj < 2; ++bj)
#pragma unroll
                    for (int n = 0; n < 2; ++n) xr[m][bj][n] = *(const f32x4*)(xb + (unsigned)((u.pm * 256 + ai * 128 + wr * 64 + m * 16 + fr) * D + u.pn * 256 + bj * 128 + wc * 32 + 16 * n + 4 * fq));
#pragma unroll
            for (int m = 0; m < 4; ++m)
#pragma unroll
                for (int bj = 0; bj < 2; ++bj)
#pragma unroll
                    for (int n = 0; n < 2; ++n) *(f32x4*)(X + (unsigned)((u.pm * 256 + ai * 128 + wr * 64 + m * 16 + fr) * D + u.pn * 256 + bj * 128 + wc * 32 + 16 * n + 4 * fq)) = xr[m][bj][n] + gv[bj][n] * acc[ai][bj][m][n];
        }
    }
};
template <int SPLIT, class Epi> __device__ __forceinline__ void small_gemm(const bf16* A, const bf16* Wt, int N, int K, int row0, const Epi& E, LAS unsigned char* lds, int bid, int tid) {
    asm volatile("" : "+v"(tid));
    const int lane = tid & 63, wave = tid >> 6, fr = lane & 15, fq = lane >> 4;
    const int nct = N >> 5, ntile = 16 * nct, tpw = 8 / SPLIT, kp = wave % SPLIT, tl = wave / SPLIT, kb = (K / SPLIT) * kp, ke = kb + K / SPLIT;
    LAS f32x4* red = (LAS f32x4*)lds;
    for (int t0 = bid * tpw; t0 < ntile; t0 += NWG * tpw) {
        const int tile = t0 + tl, rt = tile / nct, ct = tile - rt * nct;
        const bf16* ap = A + (unsigned)((16 * rt + fr) * K + 8 * fq);
        const bf16* bp0 = Wt + (unsigned)((32 * ct + fr) * K + 8 * fq);
        const bf16* bp1 = bp0 + (unsigned)(16 * K);
        f32x4 c0 = (f32x4){0.f, 0.f, 0.f, 0.f}, c1 = (f32x4){0.f, 0.f, 0.f, 0.f};
        for (int k0 = kb; k0 < ke; k0 += 256) {
            const int nst = (ke - k0) >> 5;
            bf16x8 a[8], b0[8], b1[8];
#pragma unroll
            for (int s = 0; s < 8; ++s) if (s < nst) { a[s] = *(const bf16x8*)(ap + k0 + 32 * s); b0[s] = *(const bf16x8*)(bp0 + k0 + 32 * s); b1[s] = *(const bf16x8*)(bp1 + k0 + 32 * s); }
#pragma unroll
            for (int s = 0; s < 8; ++s) if (s < nst) { c0 = __builtin_amdgcn_mfma_f32_16x16x32_bf16(b0[s], a[s], c0, 0, 0, 0); c1 = __builtin_amdgcn_mfma_f32_16x16x32_bf16(b1[s], a[s], c1, 0, 0, 0); }
        }
        if (SPLIT > 1) {
            __builtin_amdgcn_sched_barrier(0); asm volatile("s_nop 15\n\ts_nop 15" ::: "memory"); __builtin_amdgcn_sched_barrier(0);
            red[(wave * 2 + 0) * 64 + lane] = c0; red[(wave * 2 + 1) * 64 + lane] = c1;
            __syncthreads();
            if (kp == 0) {
#pragma unroll
                for (int j = 1; j < SPLIT; ++j) { c0 += red[((wave + j) * 2 + 0) * 64 + lane]; c1 += red[((wave + j) * 2 + 1) * 64 + lane]; }
            }
        }
        if (kp == 0) E.quad(row0 + 16 * rt + fr, 32 * ct, fq, c0, c1);
        if (SPLIT > 1) __syncthreads();
    }
}
template <bool SAMPLE> struct EpiUp {
    static constexpr bool PERM = false, AFTER_DRAIN = false;
    bf16* ACT; const float* cw; const float* cb; const float* sconv; float* out; int layer;
    __device__ __forceinline__ void operator()(const f32x4 (&acc)[2][2][4][2], const Unit& u, int wr, int wc, int fr, int fq) const {
        const f32x4 z = (f32x4){0.f, 0.f, 0.f, 0.f};
#pragma unroll
        for (int bj = 0; bj < 2; ++bj) {
            const int jf = 16 * (8 * u.pn + 4 * bj + wc) + 4 * fq;
            typedef const __attribute__((address_space(4))) f32x4* cptr4;
            const f32x4 wv0 = *(cptr4)(cw + jf), wv1 = *(cptr4)(cw + FF2 + jf), wv2 = *(cptr4)(cw + 2 * FF2 + jf), bv = *(cptr4)(cb + jf);
            const f32x4 wg0 = *(cptr4)(cw + FF + jf), wg1 = *(cptr4)(cw + FF2 + FF + jf), wg2 = *(cptr4)(cw + 2 * FF2 + FF + jf), bg = *(cptr4)(cb + FF + jf);
#pragma unroll
            for (int ai = 0; ai < 2; ++ai)
#pragma unroll
                for (int m = 0; m < 4; ++m) {
                    const f32x4 cv = acc[ai][bj][m][0], cg = acc[ai][bj][m][1];
                    const f32x4 pv = m > 0 ? acc[ai][bj][m > 0 ? m - 1 : 0][0] : z, pg = m > 0 ? acc[ai][bj][m > 0 ? m - 1 : 0][1] : z;
                    f32x4 val = bv + wv2 * cv, gat = bg + wg2 * cg;
                    bool valid; unsigned aoff;
                    if (SAMPLE) {
                        const int s = 8 * ai + 4 * wr + m, t = fr;
                        f32x4 p1v = row_prev1(cv, z), p2v = row_prev2(cv, z), p1g = row_prev1(cg, z), p2g = row_prev2(cg, z);
                        if (t < 2) {
                            const float* st = sconv + (unsigned)(s * 2 * FF2 + jf);
                            const f32x4 s1v = *(const f32x4*)(st + FF2), s1g = *(const f32x4*)(st + FF2 + FF);
                            if (t == 0) { p1v = s1v; p1g = s1g; p2v = *(const f32x4*)st; p2g = *(const f32x4*)(st + FF); }
                            else { p2v = s1v; p2g = s1g; }
                        }
                        val += wv0 * p2v + wv1 * p1v; gat += wg0 * p2g + wg1 * p1g;
                        valid = true; aoff = (unsigned)(TP + 16 * s + t) * FF + jf;
                        if (t >= 14) { float* o = out + O_CS + (unsigned)(((layer * 16 + s) * 2 + (t - 14)) * FF2 + jf); *(f32x4*)o = cv; *(f32x4*)(o + FF) = cg; }
                    } else {
                        { f32x2 v01 = conv_pair<0>(bv, wv0, wv1, wv2, cv, pv), v23 = conv_pair<2>(bv, wv0, wv1, wv2, cv, pv);
                          asm volatile("" : "+v"(v01), "+v"(v23));
                          const f32x2 g01 = conv_pair<0>(bg, wg0, wg1, wg2, cg, pg), g23 = conv_pair<2>(bg, wg0, wg1, wg2, cg, pg);
                          val = (f32x4){v01.x, v01.y, v23.x, v23.y}; gat = (f32x4){g01.x, g01.y, g23.x, g23.y}; }
                        const int j = 16 * m + fr, hs = 248 * u.pm + 62 * (2 * ai + wr) + j;
                        const int b = hs >= HSEQ ? 1 : 0, pos = hs - b * HSEQ - 2;
                        valid = (j >= 2) && (pos >= 0) && (hs < 2 * HSEQ);
                        aoff = (unsigned)(b * SEQ + pos) * FF + jf;
                        if (valid && pos >= SEQ - 2) { float* o = out + O_CP + (unsigned)(((layer * 2 + b) * 2 + (pos - (SEQ - 2))) * FF2 + jf); *(f32x4*)o = cv; *(f32x4*)(o + FF) = cg; }
                    }
                    if (valid) {
                        f32x4 a;
#pragma unroll
                        for (int e = 0; e < 4; ++e) a[e] = gat[e] * sigm(gat[e]) * val[e];
                        st_bf4(ACT + aoff, a);
                    }
                    SCHB;
                }
        }
    }
};

__device__ __forceinline__ int dstrow(int mode, int half, int n) { if (mode == 0) return n; const int j = n < half ? n : n - half; return 32 * (j >> 4) + (j & 15) + (n < half ? 0 : 16); }
__device__ __forceinline__ void transpose_item(const float* W, int K, int N, bf16* WT, int mode, int half, LAS float* scr, int item, int lane) {
    const int nblk = N / 32, kb = item / nblk, nb = item % nblk, k0 = 64 * kb, n0 = 32 * nb;
#pragma unroll 8
    for (int i = 0; i < 32; ++i) { const int kk = 2 * i + (lane >> 5); scr[kk * 33 + (lane & 31)] = W[(size_t)(k0 + kk) * N + n0 + (lane & 31)]; }
    asm volatile("s_waitcnt lgkmcnt(0)" ::: "memory");
    const int c = lane & 7;
#pragma unroll
    for (int j = 0; j < 4; ++j) { const int n = (lane >> 3) + 8 * j; const LAS float* s = scr + (8 * c) * 33 + n;
        u32x4 o; o.x = cvt_pk_bf16(s[0 * 33], s[1 * 33]); o.y = cvt_pk_bf16(s[2 * 33], s[3 * 33]); o.z = cvt_pk_bf16(s[4 * 33], s[5 * 33]); o.w = cvt_pk_bf16(s[6 * 33], s[7 * 33]);
        *(u32x4*)(WT + (size_t)dstrow(mode, half, n0 + n) * K + k0 + 8 * c) = o; }
    asm volatile("s_waitcnt lgkmcnt(0)" ::: "memory");
}
__device__ __forceinline__ void dsincos(double x, double& s, double& c) {
    const double k = rint(x * 0.15915494309189535);
    const double r = (x - k * 6.283185307179586) - k * 2.4492935982947064e-16;
    const double r2 = r * r;
    double ts = 1.0, tc = 1.0, ss = 1.0, cc = 1.0;
#pragma unroll
    for (int i = 1; i <= 13; ++i) { tc = -tc * r2 / (double)((2 * i - 1) * (2 * i)); cc += tc; ts = -ts * r2 / (double)((2 * i) * (2 * i + 1)); ss += ts; }
    s = ss * r; c = cc;
}
__device__ __forceinline__ void p0_prologue(const Params& p, LAS unsigned char* lds, int bid, int tid) {
    asm volatile("" : "+v"(tid));
    const int lane = tid & 63, wave = tid >> 6;
    float* mod = (float*)(p.ws + WS_MOD);
    if (bid < 192) {
        LAS float* sc = (LAS float*)lds;
        LAS float* part = (LAS float*)(lds + 81920);
        for (int idx = tid; idx < 18 * 1024; idx += NTHR) { const int bb = idx >> 10, d = idx & 1023;
            const float c = bb < 2 ? p.in[I_CP][bb * 1024 + d] : p.in[I_CS][(bb - 2) * 1024 + d]; sc[d * 20 + bb] = c / (1.0f + __expf(-c)); }
        __syncthreads();
        const int l = bid / 48, e0 = (bid % 48) * 128, col = tid & 127, dq = tid >> 7;
        float a[18];
#pragma unroll
        for (int i = 0; i < 18; ++i) a[i] = 0.f;
        const float* wp = p.in[I_ADAW] + ((size_t)l * 1024 + dq * 256) * NADA + e0 + col;
#pragma unroll 8
        for (int d = 0; d < 256; ++d) {
            const float w = wp[(size_t)d * NADA];
            const LAS f32x4* s4 = (const LAS f32x4*)(sc + (dq * 256 + d) * 20);
            const f32x4 s0 = s4[0], s1 = s4[1], s2 = s4[2], s3 = s4[3], s5 = s4[4];
            a[0] += w * s0.x; a[1] += w * s0.y; a[2] += w * s0.z; a[3] += w * s0.w; a[4] += w * s1.x; a[5] += w * s1.y; a[6] += w * s1.z; a[7] += w * s1.w;
            a[8] += w * s2.x; a[9] += w * s2.y; a[10] += w * s2.z; a[11] += w * s2.w; a[12] += w * s3.x; a[13] += w * s3.y; a[14] += w * s3.z; a[15] += w * s3.w;
            a[16] += w * s5.x; a[17] += w * s5.y;
        }
#pragma unroll
        for (int i = 0; i < 18; ++i) part[(dq * 128 + col) * 18 + i] = a[i];
        __syncthreads();
        for (int idx = tid; idx < 128 * 18; idx += NTHR) { const int c2 = idx & 127, bb = idx >> 7;
            const float v = part[(0 * 128 + c2) * 18 + bb] + part[(1 * 128 + c2) * 18 + bb] + part[(2 * 128 + c2) * 18 + bb] + part[(3 * 128 + c2) * 18 + bb] + p.in[I_ADAB][l * NADA + e0 + c2];
            mod[((size_t)l * 18 + bb) * NADA + e0 + c2] = v; }
        __syncthreads();
    }
    {
        float* rope = (float*)(p.ws + WS_ROPE);
        for (int idx = bid * NTHR + tid; idx < SEQ * 8; idx += NWG * NTHR) { const int pos = idx >> 3, i = idx & 7;
            const double f = i == 0 ? 1.0 : i == 1 ? 0.19392274474868576 : i == 2 ? 0.03760603093086393 : i == 3 ? 0.007292664737217109 : i == 4 ? 0.001414213562373095 : i == 5 ? 0.0002742481756762073 : i == 6 ? 5.318295896944988e-05 : 1.031338537721246e-05;
            double s, c; dsincos((double)pos * f, s, c); rope[pos * 16 + i] = (float)c; rope[pos * 16 + 8 + i] = (float)s; }
    }
    {
        LAS float* scr = (LAS float*)(lds + wave * 8704);
        constexpr int I_1 = 16 * 104, I_2 = 8 * 64, I_3 = 8 * 32, I_4 = 16 * 32, I_5 = 16 * 176, I_6 = 44 * 32, I_L = I_1 + I_2 + I_3 + I_4 + I_5 + I_6;
        const int gw = bid * 8 + wave;
        for (int it = gw; it < DEPTH * I_L; it += NWG * 8) {
            const int l = it / I_L; int r = it % I_L; unsigned char* wl = p.ws + WS_W + (size_t)l * W_L;
            if (r < I_1) { transpose_item(p.in[I_WIN] + (size_t)l * D * INC, D, INC, (bf16*)(wl + W_IN), 0, 0, scr, r, lane); continue; } r -= I_1;
            if (r < I_2) { transpose_item(p.in[I_WGLU] + (size_t)l * 512 * 2048, 512, 2048, (bf16*)(wl + W_GLU), 1, 1024, scr, r, lane); continue; } r -= I_2;
            if (r < I_3) { transpose_item(p.in[I_WO] + (size_t)l * 512 * 1024, 512, 1024, (bf16*)(wl + W_O), 0, 0, scr, r, lane); continue; } r -= I_3;
            if (r < I_4) { transpose_item(p.in[I_WOUT] + (size_t)l * D * D, D, D, (bf16*)(wl + W_OUT), 0, 0, scr, r, lane); continue; } r -= I_4;
            if (r < I_5) { transpose_item(p.in[I_WUP] + (size_t)l * D * FF2, D, FF2, (bf16*)(wl + W_UP), 1, FF, scr, r, lane); continue; } r -= I_5;
            transpose_item(p.in[I_WDN] + (size_t)l * FF * D, FF, D, (bf16*)(wl + W_DN), 0, 0, scr, r, lane);
        }
    }
}

__device__ __forceinline__ void norm_phase(const Params& p, int layer, int mode, int bid, int tid) {
    asm volatile("" : "+v"(tid));
    const int lane = tid & 63, wave = tid >> 6, gw = bid * 8 + wave;
    float* X = p.out; bf16* H = (bf16*)(p.ws + WS_H);
    const float* mod = (const float*)(p.ws + WS_MOD) + (size_t)layer * 18 * NADA;
    const float* gsrc = mode == 0 ? p.in[I_N1G] + layer * D : mode == 1 ? p.in[I_N2G] + layer * D : p.in[I_FG];
    f32x4 g[4];
#pragma unroll
    for (int j = 0; j < 4; ++j) g[j] = *(const f32x4*)(gsrc + 4 * lane + 256 * j);
    if (mode == 1 && gw < 4) { const int hs = (gw & 1) + (gw >> 1) * HSEQ; unsigned* o = (unsigned*)(H + (size_t)hs * D); unsigned zz = 0u; asm volatile("" : "+v"(zz));
#pragma unroll
        for (int j = 0; j < 8; ++j) o[lane + 64 * j] = zz; }
    for (int row = gw; row < MT; row += NWG * 8) {
        const float* xr = (mode == 0 && layer == 0) ? (row < TP ? p.in[I_XP] + (size_t)row * D : p.in[I_XS] + (size_t)(row - TP) * D) : X + (size_t)row * D;
        f32x4 v[4]; float s = 0.f;
#pragma unroll
        for (int j = 0; j < 4; ++j) { v[j] = *(const f32x4*)(xr + 4 * lane + 256 * j); s += (v[j].x * v[j].x + v[j].y * v[j].y) + (v[j].z * v[j].z + v[j].w * v[j].w); }
        const float rstd = 1.0f / sqrtf(wave_sum(s) * (1.0f / D) + 1e-6f);
        if (mode == 2) {
#pragma unroll
            for (int j = 0; j < 4; ++j) *(f32x4*)(X + (size_t)row * D + 4 * lane + 256 * j) = v[j] * rstd * g[j];
        } else {
            const float* mr = mod + (size_t)modrow_of(row) * NADA + (mode == 0 ? 0 : 3072);
            size_t hrow = row;
            if (mode == 1) hrow = row < TP ? (size_t)(row >> 14) * HSEQ + 2 + (row & (SEQ - 1)) : (size_t)HS_SAMPLE + (row - TP);
#pragma unroll
            for (int j = 0; j < 4; ++j) { const f32x4 sh = *(const f32x4*)(mr + 4 * lane + 256 * j), sc = *(const f32x4*)(mr + 1024 + 4 * lane + 256 * j);
                st_bf4(H + hrow * D + 4 * lane + 256 * j, (v[j] * rstd * g[j]) * (sc + 1.0f) + sh); }
        }
    }
}

struct SsmPar { float abr, abi; float bbr[16], bbi[16]; };
__device__ __forceinline__ void ssm_disc(const Params& p, int layer, int g, int lane, float& abr, float& abi, float& fr, float& fi) {
    const int gi = (layer * 32 + g) * 64 + lane;
    const float are = p.in[I_ARE][gi], aim = p.in[I_AIM][gi], dt = expf(p.in[I_LDT][layer * 32 + g]);
    const float mag = expf(are * dt); float sn, cs; sincosf(aim * dt, &sn, &cs);
    abr = mag * cs; abi = mag * sn;
    const float nr = abr - 1.0f, ni = abi, den = are * are + aim * aim;
    fr = (nr * are + ni * aim) / den; fi = (ni * are - nr * aim) / den;
}
__device__ __forceinline__ void ssm_task(const Params& p, int layer, int mode, int sq, int g, int chunk, int lane, LAS unsigned char* wl) {
    LAS float* ul = (LAS float*)wl;
    LAS bf16* Sl = (LAS bf16*)(wl + 4096);
    float abr, abi, fr, fi; ssm_disc(p, layer, g, lane, abr, abi, fr, fi);
    typedef float f32x2 __attribute__((ext_vector_type(2)));
    f32x2 bb[16];
    { const size_t bo = (((size_t)layer * 32 + g) * 64 + lane) * 16;
#pragma unroll
      for (int c4 = 0; c4 < 4; ++c4) { const f32x4 br = *(const f32x4*)(p.in[I_BRE] + bo + 4 * c4), bi = *(const f32x4*)(p.in[I_BIM] + bo + 4 * c4);
#pragma unroll
          for (int e = 0; e < 4; ++e) { bb[4 * c4 + e].x = fr * br[e] - fi * bi[e]; bb[4 * c4 + e].y = fr * bi[e] + fi * br[e]; } } }
    const bool cproj = mode != 0;
    const int g4 = lane >> 4, cl = lane & 15;
    bf16x8 cf[4];
    float dsk = 0.f;
    if (cproj) {
        const size_t co = (((size_t)layer * 32 + g) * 16 + cl) * 64;
#pragma unroll
        for (int ks = 0; ks < 4; ++ks) { const float* src = (ks < 2 ? p.in[I_CRE] : p.in[I_CIM]) + co + 32 * (ks & 1) + 8 * g4; const float sg = ks < 2 ? 1.0f : -1.0f;
            const f32x4 a = *(const f32x4*)src, b = *(const f32x4*)(src + 4);
            u32x4 o; o.x = cvt_pk_bf16(sg * a.x, sg * a.y); o.y = cvt_pk_bf16(sg * a.z, sg * a.w); o.z = cvt_pk_bf16(sg * b.x, sg * b.y); o.w = cvt_pk_bf16(sg * b.z, sg * b.w);
            cf[ks] = __builtin_bit_cast(bf16x8, o); }
        dsk = p.in[I_SD][layer * 512 + g * 16 + cl];
    }
    const int nsteps = mode == 1 ? 16 : 64;
    const size_t r0 = mode == 1 ? (size_t)TP + sq * 16 : (size_t)sq * SEQ + chunk * 64;
    const float* U = (const float*)(p.ws + WS_U);
#pragma unroll
    for (int i = 0; i < 4; ++i) { const int idx = lane + 64 * i; if (idx < nsteps * 4) { const int t = idx >> 2, c4 = idx & 3; *(LAS f32x4*)(ul + t * 16 + 4 * c4) = *(const f32x4*)(U + (r0 + t) * 512 + g * 16 + 4 * c4); } }
    float sr = 0.f, si = 0.f;
    float* CH = (float*)(p.ws + WS_CH);
    const size_t cho = (((size_t)(sq * 32 + g)) * 256 + chunk) * 128;
    if (mode == 1) { const size_t so = (((size_t)layer * 16 + sq) * 32 + g) * 64 + lane; sr = p.in[I_SRE][so]; si = p.in[I_SIM][so]; }
    else if (mode == 2) { sr = CH[cho + lane]; si = CH[cho + 64 + lane]; }
    asm volatile("s_waitcnt vmcnt(0) lgkmcnt(0)" ::: "memory"); __builtin_amdgcn_wave_barrier();
    bf16* Yg = (bf16*)(p.ws + WS_YG);
    for (int hh = 0; hh * 32 < nsteps; ++hh) {
        const int ns = nsteps - hh * 32 < 32 ? nsteps - hh * 32 : 32;
#pragma unroll 4
        for (int t = 0; t < ns; ++t) {
            const LAS f32x4* up = (const LAS f32x4*)(ul + (hh * 32 + t) * 16);
            const f32x4 u0 = up[0], u1 = up[1], u2 = up[2], u3 = up[3];
            f32x2 xa = (f32x2){0.f, 0.f}, xb = (f32x2){0.f, 0.f};
#pragma unroll
            for (int e = 0; e < 4; ++e) { xa = bb[e] * (f32x2){u0[e], u0[e]} + xa; xb = bb[4 + e] * (f32x2){u1[e], u1[e]} + xb; }
#pragma unroll
            for (int e = 0; e < 4; ++e) { xa = bb[8 + e] * (f32x2){u2[e], u2[e]} + xa; xb = bb[12 + e] * (f32x2){u3[e], u3[e]} + xb; }
            const float xr = xa.x + xb.x, xi = xa.y + xb.y;
            const float nsr = fmaf(abr, sr, fmaf(-abi, si, xr)), nsi = fmaf(abr, si, fmaf(abi, sr, xi));
            sr = nsr; si = nsi;
            if (cproj) { Sl[t * 136 + lane] = (bf16)f2bf(sr); Sl[t * 136 + 64 + lane] = (bf16)f2bf(si); }
        }
        if (cproj) {
            asm volatile("s_waitcnt lgkmcnt(0)" ::: "memory"); __builtin_amdgcn_wave_barrier();
#pragma unroll
            for (int mt = 0; mt < 2; ++mt) {
                f32x4 ya = (f32x4){0.f, 0.f, 0.f, 0.f};
#pragma unroll
                for (int ks = 0; ks < 4; ++ks) { const bf16x8 a = *(const LAS bf16x8*)(Sl + (16 * mt + cl) * 136 + 32 * ks + 8 * g4); ya = __builtin_amdgcn_mfma_f32_16x16x32_bf16(a, cf[ks], ya, 0, 0, 0); }
#pragma unroll
                for (int i = 0; i < 4; ++i) { const int t = 16 * mt + 4 * g4 + i;
                    if (t < ns) { const float y = ya[i] + dsk * ul[(hh * 32 + t) * 16 + cl]; Yg[(r0 + hh * 32 + t) * 512 + g * 16 + cl] = (bf16)f2bf(gelu_tanh(y)); } }
            }
            asm volatile("s_waitcnt lgkmcnt(0)" ::: "memory"); __builtin_amdgcn_wave_barrier();
        }
    }
    if (mode == 0) { CH[cho + lane] = sr; CH[cho + 64 + lane] = si; }
    else if (mode == 1) { const size_t so = (((size_t)layer * 16 + sq) * 32 + g) * 64 + lane; p.out[O_SRS + so] = sr; p.out[O_SIS + so] = si; }
    else if (chunk == 255) { const size_t so = (((size_t)layer * 2 + sq) * 32 + g) * 64 + lane; p.out[O_SRP + so] = sr; p.out[O_SIP + so] = si; }
    asm volatile("s_waitcnt lgkmcnt(0)" ::: "memory"); __builtin_amdgcn_wave_barrier();
}
__device__ __forceinline__ void split_hl(f32x4 a, f32x4 c, u32x4& hi, u32x4& lo) {
    hi.x = cvt_pk_bf16(a.x, a.y); hi.y = cvt_pk_bf16(a.z, a.w); hi.z = cvt_pk_bf16(c.x, c.y); hi.w = cvt_pk_bf16(c.z, c.w);
    lo.x = cvt_pk_bf16(a.x - __uint_as_float(hi.x << 16), a.y - __uint_as_float(hi.x & 0xffff0000u)); lo.y = cvt_pk_bf16(a.z - __uint_as_float(hi.y << 16), a.w - __uint_as_float(hi.y & 0xffff0000u));
    lo.z = cvt_pk_bf16(c.x - __uint_as_float(hi.z << 16), c.y - __uint_as_float(hi.z & 0xffff0000u)); lo.w = cvt_pk_bf16(c.z - __uint_as_float(hi.w << 16), c.w - __uint_as_float(hi.w & 0xffff0000u));
}
__device__ __forceinline__ void ssm_task_v2(const Params& p, int layer, int mode, int sq, int g, int chunk0, int nchunk, int cstride, int lane, LAS unsigned char* wl) {
    LAS float* Xl = (LAS float*)wl;
    LAS bf16* Sl = (LAS bf16*)(wl + 8448);
    const int g4 = lane >> 4, cl = lane & 15;
    float abr, abi, fr, fi; ssm_disc(p, layer, g, lane, abr, abi, fr, fi);
    bf16x8 bfr[8];
    const int gg = g4 & 1;
#pragma unroll
    for (int q = 0; q < 4; ++q) {
        const int st = 16 * q + cl;
        const float frs = __shfl(fr, st), fis = __shfl(fi, st);
        const size_t bo = (((size_t)layer * 32 + g) * 64 + st) * 16 + 8 * gg;
        const f32x4 r0 = *(const f32x4*)(p.in[I_BRE] + bo), r1 = *(const f32x4*)(p.in[I_BRE] + bo + 4), i0 = *(const f32x4*)(p.in[I_BIM] + bo), i1 = *(const f32x4*)(p.in[I_BIM] + bo + 4);
        const f32x4 a0 = frs * r0 - fis * i0, a1 = frs * r1 - fis * i1, c0 = frs * i0 + fis * r0, c1 = frs * i1 + fis * r1;
        u32x4 hre, him;
        hre.x = cvt_pk_bf16(a0.x, a0.y); hre.y = cvt_pk_bf16(a0.z, a0.w); hre.z = cvt_pk_bf16(a1.x, a1.y); hre.w = cvt_pk_bf16(a1.z, a1.w);
        him.x = cvt_pk_bf16(c0.x, c0.y); him.y = cvt_pk_bf16(c0.z, c0.w); him.z = cvt_pk_bf16(c1.x, c1.y); him.w = cvt_pk_bf16(c1.z, c1.w);
        if (g4 >= 2) { hre = (u32x4){0u, 0u, 0u, 0u}; him = hre; }
        bfr[q] = __builtin_bit_cast(bf16x8, hre); bfr[4 + q] = __builtin_bit_cast(bf16x8, him);
    }
    const bool cproj = mode != 0;
    bf16x8 cf[4];
    float dsk = 0.f;
    if (cproj) {
        const size_t co = (((size_t)layer * 32 + g) * 16 + cl) * 64;
#pragma unroll
        for (int ks = 0; ks < 4; ++ks) { const float* src = (ks < 2 ? p.in[I_CRE] : p.in[I_CIM]) + co + 32 * (ks & 1) + 8 * g4; const float sg = ks < 2 ? 1.0f : -1.0f;
            const f32x4 a = *(const f32x4*)src, c = *(const f32x4*)(src + 4);
            u32x4 o; o.x = cvt_pk_bf16(sg * a.x, sg * a.y); o.y = cvt_pk_bf16(sg * a.z, sg * a.w); o.z = cvt_pk_bf16(sg * c.x, sg * c.y); o.w = cvt_pk_bf16(sg * c.z, sg * c.w);
            cf[ks] = __builtin_bit_cast(bf16x8, o); }
        dsk = p.in[I_SD][layer * 512 + g * 16 + cl];
    }
    const int nblk = mode == 1 ? 1 : 4;
    bf16* Yg = (bf16*)(p.ws + WS_YG);
    const bf16* U = (const bf16*)(p.ws + WS_U);
    float* CH = (float*)(p.ws + WS_CH);
    float sr = 0.f, si = 0.f;
    if (mode == 1) { const size_t so = (((size_t)layer * 16 + sq) * 32 + g) * 64 + lane; sr = p.in[I_SRE][so]; si = p.in[I_SIM][so]; }
    else if (mode == 2) { const size_t cso = (((size_t)(sq * 32 + g)) * 32 + (chunk0 >> 3)) * 128; sr = CH[cso + lane]; si = CH[cso + 64 + lane]; }
    for (int ci = 0; ci < nchunk; ++ci) {
    const int chunk = chunk0 + ci * cstride;
    const unsigned r0 = mode == 1 ? (unsigned)(TP + sq * 16) : (unsigned)(sq * SEQ + chunk * 64);
    u32x4 ulq[4];
#pragma unroll
    for (int blk = 0; blk < 4; ++blk) if (blk < nblk) {
        ulq[blk] = *(const u32x4*)(U + (r0 + 16 * blk + cl) * 512u + g * 16 + 8 * gg);
    }
#pragma unroll
    for (int blk = 0; blk < 4; ++blk) if (blk < nblk) {
        u32x4 ua;
        ua = g4 < 2 ? ulq[blk] : (u32x4){0u, 0u, 0u, 0u};
        float ud[4];
        if (cproj) {
#pragma unroll
            for (int i = 0; i < 4; ++i) ud[i] = bf2f(U[(r0 + 16 * blk + 4 * g4 + i) * 512u + g * 16 + cl]);
        }
        const bf16x8 uf = __builtin_bit_cast(bf16x8, ua);
        f32x4 xs[8];
#pragma unroll
        for (int nt = 0; nt < 8; ++nt) {
            xs[nt] = __builtin_amdgcn_mfma_f32_16x16x32_bf16(uf, bfr[nt], (f32x4){0.f, 0.f, 0.f, 0.f}, 0, 0, 0);
        }
        __builtin_amdgcn_sched_barrier(0); asm volatile("s_nop 15\n\ts_nop 15" ::: "memory"); __builtin_amdgcn_sched_barrier(0);
#pragma unroll
        for (int nt = 0; nt < 8; ++nt) {
#pragma unroll
            for (int i = 0; i < 4; ++i) Xl[(4 * g4 + i) * 132 + 16 * nt + cl] = xs[nt][i];
        }
        asm volatile("s_waitcnt lgkmcnt(0)" ::: "memory"); __builtin_amdgcn_wave_barrier();
        float xrv[16], xiv[16];
#pragma unroll
        for (int t = 0; t < 16; ++t) { xrv[t] = Xl[t * 132 + lane]; xiv[t] = Xl[t * 132 + 64 + lane]; }
        asm volatile("s_waitcnt lgkmcnt(0)" ::: "memory");
#pragma unroll
        for (int t = 0; t < 16; ++t) {
            const float nsr = fmaf(abr, sr, fmaf(-abi, si, xrv[t])), nsi = fmaf(abr, si, fmaf(abi, sr, xiv[t]));
            sr = nsr; si = nsi;
            if (cproj) { const unsigned pk = cvt_pk_bf16(sr, si); Sl[t * 136 + lane] = (bf16)(pk & 0xffffu); Sl[t * 136 + 64 + lane] = (bf16)(pk >> 16); }
        }
        if (cproj) {
            asm volatile("s_waitcnt lgkmcnt(0)" ::: "memory"); __builtin_amdgcn_wave_barrier();
            f32x4 ya = (f32x4){0.f, 0.f, 0.f, 0.f};
#pragma unroll
            for (int ks = 0; ks < 4; ++ks) { const bf16x8 a = *(const LAS bf16x8*)(Sl + cl * 136 + 32 * ks + 8 * g4); ya = __builtin_amdgcn_mfma_f32_16x16x32_bf16(a, cf[ks], ya, 0, 0, 0); }
#pragma unroll
            for (int i = 0; i < 4; ++i) { const float y = ya[i] + dsk * ud[i]; Yg[(r0 + 16 * blk + 4 * g4 + i) * 512u + g * 16 + cl] = (bf16)f2bf(gelu_tanh(y)); }
        }
        asm volatile("s_waitcnt lgkmcnt(0)" ::: "memory"); __builtin_amdgcn_wave_barrier();
    }
    if (mode == 1) { const size_t so = (((size_t)layer * 16 + sq) * 32 + g) * 64 + lane; p.out[O_SRS + so] = sr; p.out[O_SIS + so] = si; }
    else if (chunk == 255) { const size_t so = (((size_t)layer * 2 + sq) * 32 + g) * 64 + lane; p.out[O_SRP + so] = sr; p.out[O_SIP + so] = si; }
    }
}
__device__ __forceinline__ void ssm_pass1_fast(const Params& p, int layer, int sq, int g, int chunk0, int nchunk, int cstride, int lane) {
    const int g4 = lane >> 4, cl = lane & 15, gg = g4 & 1;
    float abr, abi, fr, fi; ssm_disc(p, layer, g, lane, abr, abi, fr, fi);
    bf16x8 bfr[8];
    float ar[4], ai[4], Ar[4], Ai[4], wr_[4], wi_[4];
#pragma unroll
    for (int q = 0; q < 4; ++q) {
        const int st = 16 * q + cl;
        const float frs = __shfl(fr, st), fis = __shfl(fi, st);
        ar[q] = __shfl(abr, st); ai[q] = __shfl(abi, st);
        const size_t bo = (((size_t)layer * 32 + g) * 64 + st) * 16 + 8 * gg;
        const f32x4 r0 = *(const f32x4*)(p.in[I_BRE] + bo), r1 = *(const f32x4*)(p.in[I_BRE] + bo + 4), i0 = *(const f32x4*)(p.in[I_BIM] + bo), i1 = *(const f32x4*)(p.in[I_BIM] + bo + 4);
        const f32x4 a0 = frs * r0 - fis * i0, a1 = frs * r1 - fis * i1, c0 = frs * i0 + fis * r0, c1 = frs * i1 + fis * r1;
        u32x4 hre, him;
        hre.x = cvt_pk_bf16(a0.x, a0.y); hre.y = cvt_pk_bf16(a0.z, a0.w); hre.z = cvt_pk_bf16(a1.x, a1.y); hre.w = cvt_pk_bf16(a1.z, a1.w);
        him.x = cvt_pk_bf16(c0.x, c0.y); him.y = cvt_pk_bf16(c0.z, c0.w); him.z = cvt_pk_bf16(c1.x, c1.y); him.w = cvt_pk_bf16(c1.z, c1.w);
        if (g4 >= 2) { hre = (u32x4){0u, 0u, 0u, 0u}; him = hre; }
        bfr[q] = __builtin_bit_cast(bf16x8, hre); bfr[4 + q] = __builtin_bit_cast(bf16x8, him);
        const float a2r = ar[q] * ar[q] - ai[q] * ai[q], a2i = 2.0f * ar[q] * ai[q];
        const float a4r = a2r * a2r - a2i * a2i, a4i = 2.0f * a2r * a2i;
        const float a8r = a4r * a4r - a4i * a4i, a8i = 2.0f * a4r * a4i;
        Ar[q] = a8r * a8r - a8i * a8i; Ai[q] = 2.0f * a8r * a8i;
        const float a12r = a8r * a4r - a8i * a4i, a12i = a8r * a4i + a8i * a4r;
        wr_[q] = g4 == 3 ? 1.0f : g4 == 2 ? a4r : g4 == 1 ? a8r : a12r;
        wi_[q] = g4 == 3 ? 0.0f : g4 == 2 ? a4i : g4 == 1 ? a8i : a12i;
    }
    const bf16* U = (const bf16*)(p.ws + WS_U);
    float* CH = (float*)(p.ws + WS_CH);
    float accr[4] = {0.f, 0.f, 0.f, 0.f}, acci[4] = {0.f, 0.f, 0.f, 0.f};
    u32x4 unx[4];
#pragma unroll
    for (int blk = 0; blk < 4; ++blk) unx[blk] = *(const u32x4*)(U + ((unsigned)(sq * SEQ + chunk0 * 64) + 16 * blk + cl) * 512u + g * 16 + 8 * gg);
    for (int ci = 0; ci < nchunk; ++ci) {
        const int chunk = chunk0 + ci * cstride;
        u32x4 ulq[4];
#pragma unroll
        for (int blk = 0; blk < 4; ++blk) ulq[blk] = unx[blk];
        if (ci + 1 < nchunk) {
#pragma unroll
            for (int blk = 0; blk < 4; ++blk) unx[blk] = *(const u32x4*)(U + ((unsigned)(sq * SEQ + (chunk + cstride) * 64) + 16 * blk + cl) * 512u + g * 16 + 8 * gg);
        }
#pragma unroll
        for (int blk = 0; blk < 4; ++blk) {
            const bf16x8 uf = __builtin_bit_cast(bf16x8, g4 < 2 ? ulq[blk] : (u32x4){0u, 0u, 0u, 0u});
#pragma unroll
            for (int q = 0; q < 4; ++q) {
                const f32x4 xr = __builtin_amdgcn_mfma_f32_16x16x32_bf16(uf, bfr[q], (f32x4){0.f, 0.f, 0.f, 0.f}, 0, 0, 0);
                const f32x4 xi = __builtin_amdgcn_mfma_f32_16x16x32_bf16(uf, bfr[4 + q], (f32x4){0.f, 0.f, 0.f, 0.f}, 0, 0, 0);
                float er = xr[0], ei = xi[0];
#pragma unroll
                for (int i = 1; i < 4; ++i) { const float nr = fmaf(ar[q], er, fmaf(-ai[q], ei, xr[i])), ni = fmaf(ar[q], ei, fmaf(ai[q], er, xi[i])); er = nr; ei = ni; }
                const float nr = fmaf(Ar[q], accr[q], fmaf(-Ai[q], acci[q], er)), ni = fmaf(Ar[q], acci[q], fmaf(Ai[q], accr[q], ei));
                accr[q] = nr; acci[q] = ni;
            }
        }
    }
    {
        float outr = 0.f, outi = 0.f;
#pragma unroll
        for (int q = 0; q < 4; ++q) {
            float zr = wr_[q] * accr[q] - wi_[q] * acci[q], zi = wr_[q] * acci[q] + wi_[q] * accr[q];
            zr += __shfl_xor(zr, 16); zr += __shfl_xor(zr, 32); zi += __shfl_xor(zi, 16); zi += __shfl_xor(zi, 32);
            if (g4 == q) { outr = zr; outi = zi; }
        }
        const size_t cho = (((size_t)(sq * 32 + g)) * 32 + (chunk0 >> 3)) * 128;
        CH[cho + lane] = outr; CH[cho + 64 + lane] = outi;
    }
}
__device__ __forceinline__ void ssm_phase(const Params& p, int layer, int pass3, LAS unsigned char* lds, int bid, int tid) {
    asm volatile("" : "+v"(tid));
    const int lane = tid & 63, wave = tid >> 6; LAS unsigned char* wl = lds + wave * 12800;
    const int gw = bid * 8 + wave;
    { const int sqg = gw >> 5;
      if (pass3) ssm_task_v2(p, layer, 2, sqg >> 5, sqg & 31, 8 * (gw & 31), 8, 1, lane, wl);
      else ssm_pass1_fast(p, layer, sqg >> 5, sqg & 31, 8 * (gw & 31), 8, 1, lane); }
    if (!pass3 && gw >= 1536) { const int sg = gw - 1536; ssm_task_v2(p, layer, 1, sg >> 5, sg & 31, 0, 1, 1, lane, wl); }
}
__device__ __forceinline__ void carry_phase(const Params& p, int layer, int bid, int tid) {
    asm volatile("" : "+v"(tid));
    const int lane = tid & 63, wave = tid >> 6, gw = bid * 8 + wave;
    if (gw >= 64) return;
    float abr, abi, fr, fi; ssm_disc(p, layer, gw & 31, lane, abr, abi, fr, fi);
    float ar = abr, ai = abi;
#pragma unroll
    for (int i = 0; i < 9; ++i) { const float nr = ar * ar - ai * ai, ni = 2.0f * ar * ai; ar = nr; ai = ni; }
    float* CH = (float*)(p.ws + WS_CH) + (size_t)gw * 32 * 128;
    float cr = 0.f, ci = 0.f;
    float fr8[32], fi8[32];
#pragma unroll
    for (int j = 0; j < 32; ++j) { fr8[j] = CH[j * 128 + lane]; fi8[j] = CH[j * 128 + 64 + lane]; }
#pragma unroll
    for (int j = 0; j < 32; ++j) { CH[j * 128 + lane] = cr; CH[j * 128 + 64 + lane] = ci;
        const float nr = fmaf(ar, cr, fmaf(-ai, ci, fr8[j])), ni = fmaf(ar, ci, fmaf(ai, cr, fi8[j])); cr = nr; ci = ni; }
}

__device__ __forceinline__ void attn_phase(const Params& p, int layer, LAS unsigned char* lds, int bid, int tid) {
    asm volatile("" : "+v"(tid));
    const int lane = tid & 63, wave = tid >> 6, g4 = lane >> 4, cl = lane & 15;
    LAS bf16* Kl = (LAS bf16*)lds;
    LAS bf16* Vt = (LAS bf16*)(lds + 27648);
    const bf16* Qb = (const bf16*)(p.ws + WS_Q); const bf16* Kb = (const bf16*)(p.ws + WS_K); const bf16* Vb = (const bf16*)(p.ws + WS_V);
    bf16* Ob = (bf16*)(p.ws + WS_O);
    u32x4 pk[3], pv[3];
#define ATT_LOAD(TKX) do { const int tk_ = (TKX); const bool smp_ = tk_ >= 1024; \
        const int b_ = smp_ ? (tk_ - 1024) >> 1 : tk_ >> 9, n_ = smp_ ? 0 : (tk_ >> 1) & 255, kvh_ = tk_ & 1; \
        _Pragma("unroll") for (int i = 0; i < 3; ++i) { \
            const int idx = tid + NTHR * i, key = idx >> 3, c8 = idx & 7; \
            u32x4 kv = (u32x4){0u, 0u, 0u, 0u}, vv = (u32x4){0u, 0u, 0u, 0u}; \
            if (!smp_) { \
                const int pos = 64 * (n_ - 2) + key; \
                if (pos >= 0) { const size_t o = ((size_t)b_ * SEQ + pos) * 128 + kvh_ * 64 + 8 * c8; kv = *(const u32x4*)(Kb + o); vv = *(const u32x4*)(Vb + o); } \
            } else if (key < 128) { \
                const size_t o = ((((size_t)layer * 16 + b_) * 128 + key) * 2 + kvh_) * 64 + 8 * c8; \
                const f32x4 k0 = *(const f32x4*)(p.in[I_CK] + o), k1 = *(const f32x4*)(p.in[I_CK] + o + 4), v0 = *(const f32x4*)(p.in[I_CV] + o), v1 = *(const f32x4*)(p.in[I_CV] + o + 4); \
                kv.x = cvt_pk_bf16(k0.x, k0.y); kv.y = cvt_pk_bf16(k0.z, k0.w); kv.z = cvt_pk_bf16(k1.x, k1.y); kv.w = cvt_pk_bf16(k1.z, k1.w); \
                vv.x = cvt_pk_bf16(v0.x, v0.y); vv.y = cvt_pk_bf16(v0.z, v0.w); vv.z = cvt_pk_bf16(v1.x, v1.y); vv.w = cvt_pk_bf16(v1.z, v1.w); \
            } else if (key < 144) { \
                const size_t o = ((size_t)TP + b_ * 16 + (key - 128)) * 128 + kvh_ * 64 + 8 * c8; kv = *(const u32x4*)(Kb + o); vv = *(const u32x4*)(Vb + o); \
            } \
            pk[i] = kv; pv[i] = vv; } } while (0)
    ATT_LOAD(bid);
    for (int tk = bid; tk < 1024 + 32; tk += NWG) {
        const bool smp = tk >= 1024;
        const int b = smp ? (tk - 1024) >> 1 : tk >> 9, n = smp ? 0 : (tk >> 1) & 255, kvh = tk & 1;
        __syncthreads();
#pragma unroll
        for (int i = 0; i < 3; ++i) {
            const int idx = tid + NTHR * i, key = idx >> 3, c8 = idx & 7;
            const u32x4 kv = pk[i], vv = pv[i];
            *(LAS u32x4*)(Kl + key * 72 + 8 * c8) = kv;
            LAS bf16* vd = Vt + (8 * c8) * 200 + key;
            vd[0] = (bf16)(vv.x & 0xffffu); vd[200] = (bf16)(vv.x >> 16); vd[400] = (bf16)(vv.y & 0xffffu); vd[600] = (bf16)(vv.y >> 16);
            vd[800] = (bf16)(vv.z & 0xffffu); vd[1000] = (bf16)(vv.z >> 16); vd[1200] = (bf16)(vv.w & 0xffffu); vd[1400] = (bf16)(vv.w >> 16);
        }
        __syncthreads();
        if (tk + NWG < 1024 + 32) ATT_LOAD(tk + NWG);
        const int gh = wave & 3, qh = wave >> 2, h = kvh * 4 + gh;
        if (smp && qh == 1) continue;
        const int nq = smp ? 16 : 32;
        const size_t qrow0 = smp ? (size_t)TP + b * 16 : (size_t)b * SEQ + 64 * n + 32 * qh;
        bf16x8 qf[2][2];
#pragma unroll
        for (int nt = 0; nt < 2; ++nt) { int qi = 16 * nt + cl; if (qi >= nq) qi = nq - 1;
#pragma unroll
            for (int ks = 0; ks < 2; ++ks) qf[nt][ks] = *(const bf16x8*)(Qb + (qrow0 + qi) * 512 + h * 64 + 32 * ks + 8 * g4); }
        f32x4 s[12][2];
#pragma unroll
        for (int mt = 0; mt < 12; ++mt) {
            s[mt][0] = (f32x4){0.f, 0.f, 0.f, 0.f}; s[mt][1] = (f32x4){0.f, 0.f, 0.f, 0.f};
#pragma unroll
            for (int ks = 0; ks < 2; ++ks) { const bf16x8 a = *(const LAS bf16x8*)(Kl + (16 * mt + cl) * 72 + 32 * ks + 8 * g4);
                s[mt][0] = __builtin_amdgcn_mfma_f32_16x16x32_bf16(a, qf[0][ks], s[mt][0], 0, 0, 0);
                s[mt][1] = __builtin_amdgcn_mfma_f32_16x16x32_bf16(a, qf[1][ks], s[mt][1], 0, 0, 0); }
            const bool valid = smp ? (mt < 9) : (n - 2 + (mt >> 2) >= 0);
            if (!valid) { s[mt][0] = (f32x4){-1e30f, -1e30f, -1e30f, -1e30f}; s[mt][1] = s[mt][0]; }
        }
        const float sink = p.in[I_SINK][layer * 8 + h];
        float inv[2];
#pragma unroll
        for (int nt = 0; nt < 2; ++nt) {
            float mx = sink;
#pragma unroll
            for (int mt = 0; mt < 12; ++mt) mx = fmaxf(mx, fmaxf(fmaxf(s[mt][nt].x, s[mt][nt].y), fmaxf(s[mt][nt].z, s[mt][nt].w)));
            mx = fmaxf(mx, __shfl_xor(mx, 16)); mx = fmaxf(mx, __shfl_xor(mx, 32));
            float sum = 0.f;
#pragma unroll
            for (int mt = 0; mt < 12; ++mt) {
#pragma unroll
                for (int e = 0; e < 4; ++e) { const float pe = __expf(s[mt][nt][e] - mx); s[mt][nt][e] = pe; sum += pe; } }
            sum += __shfl_xor(sum, 16); sum += __shfl_xor(sum, 32);
            inv[nt] = 1.0f / (sum + __expf(sink - mx));
        }
        f32x4 o[4][2];
#pragma unroll
        for (int dt = 0; dt < 4; ++dt) { o[dt][0] = (f32x4){0.f, 0.f, 0.f, 0.f}; o[dt][1] = (f32x4){0.f, 0.f, 0.f, 0.f}; }
#pragma unroll
        for (int ks = 0; ks < 6; ++ks) {
            bf16x8 pf[2];
#pragma unroll
            for (int nt = 0; nt < 2; ++nt) { u32x4 t; t.x = cvt_pk_bf16(s[2 * ks][nt].x, s[2 * ks][nt].y); t.y = cvt_pk_bf16(s[2 * ks][nt].z, s[2 * ks][nt].w);
                t.z = cvt_pk_bf16(s[2 * ks + 1][nt].x, s[2 * ks + 1][nt].y); t.w = cvt_pk_bf16(s[2 * ks + 1][nt].z, s[2 * ks + 1][nt].w); pf[nt] = __builtin_bit_cast(bf16x8, t); }
#pragma unroll
            for (int dt = 0; dt < 4; ++dt) {
                const LAS bf16* vp = Vt + (16 * dt + cl) * 200 + 32 * ks + 4 * g4;
                const u32x2 lo = *(const LAS u32x2*)vp, hi = *(const LAS u32x2*)(vp + 16);
                const bf16x8 a = __builtin_bit_cast(bf16x8, (u32x4){lo.x, lo.y, hi.x, hi.y});
                o[dt][0] = __builtin_amdgcn_mfma_f32_16x16x32_bf16(a, pf[0], o[dt][0], 0, 0, 0);
                o[dt][1] = __builtin_amdgcn_mfma_f32_16x16x32_bf16(a, pf[1], o[dt][1], 0, 0, 0);
            }
        }
#pragma unroll
        for (int nt = 0; nt < 2; ++nt) { const int qi = 16 * nt + cl;
            if (qi < nq) {
#pragma unroll
                for (int dt = 0; dt < 4; ++dt) st_bf4(Ob + (qrow0 + qi) * 512 + h * 64 + 16 * dt + 4 * g4, o[dt][nt] * inv[nt]); } }
    }
    __syncthreads();
}

__global__ void __launch_bounds__(512, 2) fwd(Params p) {
    extern __shared__ __attribute__((aligned(16))) unsigned char lds_raw[];
    LAS unsigned char* lds = (LAS unsigned char*)lds_raw;
    cg::grid_group grid = cg::this_grid();
    const int bid = blockIdx.x, tid = threadIdx.x, G = gridDim.x;
    unsigned char* ws = p.ws;
    float* X = p.out;
    bf16* H = (bf16*)(ws + WS_H);
    const float* modall = (const float*)(ws + WS_MOD);
    if (tid < 16) ((volatile LAS unsigned*)(lds + MISC_OFF))[tid] = 0u;
    __syncthreads();
    const xb::XcdBarrier bar = xb::xcd_barrier_post((unsigned*)(ws + WS_BAR), (volatile LAS unsigned*)(lds + MISC_OFF));
#define GSYNC() xb::xcd_barrier(bar)

#if !defined(ONLY) || ONLY == 0
    REPK(10) { p0_prologue(p, lds, bid, tid); if (PROBE == 10) { asm volatile("s_waitcnt vmcnt(0) lgkmcnt(0)" ::: "memory"); __syncthreads(); } }
    if (PROBE == 7 || PROBE == 8) { float* zr = (float*)(ws + WS_ZERO); for (int i = bid * NTHR + tid; i < 18 * NADA; i += NWG * NTHR) zr[i] = 0.f; }
#endif
    grid.sync();
    for (int layer = 0; layer < DEPTH; ++layer) {
        unsigned char* wl = ws + WS_W + (size_t)layer * W_L;
        const float* modl = modall + (size_t)layer * 18 * NADA;
#if !defined(ONLY) || ONLY == 1
        REPK(4) norm_phase(p, layer, 0, bid, tid);
#endif
        GSYNC();
#if !defined(ONLY) || ONLY == 2
        REPK(1) { Gemm g{H, (const bf16*)(wl + W_IN), MT, INC, D}; StaticOrder S; S.init(MT, INC, G, bid);
          EpiWin E{(bf16*)(ws + WS_U), (bf16*)(ws + WS_Q), (bf16*)(ws + WS_K), (bf16*)(ws + WS_V), (bf16*)(ws + WS_G), (const float*)(ws + WS_ROPE), p.out, layer};
          pg8::gemm_phase<EpiWin, StaticOrder, 0>(lds, g, S, E, nullptr); }
        GSYNC();
#endif
#if !defined(ONLY) || ONLY == 3
        REPK(2) ssm_phase(p, layer, 0, lds, bid, tid);
#endif
#if !defined(ONLY) || ONLY == 4
        REPK(3) attn_phase(p, layer, lds, bid, tid);
#endif
        GSYNC();
#if !defined(ONLY) || ONLY == 5
        carry_phase(p, layer, bid, tid);
        REPK(9) { Gemm g{(const bf16*)(ws + WS_O), (const bf16*)(wl + W_O), TP, D, 512}; StaticOrder S; S.init(TP, D, G, bid);
          EpiAttnO E{(const bf16*)(ws + WS_G), (bf16*)(ws + WS_P)};
          pg8::gemm_phase<EpiAttnO, StaticOrder, 0>(lds, g, S, E, nullptr);
          small_gemm<4>(g.A + (size_t)TP * 512, g.Bt, D, 512, TP, E, lds, bid, tid); }
        GSYNC();
#endif
#if !defined(ONLY) || ONLY == 3
        REPK(2) ssm_phase(p, layer, 1, lds, bid, tid);
#endif
        GSYNC();
#if !defined(ONLY) || ONLY == 6
        { Gemm g{(const bf16*)(ws + WS_YG), (const bf16*)(wl + W_GLU), TP, 2048, 512}; StaticOrder S; S.init(TP, 2048, G, bid);
          EpiGlu E{(const bf16*)(ws + WS_G), (bf16*)(ws + WS_P)};
          pg8::gemm_phase<EpiGlu, StaticOrder, 0>(lds, g, S, E, nullptr);
          small_gemm<2>(g.A + (size_t)TP * 512, g.Bt, 2048, 512, TP, E, lds, bid, tid); }
        GSYNC();
#endif
#if !defined(ONLY) || ONLY == 7
        { Gemm g{(const bf16*)(ws + WS_P), (const bf16*)(wl + W_OUT), TP, D, D}; StaticOrder S; S.init(TP, D, G, bid);
          EpiRes E{layer == 0 ? p.in[I_XP] : X, X, modl + 2048};
          pg8::gemm_phase<EpiRes, StaticOrder, 0>(lds, g, S, E, nullptr);
          EpiRes Es{layer == 0 ? p.in[I_XS] - (size_t)TP * D : X, X, modl + 2048};
          small_gemm<4>(g.A + (size_t)TP * D, g.Bt, D, D, TP, Es, lds, bid, tid); }
        GSYNC();
#endif
#if !defined(ONLY) || ONLY == 1
        REPK(4) norm_phase(p, layer, 1, bid, tid);
#endif
        GSYNC();
#if !defined(ONLY) || ONLY == 9
        REPK(5) { Gemm g{H, (const bf16*)(wl + W_UP), UP_TILES * 256, FF2, D}; StaticOrder S; S.init(UP_TILES * 256, FF2, G, bid);
          EpiUp<false> E{(bf16*)(ws + WS_ACT), p.in[I_CW] + (size_t)layer * 3 * FF2, p.in[I_CB] + (size_t)layer * FF2, nullptr, p.out, layer};
          pg8::gemm_phase<EpiUp<false>, StaticOrder, 1>(lds, g, S, E, nullptr); }
        { Gemm g{H + (size_t)HS_SAMPLE * D, (const bf16*)(wl + W_UP), 256, FF2, D}; StaticOrder S; S.init(256, FF2, G, G - 1 - bid);
          EpiUp<true> E{(bf16*)(ws + WS_ACT), p.in[I_CW] + (size_t)layer * 3 * FF2, p.in[I_CB] + (size_t)layer * FF2, p.in[I_SCONV] + (size_t)layer * 16 * 2 * FF2, p.out, layer};
          pg8::gemm_phase<EpiUp<true>, StaticOrder, 0>(lds, g, S, E, nullptr); }
        GSYNC();
#endif
        if (PROBE == 6) { for (int i_ = 0; i_ < 10; ++i_) GSYNC(); }
#if !defined(ONLY) || ONLY == 10
        { Gemm g{(const bf16*)(ws + WS_ACT), (const bf16*)(wl + W_DN), TP, D, FF}; StaticOrder S; S.init(TP, D, G, bid);
          EpiRes E{X, X, modl + 5120};
          pg8::gemm_phase<EpiRes, StaticOrder, 0>(lds, g, S, E, nullptr);
          small_gemm<4>(g.A + (size_t)TP * FF, g.Bt, D, FF, TP, E, lds, bid, tid); }
#endif
        GSYNC();
    }
#if !defined(ONLY) || ONLY == 1
    norm_phase(p, 0, 2, bid, tid);
#endif
}
}

extern "C" void kernel_launch(void* const* d_in, const int* in_sizes, int n_in, void* d_out, int out_size, void* d_ws, size_t ws_size, hipStream_t stream) {
    static int ok = 0;
    if (ok == 0) {
        ok = 1;
        if (n_in != 31 || (size_t)out_size != mk::O_END || ws_size < mk::WS_BAR + mk::BAR_BYTES) { fprintf(stderr, "kernel_launch: unexpected shapes n_in %d out %d ws %zu (need %zu)\n", n_in, out_size, ws_size, (size_t)mk::WS_END); ok = -1; }
        if (hipFuncSetAttribute((const void*)mk::fwd, hipFuncAttributeMaxDynamicSharedMemorySize, mk::LDS_BYTES) != hipSuccess) { fprintf(stderr, "kernel_launch: hipFuncSetAttribute failed\n"); ok = -1; }
        int per_cu = 0;
        if (hipOccupancyMaxActiveBlocksPerMultiprocessor(&per_cu, (const void*)mk::fwd, mk::NTHR, mk::LDS_BYTES) != hipSuccess || per_cu < 1) fprintf(stderr, "kernel_launch: occupancy query says %d blocks per CU\n", per_cu);
        (void)hipGetLastError();
    }
    if (ok < 0) return;
    if (hipMemsetAsync((char*)d_ws + mk::WS_BAR, 0, mk::BAR_BYTES, stream) != hipSuccess) { fprintf(stderr, "kernel_launch: memset of the barrier words failed\n"); return; }
    mk::Params p{};
    for (int i = 0; i < 31; ++i) p.in[i] = (const float*)d_in[i];
    p.out = (float*)d_out; p.ws = (unsigned char*)d_ws;
    void* args[] = {&p};
    hipError_t e = hipLaunchCooperativeKernel((void*)mk::fwd, dim3(mk::NWG), dim3(mk::NTHR), args, mk::LDS_BYTES, stream);
    if (e != hipSuccess) fprintf(stderr, "kernel_launch: cooperative launch failed: %s\n", hipGetErrorString(e));
}
```

```cpp
#include <hip/hip_runtime.h>
#include <hip/hip_cooperative_groups.h>
#include <cstdio>
#include <cstdint>
namespace cg = cooperative_groups;
namespace pg8 {
#define PG8_LAS __attribute__((address_space(3)))
typedef unsigned short bf16_t;
typedef short bf16x8 __attribute__((ext_vector_type(8)));
typedef float f32x4 __attribute__((ext_vector_type(4)));
typedef unsigned u32x4 __attribute__((ext_vector_type(4)));
constexpr int BM = 256, BK = 64, HALF = 128, HTB = HALF * BK * 2  , STAGE_BYTES = 8 * HTB, NXCD = 8, WGM = 8;

__host__ __device__ __forceinline__ int lds_byte(int r, int c) { const int st = (r >> 4) * 2 + (c >> 5), rr = r & 15, cc = c & 31, ob = rr * 64 + cc * 2; return st * 1024 + (ob ^ (((ob >> 9) & 1) << 5)); }
__host__ __device__ __forceinline__ void stage_rc(int b, int& R, int& C) { const int st = b / 1024, sb = b % 1024, swz = sb ^ (((sb >> 9) & 1) << 5); R = (st >> 1) * 16 + swz / 64; C = (st & 1) * 32 + (swz % 64) / 2; }
__host__ __device__ __forceinline__ int perm32(int rho) { const int n = rho >> 4, i = rho & 15; return 8 * (i >> 2) + 4 * n + (i & 3); }

struct Unit { int pm, pn; };
struct Gemm { const bf16_t* A; const bf16_t* Bt; int M, N, K; };
struct StaticOrder {
    int nM, nN, nwg, G, c;
    __host__ __device__ void init(int M, int N, int G_, int c_) { nM = M / BM; nN = N / BM; nwg = nM * nN; G = G_; c = c_; }
    __host__ __device__ bool next(int i, Unit& u) const {
        const long L = (long)i * G + c; if (L >= nwg) return false;
        int wgid = (int)L; { const int q = nwg / NXCD, r = nwg % NXCD, xcd = wgid % NXCD, off = wgid / NXCD; wgid = (xcd < r ? xcd * (q + 1) : r * (q + 1) + (xcd - r) * q) + off; }
        const int nig = WGM * nN, gid = wgid / nig, fm = gid * WGM, gsz = (nM - fm) < WGM ? (nM - fm) : WGM;
        u.pm = fm + ((wgid % nig) % gsz); u.pn = (wgid % nig) / gsz; return true;
    }
    __device__ __forceinline__ void a_ready(const Unit&) const {}
    __device__ __forceinline__ void done(const Unit&) const {}
};
__device__ __forceinline__ unsigned cvt_pk_bf16(float lo, float hi) { unsigned r; asm volatile("v_cvt_pk_bf16_f32 %0, %1, %2" : "=v"(r) : "v"(lo), "v"(hi)); return r; }
template <class Epi, class Sched, int AMAP = 0, bool STAMP = false>
__device__ __forceinline__ void gemm_phase(PG8_LAS unsigned char* lds, const Gemm g, const Sched& S, const Epi& E, unsigned long long* stamps) {
    int tid_o = threadIdx.x; asm volatile("" : "+v"(tid_o)); const int tid = tid_o, wid = __builtin_amdgcn_readfirstlane(tid >> 6), lane = tid & 63, wr = wid >> 2, wc = wid & 3, fr = lane & 15, fq = lane >> 4;
    const int K = g.K, nt = K / BK;
    int ts_lo = 0, ts_hi = 0, nts = 0; const unsigned long long rt_entry = STAMP ? (unsigned long long)0ull : 0ull;
#define PG8_STAMP() do { if (STAMP && wid == 0 && nts < 64) { const unsigned long long _c = (unsigned long long)0ull; \
        ts_lo = (lane == nts) ? (int)(unsigned)_c : ts_lo; ts_hi = (lane == nts) ? (int)(unsigned)(_c >> 32) : ts_hi; ++nts; } } while (0)
    PG8_STAMP();
    unsigned voffA[2], voffB[2];
#pragma unroll
    for (int i = 0; i < 2; ++i) { int R, C; stage_rc(tid * 16 + i * 8192, R, C); const int Rb = Epi::PERM ? ((R & ~31) + perm32(R & 31)) : R;
        const int Ra = AMAP ? ((R >> 6) * 62 + (R & 63)) : R; voffA[i] = (unsigned)(Ra * K + C) * 2u; voffB[i] = (unsigned)(Rb * K + C) * 2u; }
    const size_t kstep = (size_t)(BK * 2);
    const size_t hstep = (size_t)HALF * K * 2;
    const size_t tstep = 2 * hstep; const size_t hstepA = AMAP ? (size_t)124 * K * 2 : hstep; const size_t tstepA = 2 * hstepA;
    const unsigned ldsw = (unsigned)wid * 1024u;
    const int aoff = lds_byte(wr * 64 + fr, fq * 8), boff = lds_byte(wc * 32 + fr, fq * 8);
#define PG8_SA(b, h) (((b) * 2 + (h)) * HTB)
#define PG8_SB(b, h) ((4 + (b) * 2 + (h)) * HTB)
#define PG8_STAGE(bufoff, gbase, voff) do { _Pragma("unroll") for (int _i = 0; _i < 2; ++_i) \
        __builtin_amdgcn_global_load_lds((const unsigned*)((const char*)(gbase) + (voff)[_i]), (PG8_LAS unsigned*)(lds + (bufoff) + ldsw + _i * 8192), 16, 0, 0); } while (0)
#define PG8_LDA(dst, b, h) do { _Pragma("unroll") for (int m = 0; m < 4; ++m) _Pragma("unroll") for (int k = 0; k < 2; ++k) dst[m][k] = *(const PG8_LAS bf16x8*)(lds + PG8_SA(b, h) + aoff + m * 2048 + k * 1024); } while (0)
#define PG8_LDB(dst, b, h) do { _Pragma("unroll") for (int n = 0; n < 2; ++n) _Pragma("unroll") for (int k = 0; k < 2; ++k) dst[n][k] = *(const PG8_LAS bf16x8*)(lds + PG8_SB(b, h) + boff + n * 2048 + k * 1024); } while (0)
#define PG8_MMA(ai, bj, At, Bt) do { __builtin_amdgcn_s_setprio(1); _Pragma("unroll") for (int m = 0; m < 4; ++m) _Pragma("unroll") for (int n = 0; n < 2; ++n) _Pragma("unroll") for (int k = 0; k < 2; ++k) \
        acc[ai][bj][m][n] = __builtin_amdgcn_mfma_f32_16x16x32_bf16(Bt[n][k], At[m][k], acc[ai][bj][m][n], 0, 0, 0); __builtin_amdgcn_s_setprio(0); } while (0)
#define PG8_WAIT_V(n) asm volatile("s_waitcnt vmcnt(" #n ")" ::: "memory")
#define PG8_WAIT_L(n) asm volatile("s_waitcnt lgkmcnt(" #n ")" ::: "memory")
#define PG8_BAR __builtin_amdgcn_s_barrier()
#define PG8_SCHED __builtin_amdgcn_sched_barrier(0)
    Unit cur, nxt; int ui = 0;
    if (!S.next(0, cur)) return;
    f32x4 acc[2][2][4][2];
#pragma unroll
    for (int a = 0; a < 2; ++a)
#pragma unroll
        for (int b = 0; b < 2; ++b)
#pragma unroll
            for (int m = 0; m < 4; ++m)
#pragma unroll
                for (int n = 0; n < 2; ++n) acc[a][b][m][n] = (f32x4){0.f, 0.f, 0.f, 0.f};
    bf16x8 At[4][2], B0[2][2], B1[2][2];
    const char* cA = (const char*)g.A + (size_t)cur.pm * tstepA; const char* cB = (const char*)g.Bt + (size_t)cur.pn * tstep;
    S.a_ready(cur);
    PG8_STAGE(PG8_SB(0, 0), cB, voffB); PG8_STAGE(PG8_SA(0, 0), cA, voffA); PG8_STAGE(PG8_SB(0, 1), cB + hstep, voffB); PG8_STAGE(PG8_SA(0, 1), cA + hstepA, voffA);
    if (wr == 1) PG8_BAR;
    PG8_WAIT_V(4); PG8_BAR;
    PG8_STAGE(PG8_SB(1, 0), cB + kstep, voffB); PG8_STAGE(PG8_SA(1, 0), cA + kstep, voffA); PG8_STAGE(PG8_SB(1, 1), cB + hstep + kstep, voffB);
    PG8_WAIT_V(6); PG8_BAR;
    PG8_STAMP();
    for (;;) {
        const bool has_next = S.next(ui + 1, nxt);
        const char* nA = has_next ? (const char*)g.A + (size_t)nxt.pm * tstepA : cA; const char* nB = has_next ? (const char*)g.Bt + (size_t)nxt.pn * tstep : cB;
        for (int t = 0; t < nt; t += 2) {
            const bool last = (t == nt - 2);
            const char* a1 = cA + (size_t)(t + 1) * kstep;
            const char* a2 = last ? nA : cA + (size_t)(t + 2) * kstep; const char* b2 = last ? nB : cB + (size_t)(t + 2) * kstep;
            const char* a3 = a2 + kstep; const char* b3 = b2 + kstep;
            if (last && has_next) S.a_ready(nxt);
            PG8_LDB(B0, 0, 0); PG8_SCHED; PG8_LDA(At, 0, 0); PG8_STAGE(PG8_SA(1, 1), a1 + hstepA, voffA);
            PG8_WAIT_L(8); PG8_BAR; PG8_WAIT_L(0); PG8_MMA(0, 0, At, B0); PG8_BAR; PG8_SCHED;
            PG8_LDB(B1, 0, 1); PG8_STAGE(PG8_SB(0, 0), b2, voffB);
            PG8_BAR; PG8_WAIT_L(0); PG8_MMA(0, 1, At, B1); PG8_BAR;
            PG8_LDA(At, 0, 1); PG8_STAGE(PG8_SA(0, 0), a2, voffA);
            PG8_BAR; PG8_WAIT_L(0); PG8_MMA(1, 0, At, B0); PG8_BAR; PG8_SCHED;
            PG8_STAGE(PG8_SB(0, 1), b2 + hstep, voffB);
            PG8_WAIT_V(6); PG8_BAR; PG8_MMA(1, 1, At, B1); PG8_BAR;
            PG8_LDB(B0, 1, 0); PG8_SCHED; PG8_LDA(At, 1, 0); PG8_STAGE(PG8_SA(0, 1), a2 + hstepA, voffA);
            PG8_WAIT_L(8); PG8_BAR; PG8_WAIT_L(0); PG8_MMA(0, 0, At, B0); PG8_BAR; PG8_SCHED;
            PG8_LDB(B1, 1, 1); PG8_STAGE(PG8_SB(1, 0), b3, voffB);
            PG8_BAR; PG8_WAIT_L(0); PG8_MMA(0, 1, At, B1); PG8_BAR;
            PG8_LDA(At, 1, 1); PG8_STAGE(PG8_SA(1, 0), a3, voffA);
            PG8_BAR; PG8_WAIT_L(0); PG8_MMA(1, 0, At, B0); PG8_BAR; PG8_SCHED;
            PG8_STAGE(PG8_SB(1, 1), b3 + hstep, voffB);
            PG8_WAIT_V(6); PG8_BAR; PG8_MMA(1, 1, At, B1); PG8_BAR;
        }
        PG8_STAMP();
        if (wr == 0) PG8_BAR;
        if constexpr (!Epi::AFTER_DRAIN) { E(acc, cur, wr, wc, fr, fq); S.done(cur); }
        PG8_STAMP();
        if (!has_next) break;
#pragma unroll
        for (int a = 0; a < 2; ++a)
#pragma unroll
            for (int b = 0; b < 2; ++b)
#pragma unroll
                for (int m = 0; m < 4; ++m)
#pragma unroll
                    for (int n = 0; n < 2; ++n) acc[a][b][m][n] = (f32x4){0.f, 0.f, 0.f, 0.f};
        cur = nxt; cA = nA; cB = nB; ++ui;
        if (wr == 1) PG8_BAR;
    }
    PG8_WAIT_V(0);
    PG8_BAR;
    if constexpr (Epi::AFTER_DRAIN) { E.fused(acc, cur, wr, wc, fr, fq, lds, wid, lane); S.done(cur); }
    PG8_STAMP();
    if (STAMP && wid == 0) { stamps[lane] = lane < nts ? (((unsigned long long)(unsigned)ts_hi << 32) | (unsigned)ts_lo) : 0ull;
        if (lane == 62) stamps[62] = rt_entry; if (lane == 63) stamps[63] = (unsigned long long)0ull; }
#undef PG8_STAMP
#undef PG8_SA
#undef PG8_SB
#undef PG8_STAGE
#undef PG8_LDA
#undef PG8_LDB
#undef PG8_MMA
#undef PG8_WAIT_V
#undef PG8_WAIT_L
#undef PG8_BAR
#undef PG8_SCHED
}
}
namespace xb {
#define XB_TMO      128
#define XB_XCNT(j)  (256  + 64 * (j))
#define XB_XSUB(j)  (1280 + 64 * (j))
#define XB_XGEN(j)  (2304 + 64 * (j))
#define XB_TOP      3328
#define XB_TOPGEN   3392
#define XCD_BAR_WORDS 3456
#define XB_SPIN_CAP (1u << 18)

__device__ __forceinline__ unsigned xb_ld(unsigned* p)              { return __hip_atomic_load(p, __ATOMIC_RELAXED, __HIP_MEMORY_SCOPE_AGENT); }
__device__ __forceinline__ unsigned xb_add(unsigned* p, unsigned v) { return __hip_atomic_fetch_add(p, v, __ATOMIC_RELAXED, __HIP_MEMORY_SCOPE_AGENT); }
__device__ __forceinline__ unsigned xb_xcc_id() { return (unsigned)__builtin_amdgcn_s_getreg((3 << 11) | 20) & 0xFu; }
#define XB_SPIN(cond, bar) do { unsigned _sp = 0; while (cond) { __builtin_amdgcn_s_sleep(1); \
    if ((++_sp & 255u) == 0u) { if (xb_ld(&(bar)[XB_TMO])) break; if (_sp > XB_SPIN_CAP) { atomicAdd(&(bar)[XB_TMO], 1u); break; } } } } while (0)

struct XcdBarrier {
    unsigned* bar; unsigned x;
    volatile __attribute__((address_space(3))) unsigned* st;
};

__device__ __forceinline__ XcdBarrier xcd_barrier_post(unsigned* bar, volatile __attribute__((address_space(3))) unsigned* st) {
    XcdBarrier b; b.bar = bar; b.x = xb_xcc_id(); b.st = st;
    if (threadIdx.x == 0) (void)xb_add(&bar[XB_XCNT(b.x)], 1u);
    return b;
}
__device__ __forceinline__ void xcd_barrier_complete(unsigned* bar, unsigned x, unsigned& nloc, unsigned& nx) {
    const unsigned G = gridDim.x * gridDim.y * gridDim.z;
    unsigned sum, cnt, mine, sp = 0u;
    for (;;) {
        sum = 0u; cnt = 0u; mine = 0u;
#pragma unroll
        for (unsigned j = 0; j < 16; ++j) { const unsigned c = xb_ld(&bar[XB_XCNT(j)]); sum += c; cnt += (c > 0u) ? 1u : 0u; mine = (j == x) ? c : mine; }
        if (sum == G) break;
        __builtin_amdgcn_s_sleep(1);
        if ((++sp & 255u) == 0u) { if (xb_ld(&bar[XB_TMO])) break; if (sp > XB_SPIN_CAP) { atomicAdd(&bar[XB_TMO], 1u); break; } }
    }
    nloc = mine > 0u ? mine : 1u; nx = cnt > 0u ? cnt : 1u;
}

__device__ __forceinline__ void xcd_barrier(const XcdBarrier& b) {
    asm volatile("s_waitcnt vmcnt(0)" ::: "memory");
    __syncthreads();
    if (threadIdx.x == 0) {
        unsigned* bar = b.bar;
        __builtin_amdgcn_s_waitcnt(0);
        unsigned nloc = b.st[0], nx = b.st[1];
        if (nloc == 0u) { xcd_barrier_complete(bar, b.x, nloc, nx); b.st[0] = nloc; b.st[1] = nx; }
        const unsigned old = xb_add(&bar[XB_XSUB(b.x)], 1u);
        const unsigned gen = old / nloc;
        if (old + 1u == (gen + 1u) * nloc) {
            __builtin_amdgcn_fence(__ATOMIC_RELEASE, "agent");
            asm volatile("s_waitcnt vmcnt(0)" ::: "memory");
            const unsigned og = xb_add(&bar[XB_TOP], 1u);
            const unsigned tg = og / nx;
            if (og + 1u == (tg + 1u) * nx) xb_add(&bar[XB_TOPGEN], 1u);
            else XB_SPIN(xb_ld(&bar[XB_TOPGEN]) == tg, bar);
            __builtin_amdgcn_fence(__ATOMIC_ACQUIRE, "agent");
            xb_add(&bar[XB_XGEN(b.x)], 1u);
            asm volatile("s_waitcnt vmcnt(0)" ::: "memory");
        } else {
            XB_SPIN(xb_ld(&bar[XB_XGEN(b.x)]) == gen, bar);
            __builtin_amdgcn_fence(__ATOMIC_ACQUIRE, "agent");
            asm volatile("s_waitcnt vmcnt(0)" ::: "memory");
        }
    }
    __syncthreads();
}

}
#ifndef PROBE
#define PROBE 0
#endif
#define REPK(k) _Pragma("unroll 1") for (int rep_ = 0; rep_ < ((PROBE == (k)) ? 2 : 1); ++rep_)
namespace mk {
#ifndef SCHB
#define SCHB (void)0
#endif
using pg8::Unit; using pg8::Gemm; using pg8::StaticOrder; using pg8::cvt_pk_bf16;
#define LAS __attribute__((address_space(3)))
typedef unsigned short bf16;
typedef float f32x4 __attribute__((ext_vector_type(4)));
typedef short bf16x8 __attribute__((ext_vector_type(8)));
typedef unsigned u32x2 __attribute__((ext_vector_type(2)));
typedef unsigned u32x4 __attribute__((ext_vector_type(4)));

constexpr int D = 1024, SEQ = 16384, TP = 32768, TS = 256, MT = 33024, DEPTH = 4, INC = 3328, FF = 2816, FF2 = 5632, NADA = 6144;
constexpr int HSEQ = 16386, HS_SAMPLE = 33280, H_ROWS = 33536, UP_TILES = 133;
constexpr int NWG = 256, NTHR = 512;
constexpr int LDS_BYTES = 135168;
constexpr size_t O_Y = 0, O_YS = 33554432, O_KP = 33816576, O_VP = 33947648, O_SRP = 34078720, O_SIP = 34095104, O_CP = 34111488,
                 O_KS = 34201600, O_VS = 34332672, O_SRS = 34463744, O_SIS = 34594816, O_CS = 34725888, O_END = 35446784;
constexpr size_t WS_BAR = 518586368, BAR_BYTES = 16384;
constexpr size_t WS_ZERO = 518602752;
constexpr int MISC_OFF = 131072;
constexpr size_t W_L = 29360128, W_IN = 0, W_GLU = 6815744, W_O = 8912896, W_OUT = 9961472, W_UP = 12058624, W_DN = 23592960;
constexpr size_t WS_W = 0, WS_MOD = 117440512, WS_ROPE = 119209984, WS_CH = 120258560, WS_H = 128647168, WS_O = WS_H, WS_YG = WS_H + 33816576,
                 WS_U = 197328896, WS_Q = 264962048, WS_K = 298778624, WS_V = 307232768, WS_G = 315686912, WS_P = 450953216, WS_END = 518586368, WS_ACT = WS_U;

struct Params { const float* in[31]; float* out; unsigned char* ws; };
enum { I_XP = 0, I_XS, I_CK, I_CV, I_SRE, I_SIM, I_SCONV, I_CP, I_CS, I_ADAW, I_ADAB, I_N1G, I_N2G, I_WIN, I_ARE, I_AIM, I_LDT, I_BRE, I_BIM, I_CRE, I_CIM, I_SD,
       I_WGLU, I_SINK, I_WO, I_WOUT, I_WUP, I_CW, I_CB, I_WDN, I_FG };

__device__ __forceinline__ float bf2f(unsigned h) { return __uint_as_float(h << 16); }
__device__ __forceinline__ unsigned f2bf(float f) { unsigned u = __float_as_uint(f); return (u + 0x7fffu + ((u >> 16) & 1u)) >> 16; }
__device__ __forceinline__ float sigm(float x) { return __builtin_amdgcn_rcpf(1.0f + __builtin_amdgcn_exp2f(-1.4426950409f * x)); }
__device__ __forceinline__ float gelu_tanh(float x) { const float z = 1.5957691216f * (x + 0.044715f * x * x * x); return x * sigm(z); }
__device__ __forceinline__ f32x4 ld_bf4(const bf16* p) { const u32x2 v = *(const u32x2*)p; return (f32x4){__uint_as_float(v.x << 16), __uint_as_float(v.x & 0xffff0000u), __uint_as_float(v.y << 16), __uint_as_float(v.y & 0xffff0000u)}; }
__device__ __forceinline__ void st_bf4(bf16* p, f32x4 v) { u32x2 o; o.x = cvt_pk_bf16(v.x, v.y); o.y = cvt_pk_bf16(v.z, v.w); *(u32x2*)p = o; }
__device__ __forceinline__ int modrow_of(int row) { return row < TP ? (row >> 14) : 2 + ((row - TP) >> 4); }
__device__ __forceinline__ int pos_of(int row) { return row < TP ? (row & (SEQ - 1)) : 2048 + ((row - TP) & 15); }
__device__ __forceinline__ float wave_sum(float v) {
#pragma unroll
    for (int o = 1; o < 64; o <<= 1) v += __shfl_xor(v, o);
    return v;
}
template <int CTRL> __device__ __forceinline__ float dpp_mov(float old, float src) {
    return __builtin_bit_cast(float, __builtin_amdgcn_update_dpp(__builtin_bit_cast(int, old), __builtin_bit_cast(int, src), CTRL, 0xf, 0xf, false));
}
template <int CTRL> __device__ __forceinline__ float dpp_rot(float src) {
    return __builtin_bit_cast(float, __builtin_amdgcn_mov_dpp(__builtin_bit_cast(int, src), CTRL, 0xf, 0xf, true));
}
__device__ __forceinline__ f32x4 row_prev1(f32x4 cur, f32x4 pm) { f32x4 r;
#pragma unroll
    for (int e = 0; e < 4; ++e) r[e] = dpp_mov<0x111>(dpp_rot<0x121>(pm[e]), cur[e]);
    return r; }
__device__ __forceinline__ f32x4 row_prev2(f32x4 cur, f32x4 pm) { f32x4 r;
#pragma unroll
    for (int e = 0; e < 4; ++e) r[e] = dpp_mov<0x112>(dpp_rot<0x122>(pm[e]), cur[e]);
    return r; }

typedef float f32x2 __attribute__((ext_vector_type(2)));
template <int E> __device__ __forceinline__ f32x2 conv_pair(f32x4 b, f32x4 w0, f32x4 w1, f32x4 w2, f32x4 cur, f32x4 pm) {
    const f32x2 c = (f32x2){cur[E], cur[E + 1]};
    const f32x2 p1 = (f32x2){dpp_mov<0x111>(dpp_rot<0x121>(pm[E]), cur[E]), dpp_mov<0x111>(dpp_rot<0x121>(pm[E + 1]), cur[E + 1])};
    const f32x2 p2 = (f32x2){dpp_mov<0x112>(dpp_rot<0x122>(pm[E]), cur[E]), dpp_mov<0x112>(dpp_rot<0x122>(pm[E + 1]), cur[E + 1])};
    f32x2 r = (f32x2){b[E], b[E + 1]} + (f32x2){w2[E], w2[E + 1]} * c;
    r = (f32x2){w1[E], w1[E + 1]} * p1 + r;
    r = (f32x2){w0[E], w0[E + 1]} * p2 + r;
    return r;
}
struct EpiWin {
    static constexpr bool PERM = false, AFTER_DRAIN = false;
    bf16* U; bf16* Q; bf16* Kb; bf16* Vb; bf16* G; const float* rope; float* out; int layer;
    __device__ __forceinline__ f32x4 rot(f32x4 v, f32x4 cs, f32x4 sn, int fq) const {
        f32x4 o, r;
#pragma unroll
        for (int e = 0; e < 4; ++e) o[e] = __shfl_xor(v[e], 32);
        if (fq < 2) r = v * cs - o * sn; else r = v * cs + o * sn;
        return r;
    }
    __device__ __forceinline__ void operator()(const f32x4 (&acc)[2][2][4][2], const Unit& u, int wr, int wc, int fr, int fq) const {
        const int pn = u.pn;
        const bool need_rot = (pn >= 2 && pn <= 4) && (wc & 1) == 0;
#pragma unroll
        for (int ai = 0; ai < 2; ++ai) {
            f32x4 rcs[4], rsn[4];
#pragma unroll
            for (int m = 0; m < 4; ++m) { rcs[m] = (f32x4){1.f, 1.f, 1.f, 1.f}; rsn[m] = (f32x4){0.f, 0.f, 0.f, 0.f};
                if (need_rot) { const float* rp = rope + (unsigned)(pos_of(u.pm * 256 + ai * 128 + wr * 64 + m * 16 + fr) * 16 + 4 * (fq & 1)); rcs[m] = *(const f32x4*)rp; rsn[m] = *(const f32x4*)(rp + 8); } }
#pragma unroll
            for (int m = 0; m < 4; ++m) {
                const int row = u.pm * 256 + ai * 128 + wr * 64 + m * 16 + fr;
                const int pos = pos_of(row);
                if (pn < 2) {
#pragma unroll
                    for (int bj = 0; bj < 2; ++bj)
#pragma unroll
                        for (int n = 0; n < 2; ++n) st_bf4(U + (unsigned)(row * 512 + pn * 256 + bj * 128 + wc * 32 + n * 16 + 4 * fq), acc[ai][bj][m][n]);
                } else if (pn < 4) {
#pragma unroll
                    for (int bj = 0; bj < 2; ++bj)
#pragma unroll
                        for (int n = 0; n < 2; ++n) {
                            f32x4 v = acc[ai][bj][m][n] * 0.125f;
                            if (n == 0 && (wc & 1) == 0) v = rot(v, rcs[m], rsn[m], fq);
                            st_bf4(Q + (unsigned)(row * 512 + (pn - 2) * 256 + bj * 128 + wc * 32 + n * 16 + 4 * fq), v);
                        }
                } else if (pn == 4) {
#pragma unroll
                    for (int bj = 0; bj < 2; ++bj)
#pragma unroll
                        for (int n = 0; n < 2; ++n) {
                            f32x4 v = acc[ai][bj][m][n];
                            const int c = wc * 32 + n * 16 + 4 * fq;
                            if (bj == 0 && n == 0 && (wc & 1) == 0) v = rot(v, rcs[m], rsn[m], fq);
                            st_bf4((bj == 0 ? Kb : Vb) + (unsigned)(row * 128 + c), v);
                            if (row >= TP) *(f32x4*)(out + (bj == 0 ? O_KS : O_VS) + (unsigned)((layer * 256 + (row - TP)) * 128 + c)) = v;
                            else if (pos >= SEQ - 128) *(f32x4*)(out + (bj == 0 ? O_KP : O_VP) + (unsigned)(((layer * 2 + (row >> 14)) * 128 + (pos - (SEQ - 128))) * 128 + c)) = v;
                        }
                } else {
#pragma unroll
                    for (int bj = 0; bj < 2; ++bj)
#pragma unroll
                        for (int n = 0; n < 2; ++n) {
                            const f32x4 a = acc[ai][bj][m][n]; f32x4 v;
#pragma unroll
                            for (int e = 0; e < 4; ++e) v[e] = sigm(a[e]);
                            st_bf4(G + (unsigned)(row * 2048 + (pn - 5) * 256 + bj * 128 + wc * 32 + n * 16 + 4 * fq), v);
                        }
                }
            }
        }
    }
};
struct EpiAttnO {
    static constexpr bool PERM = false, AFTER_DRAIN = false;
    const bf16* G; bf16* P;
    __device__ __forceinline__ void quad(int row, int cb, int fq, f32x4 v0, f32x4 v1) const {
        const int col = cb + 4 * fq;
        st_bf4(P + (unsigned)(row * 1024 + col), ld_bf4(G + (unsigned)(row * 2048 + 1024 + col)) * v0);
        st_bf4(P + (unsigned)(row * 1024 + col + 16), ld_bf4(G + (unsigned)(row * 2048 + 1024 + col + 16)) * v1);
    }
    __device__ __forceinline__ void operator()(const f32x4 (&acc)[2][2][4][2], const Unit& u, int wr, int wc, int fr, int fq) const {
#pragma unroll
        for (int ai = 0; ai < 2; ++ai) {
            u32x2 gq[4][2][2];
#pragma unroll
            for (int m = 0; m < 4; ++m)
#pragma unroll
                for (int bj = 0; bj < 2; ++bj)
#pragma unroll
                    for (int n = 0; n < 2; ++n) gq[m][bj][n] = *(const u32x2*)(G + (unsigned)((u.pm * 256 + ai * 128 + wr * 64 + m * 16 + fr) * 2048 + 1024 + u.pn * 256 + bj * 128 + wc * 32 + 16 * n + 4 * fq));
#pragma unroll
            for (int m = 0; m < 4; ++m)
#pragma unroll
                for (int bj = 0; bj < 2; ++bj)
#pragma unroll
                    for (int n = 0; n < 2; ++n) { const u32x2 q = gq[m][bj][n];
                        const f32x4 gb = (f32x4){__uint_as_float(q.x << 16), __uint_as_float(q.x & 0xffff0000u), __uint_as_float(q.y << 16), __uint_as_float(q.y & 0xffff0000u)};
                        st_bf4(P + (unsigned)((u.pm * 256 + ai * 128 + wr * 64 + m * 16 + fr) * 1024 + u.pn * 256 + bj * 128 + wc * 32 + 16 * n + 4 * fq), gb * acc[ai][bj][m][n]); }
        }
    }
};
struct EpiGlu {
    static constexpr bool PERM = false, AFTER_DRAIN = false;
    const bf16* G; bf16* P;
    __device__ __forceinline__ void quad(int row, int cb, int fq, f32x4 a, f32x4 b) const {
        const int j = (cb >> 1) + 4 * fq;
        const f32x4 ga = ld_bf4(G + (unsigned)(row * 2048 + j)), pb = ld_bf4(P + (unsigned)(row * 1024 + j));
        f32x4 v;
#pragma unroll
        for (int e = 0; e < 4; ++e) v[e] = ga[e] * a[e] * sigm(b[e]) + pb[e];
        st_bf4(P + (unsigned)(row * 1024 + j), v);
    }
    __device__ __forceinline__ void operator()(const f32x4 (&acc)[2][2][4][2], const Unit& u, int wr, int wc, int fr, int fq) const {
#pragma unroll
        for (int ai = 0; ai < 2; ++ai) {
            u32x2 gq[4][2], pq[4][2];
#pragma unroll
            for (int m = 0; m < 4; ++m)
#pragma unroll
                for (int bj = 0; bj < 2; ++bj) { const int row = u.pm * 256 + ai * 128 + wr * 64 + m * 16 + fr, j = ((u.pn * 256 + bj * 128 + wc * 32) >> 1) + 4 * fq;
                    gq[m][bj] = *(const u32x2*)(G + (unsigned)(row * 2048 + j)); pq[m][bj] = *(const u32x2*)(P + (unsigned)(row * 1024 + j)); }
#pragma unroll
            for (int m = 0; m < 4; ++m)
#pragma unroll
                for (int bj = 0; bj < 2; ++bj) { const int row = u.pm * 256 + ai * 128 + wr * 64 + m * 16 + fr, j = ((u.pn * 256 + bj * 128 + wc * 32) >> 1) + 4 * fq;
                    const u32x2 q = gq[m][bj], r = pq[m][bj];
                    const f32x4 ga = (f32x4){__uint_as_float(q.x << 16), __uint_as_float(q.x & 0xffff0000u), __uint_as_float(q.y << 16), __uint_as_float(q.y & 0xffff0000u)};
                    const f32x4 pb = (f32x4){__uint_as_float(r.x << 16), __uint_as_float(r.x & 0xffff0000u), __uint_as_float(r.y << 16), __uint_as_float(r.y & 0xffff0000u)};
                    const f32x4 a = acc[ai][bj][m][0], bb = acc[ai][bj][m][1]; f32x4 v;
#pragma unroll
                    for (int e2 = 0; e2 < 4; ++e2) v[e2] = ga[e2] * a[e2] * sigm(bb[e2]) + pb[e2];
                    st_bf4(P + (unsigned)(row * 1024 + j), v); }
        }
    }
};
struct EpiRes {
    static constexpr bool PERM = false, AFTER_DRAIN = false;
    const float* xb; float* X; const float* gvec;
    __device__ __forceinline__ void quad(int row, int cb, int fq, f32x4 v0, f32x4 v1) const {
        const unsigned go = (unsigned)(modrow_of(row) * NADA), o = (unsigned)(row * D + cb + 4 * fq);
        *(f32x4*)(X + o) = *(const f32x4*)(xb + o) + *(const f32x4*)(gvec + (go + cb + 4 * fq)) * v0;
        *(f32x4*)(X + o + 16) = *(const f32x4*)(xb + o + 16) + *(const f32x4*)(gvec + (go + cb + 4 * fq + 16)) * v1;
    }
    __device__ __forceinline__ void operator()(const f32x4 (&acc)[2][2][4][2], const Unit& u, int wr, int wc, int fr, int fq) const {
        const unsigned go = (unsigned)(modrow_of(u.pm * 256) * NADA);
        f32x4 gv[2][2];
#pragma unroll
        for (int bj = 0; bj < 2; ++bj)
#pragma unroll
            for (int n = 0; n < 2; ++n) gv[bj][n] = *(const f32x4*)(gvec + (go + u.pn * 256 + bj * 128 + wc * 32 + 16 * n + 4 * fq));
#pragma unroll
        for (int ai = 0; ai < 2; ++ai) {
            f32x4 xr[4][2][2];
#pragma unroll
            for (int m = 0; m < 4; ++m)
#pragma unroll
                for (int bj = 0; bj < 2; ++bj)
#pragma unroll
                    for (int n = 0; n < 2; ++n) xr[m][bj][n] = *(const f32x4*)(xb + (unsigned)((u.pm * 256 + ai * 128 + wr * 64 + m * 16 + fr) * D + u.pn * 256 + bj * 128 + wc * 32 + 16 * n + 4 * fq));
#pragma unroll
            for (int m = 0; m < 4; ++m)
#pragma unroll
                for (int bj = 0; bj < 2; ++bj)
#pragma unroll
                    for (int n = 0; n < 2; ++n) *(f32x4*)(X + (unsigned)((u.pm * 256 + ai * 128 + wr * 64 + m * 16 + fr) * D + u.pn * 256 + bj * 128 + wc * 32 + 16 * n + 4 * fq)) = xr[m][bj][n] + gv[bj][n] * acc[ai][bj][m][n];
        }
    }
};
template <int SPLIT, class Epi> __device__ __forceinline__ void small_gemm(const bf16* A, const bf16* Wt, int N, int K, int row0, const Epi& E, LAS unsigned char* lds, int bid, int tid) {
    asm volatile("" : "+v"(tid));
    const int lane = tid & 63, wave = tid >> 6, fr = lane & 15, fq = lane >> 4;
    const int nct = N >> 5, ntile = 16 * nct, tpw = 8 / SPLIT, kp = wave % SPLIT, tl = wave / SPLIT, kb = (K / SPLIT) * kp, ke = kb + K / SPLIT;
    LAS f32x4* red = (LAS f32x4*)lds;
    for (int t0 = bid * tpw; t0 < ntile; t0 += NWG * tpw) {
        const int tile = t0 + tl, rt = tile / nct, ct = tile - rt * nct;
        const bf16* ap = A + (unsigned)((16 * rt + fr) * K + 8 * fq);
        const bf16* bp0 = Wt + (unsigned)((32 * ct + fr) * K + 8 * fq);
        const bf16* bp1 = bp0 + (unsigned)(16 * K);
        f32x4 c0 = (f32x4){0.f, 0.f, 0.f, 0.f}, c1 = (f32x4){0.f, 0.f, 0.f, 0.f};
        for (int k0 = kb; k0 < ke; k0 += 256) {
            const int nst = (ke - k0) >> 5;
            bf16x8 a[8], b0[8], b1[8];
#pragma unroll
            for (int s = 0; s < 8; ++s) if (s < nst) { a[s] = *(const bf16x8*)(ap + k0 + 32 * s); b0[s] = *(const bf16x8*)(bp0 + k0 + 32 * s); b1[s] = *(const bf16x8*)(bp1 + k0 + 32 * s); }
#pragma unroll
            for (int s = 0; s < 8; ++s) if (s < nst) { c0 = __builtin_amdgcn_mfma_f32_16x16x32_bf16(b0[s], a[s], c0, 0, 0, 0); c1 = __builtin_amdgcn_mfma_f32_16x16x32_bf16(b1[s], a[s], c1, 0, 0, 0); }
        }
        if (SPLIT > 1) {
            __builtin_amdgcn_sched_barrier(0); asm volatile("s_nop 15\n\ts_nop 15" ::: "memory"); __builtin_amdgcn_sched_barrier(0);
            red[(wave * 2 + 0) * 64 + lane] = c0; red[(wave * 2 + 1) * 64 + lane] = c1;
            __syncthreads();
            if (kp == 0) {
#pragma unroll
                for (int j = 1; j < SPLIT; ++j) { c0 += red[((wave + j) * 2 + 0) * 64 + lane]; c1 += red[((wave + j) * 2 + 1) * 64 + lane]; }
            }
        }
        if (kp == 0) E.quad(row0 + 16 * rt + fr, 32 * ct, fq, c0, c1);
        if (SPLIT > 1) __syncthreads();
    }
}
template <bool SAMPLE> struct EpiUp {
    static constexpr bool PERM = false, AFTER_DRAIN = false;
    bf16* ACT; const float* cw; const float* cb; const float* sconv; float* out; int layer;
    __device__ __forceinline__ void operator()(const f32x4 (&acc)[2][2][4][2], const Unit& u, int wr, int wc, int fr, int fq) const {
        const f32x4 z = (f32x4){0.f, 0.f, 0.f, 0.f};
#pragma unroll
        for (int bj = 0; bj < 2; ++bj) {
            const int jf = 16 * (8 * u.pn + 4 * bj + wc) + 4 * fq;
            typedef const __attribute__((address_space(4))) f32x4* cptr4;
            const f32x4 wv0 = *(cptr4)(cw + jf), wv1 = *(cptr4)(cw + FF2 + jf), wv2 = *(cptr4)(cw + 2 * FF2 + jf), bv = *(cptr4)(cb + jf);
            const f32x4 wg0 = *(cptr4)(cw + FF + jf), wg1 = *(cptr4)(cw + FF2 + FF + jf), wg2 = *(cptr4)(cw + 2 * FF2 + FF + jf), bg = *(cptr4)(cb + FF + jf);
#pragma unroll
            for (int ai = 0; ai < 2; ++ai)
#pragma unroll
                for (int m = 0; m < 4; ++m) {
                    const f32x4 cv = acc[ai][bj][m][0], cg = acc[ai][bj][m][1];
                    const f32x4 pv = m > 0 ? acc[ai][bj][m > 0 ? m - 1 : 0][0] : z, pg = m > 0 ? acc[ai][bj][m > 0 ? m - 1 : 0][1] : z;
                    f32x4 val = bv + wv2 * cv, gat = bg + wg2 * cg;
                    bool valid; unsigned aoff;
                    if (SAMPLE) {
                        const int s = 8 * ai + 4 * wr + m, t = fr;
                        f32x4 p1v = row_prev1(cv, z), p2v = row_prev2(cv, z), p1g = row_prev1(cg, z), p2g = row_prev2(cg, z);
                        if (t < 2) {
                            const float* st = sconv + (unsigned)(s * 2 * FF2 + jf);
                            const f32x4 s1v = *(const f32x4*)(st + FF2), s1g = *(const f32x4*)(st + FF2 + FF);
                            if (t == 0) { p1v = s1v; p1g = s1g; p2v = *(const f32x4*)st; p2g = *(const f32x4*)(st + FF); }
                            else { p2v = s1v; p2g = s1g; }
                        }
                        val += wv0 * p2v + wv1 * p1v; gat += wg0 * p2g + wg1 * p1g;
                        valid = true; aoff = (unsigned)(TP + 16 * s + t) * FF + jf;
                        if (t >= 14) { float* o = out + O_CS + (unsigned)(((layer * 16 + s) * 2 + (t - 14)) * FF2 + jf); *(f32x4*)o = cv; *(f32x4*)(o + FF) = cg; }
                    } else {
                        { f32x2 v01 = conv_pair<0>(bv, wv0, wv1, wv2, cv, pv), v23 = conv_pair<2>(bv, wv0, wv1, wv2, cv, pv);
                          asm volatile("" : "+v"(v01), "+v"(v23));
                          const f32x2 g01 = conv_pair<0>(bg, wg0, wg1, wg2, cg, pg), g23 = conv_pair<2>(bg, wg0, wg1, wg2, cg, pg);
                          val = (f32x4){v01.x, v01.y, v23.x, v23.y}; gat = (f32x4){g01.x, g01.y, g23.x, g23.y}; }
                        const int j = 16 * m + fr, hs = 248 * u.pm + 62 * (2 * ai + wr) + j;
                        const int b = hs >= HSEQ ? 1 : 0, pos = hs - b * HSEQ - 2;
                        valid = (j >= 2) && (pos >= 0) && (hs < 2 * HSEQ);
                        aoff = (unsigned)(b * SEQ + pos) * FF + jf;
                        if (valid && pos >= SEQ - 2) { float* o = out + O_CP + (unsigned)(((layer * 2 + b) * 2 + (pos - (SEQ - 2))) * FF2 + jf); *(f32x4*)o = cv; *(f32x4*)(o + FF) = cg; }
                    }
                    if (valid) {
                        f32x4 a;
#pragma unroll
                        for (int e = 0; e < 4; ++e) a[e] = gat[e] * sigm(gat[e]) * val[e];
                        st_bf4(ACT + aoff, a);
                    }
                    SCHB;
                }
        }
    }
};

__device__ __forceinline__ int dstrow(int mode, int half, int n) { if (mode == 0) return n; const int j = n < half ? n : n - half; return 32 * (j >> 4) + (j & 15) + (n < half ? 0 : 16); }
__device__ __forceinline__ void transpose_item(const float* W, int K, int N, bf16* WT, int mode, int half, LAS float* scr, int item, int lane) {
    const int nblk = N / 32, kb = item / nblk, nb = item % nblk, k0 = 64 * kb, n0 = 32 * nb;
#pragma unroll 8
    for (int i = 0; i < 32; ++i) { const int kk = 2 * i + (lane >> 5); scr[kk * 33 + (lane & 31)] = W[(size_t)(k0 + kk) * N + n0 + (lane & 31)]; }
    asm volatile("s_waitcnt lgkmcnt(0)" ::: "memory");
    const int c = lane & 7;
#pragma unroll
    for (int j = 0; j < 4; ++j) { const int n = (lane >> 3) + 8 * j; const LAS float* s = scr + (8 * c) * 33 + n;
        u32x4 o; o.x = cvt_pk_bf16(s[0 * 33], s[1 * 33]); o.y = cvt_pk_bf16(s[2 * 33], s[3 * 33]); o.z = cvt_pk_bf16(s[4 * 33], s[5 * 33]); o.w = cvt_pk_bf16(s[6 * 33], s[7 * 33]);
        *(u32x4*)(WT + (size_t)dstrow(mode, half, n0 + n) * K + k0 + 8 * c) = o; }
    asm volatile("s_waitcnt lgkmcnt(0)" ::: "memory");
}
__device__ __forceinline__ void dsincos(double x, double& s, double& c) {
    const double k = rint(x * 0.15915494309189535);
    const double r = (x - k * 6.283185307179586) - k * 2.4492935982947064e-16;
    const double r2 = r * r;
    double ts = 1.0, tc = 1.0, ss = 1.0, cc = 1.0;
#pragma unroll
    for (int i = 1; i <= 13; ++i) { tc = -tc * r2 / (double)((2 * i - 1) * (2 * i)); cc += tc; ts = -ts * r2 / (double)((2 * i) * (2 * i + 1)); ss += ts; }
    s = ss * r; c = cc;
}
__device__ __forceinline__ void p0_prologue(const Params& p, LAS unsigned char* lds, int bid, int tid) {
    asm volatile("" : "+v"(tid));
    const int lane = tid & 63, wave = tid >> 6;
    float* mod = (float*)(p.ws + WS_MOD);
    if (bid < 192) {
        LAS float* sc = (LAS float*)lds;
        LAS float* part = (LAS float*)(lds + 81920);
        for (int idx = tid; idx < 18 * 1024; idx += NTHR) { const int bb = idx >> 10, d = idx & 1023;
            const float c = bb < 2 ? p.in[I_CP][bb * 1024 + d] : p.in[I_CS][(bb - 2) * 1024 + d]; sc[d * 20 + bb] = c / (1.0f + __expf(-c)); }
        __syncthreads();
        const int l = bid / 48, e0 = (bid % 48) * 128, col = tid & 127, dq = tid >> 7;
        float a[18];
#pragma unroll
        for (int i = 0; i < 18; ++i) a[i] = 0.f;
        const float* wp = p.in[I_ADAW] + ((size_t)l * 1024 + dq * 256) * NADA + e0 + col;
#pragma unroll 8
        for (int d = 0; d < 256; ++d) {
            const float w = wp[(size_t)d * NADA];
            const LAS f32x4* s4 = (const LAS f32x4*)(sc + (dq * 256 + d) * 20);
            const f32x4 s0 = s4[0], s1 = s4[1], s2 = s4[2], s3 = s4[3], s5 = s4[4];
            a[0] += w * s0.x; a[1] += w * s0.y; a[2] += w * s0.z; a[3] += w * s0.w; a[4] += w * s1.x; a[5] += w * s1.y; a[6] += w * s1.z; a[7] += w * s1.w;
            a[8] += w * s2.x; a[9] += w * s2.y; a[10] += w * s2.z; a[11] += w * s2.w; a[12] += w * s3.x; a[13] += w * s3.y; a[14] += w * s3.z; a[15] += w * s3.w;
            a[16] += w * s5.x; a[17] += w * s5.y;
        }
#pragma unroll
        for (int i = 0; i < 18; ++i) part[(dq * 128 + col) * 18 + i] = a[i];
        __syncthreads();
        for (int idx = tid; idx < 128 * 18; idx += NTHR) { const int c2 = idx & 127, bb = idx >> 7;
            const float v = part[(0 * 128 + c2) * 18 + bb] + part[(1 * 128 + c2) * 18 + bb] + part[(2 * 128 + c2) * 18 + bb] + part[(3 * 128 + c2) * 18 + bb] + p.in[I_ADAB][l * NADA + e0 + c2];
            mod[((size_t)l * 18 + bb) * NADA + e0 + c2] = v; }
        __syncthreads();
    }
    {
        float* rope = (float*)(p.ws + WS_ROPE);
        for (int idx = bid * NTHR + tid; idx < SEQ * 8; idx += NWG * NTHR) { const int pos = idx >> 3, i = idx & 7;
            const double f = i == 0 ? 1.0 : i == 1 ? 0.19392274474868576 : i == 2 ? 0.03760603093086393 : i == 3 ? 0.007292664737217109 : i == 4 ? 0.001414213562373095 : i == 5 ? 0.0002742481756762073 : i == 6 ? 5.318295896944988e-05 : 1.031338537721246e-05;
            double s, c; dsincos((double)pos * f, s, c); rope[pos * 16 + i] = (float)c; rope[pos * 16 + 8 + i] = (float)s; }
    }
    {
        LAS float* scr = (LAS float*)(lds + wave * 8704);
        constexpr int I_1 = 16 * 104, I_2 = 8 * 64, I_3 = 8 * 32, I_4 = 16 * 32, I_5 = 16 * 176, I_6 = 44 * 32, I_L = I_1 + I_2 + I_3 + I_4 + I_5 + I_6;
        const int gw = bid * 8 + wave;
        for (int it = gw; it < DEPTH * I_L; it += NWG * 8) {
            const int l = it / I_L; int r = it % I_L; unsigned char* wl = p.ws + WS_W + (size_t)l * W_L;
            if (r < I_1) { transpose_item(p.in[I_WIN] + (size_t)l * D * INC, D, INC, (bf16*)(wl + W_IN), 0, 0, scr, r, lane); continue; } r -= I_1;
            if (r < I_2) { transpose_item(p.in[I_WGLU] + (size_t)l * 512 * 2048, 512, 2048, (bf16*)(wl + W_GLU), 1, 1024, scr, r, lane); continue; } r -= I_2;
            if (r < I_3) { transpose_item(p.in[I_WO] + (size_t)l * 512 * 1024, 512, 1024, (bf16*)(wl + W_O), 0, 0, scr, r, lane); continue; } r -= I_3;
            if (r < I_4) { transpose_item(p.in[I_WOUT] + (size_t)l * D * D, D, D, (bf16*)(wl + W_OUT), 0, 0, scr, r, lane); continue; } r -= I_4;
            if (r < I_5) { transpose_item(p.in[I_WUP] + (size_t)l * D * FF2, D, FF2, (bf16*)(wl + W_UP), 1, FF, scr, r, lane); continue; } r -= I_5;
            transpose_item(p.in[I_WDN] + (size_t)l * FF * D, FF, D, (bf16*)(wl + W_DN), 0, 0, scr, r, lane);
        }
    }
}

__device__ __forceinline__ void norm_phase(const Params& p, int layer, int mode, int bid, int tid) {
    asm volatile("" : "+v"(tid));
    const int lane = tid & 63, wave = tid >> 6, gw = bid * 8 + wave;
    float* X = p.out; bf16* H = (bf16*)(p.ws + WS_H);
    const float* mod = (const float*)(p.ws + WS_MOD) + (size_t)layer * 18 * NADA;
    const float* gsrc = mode == 0 ? p.in[I_N1G] + layer * D : mode == 1 ? p.in[I_N2G] + layer * D : p.in[I_FG];
    f32x4 g[4];
#pragma unroll
    for (int j = 0; j < 4; ++j) g[j] = *(const f32x4*)(gsrc + 4 * lane + 256 * j);
    if (mode == 1 && gw < 4) { const int hs = (gw & 1) + (gw >> 1) * HSEQ; unsigned* o = (unsigned*)(H + (size_t)hs * D); unsigned zz = 0u; asm volatile("" : "+v"(zz));
#pragma unroll
        for (int j = 0; j < 8; ++j) o[lane + 64 * j] = zz; }
    for (int row = gw; row < MT; row += NWG * 8) {
        const float* xr = (mode == 0 && layer == 0) ? (row < TP ? p.in[I_XP] + (size_t)row * D : p.in[I_XS] + (size_t)(row - TP) * D) : X + (size_t)row * D;
        f32x4 v[4]; float s = 0.f;
#pragma unroll
        for (int j = 0; j < 4; ++j) { v[j] = *(const f32x4*)(xr + 4 * lane + 256 * j); s += (v[j].x * v[j].x + v[j].y * v[j].y) + (v[j].z * v[j].z + v[j].w * v[j].w); }
        const float rstd = 1.0f / sqrtf(wave_sum(s) * (1.0f / D) + 1e-6f);
        if (mode == 2) {
#pragma unroll
            for (int j = 0; j < 4; ++j) *(f32x4*)(X + (size_t)row * D + 4 * lane + 256 * j) = v[j] * rstd * g[j];
        } else {
            const float* mr = mod + (size_t)modrow_of(row) * NADA + (mode == 0 ? 0 : 3072);
            size_t hrow = row;
            if (mode == 1) hrow = row < TP ? (size_t)(row >> 14) * HSEQ + 2 + (row & (SEQ - 1)) : (size_t)HS_SAMPLE + (row - TP);
#pragma unroll
            for (int j = 0; j < 4; ++j) { const f32x4 sh = *(const f32x4*)(mr + 4 * lane + 256 * j), sc = *(const f32x4*)(mr + 1024 + 4 * lane + 256 * j);
                st_bf4(H + hrow * D + 4 * lane + 256 * j, (v[j] * rstd * g[j]) * (sc + 1.0f) + sh); }
        }
    }
}

struct SsmPar { float abr, abi; float bbr[16], bbi[16]; };
__device__ __forceinline__ void ssm_disc(const Params& p, int layer, int g, int lane, float& abr, float& abi, float& fr, float& fi) {
    const int gi = (layer * 32 + g) * 64 + lane;
    const float are = p.in[I_ARE][gi], aim = p.in[I_AIM][gi], dt = expf(p.in[I_LDT][layer * 32 + g]);
    const float mag = expf(are * dt); float sn, cs; sincosf(aim * dt, &sn, &cs);
    abr = mag * cs; abi = mag * sn;
    const float nr = abr - 1.0f, ni = abi, den = are * are + aim * aim;
    fr = (nr * are + ni * aim) / den; fi = (ni * are - nr * aim) / den;
}
__device__ __forceinline__ void ssm_task(const Params& p, int layer, int mode, int sq, int g, int chunk, int lane, LAS unsigned char* wl) {
    LAS float* ul = (LAS float*)wl;
    LAS bf16* Sl = (LAS bf16*)(wl + 4096);
    float abr, abi, fr, fi; ssm_disc(p, layer, g, lane, abr, abi, fr, fi);
    typedef float f32x2 __attribute__((ext_vector_type(2)));
    f32x2 bb[16];
    { const size_t bo = (((size_t)layer * 32 + g) * 64 + lane) * 16;
#pragma unroll
      for (int c4 = 0; c4 < 4; ++c4) { const f32x4 br = *(const f32x4*)(p.in[I_BRE] + bo + 4 * c4), bi = *(const f32x4*)(p.in[I_BIM] + bo + 4 * c4);
#pragma unroll
          for (int e = 0; e < 4; ++e) { bb[4 * c4 + e].x = fr * br[e] - fi * bi[e]; bb[4 * c4 + e].y = fr * bi[e] + fi * br[e]; } } }
    const bool cproj = mode != 0;
    const int g4 = lane >> 4, cl = lane & 15;
    bf16x8 cf[4];
    float dsk = 0.f;
    if (cproj) {
        const size_t co = (((size_t)layer * 32 + g) * 16 + cl) * 64;
#pragma unroll
        for (int ks = 0; ks < 4; ++ks) { const float* src = (ks < 2 ? p.in[I_CRE] : p.in[I_CIM]) + co + 32 * (ks & 1) + 8 * g4; const float sg = ks < 2 ? 1.0f : -1.0f;
            const f32x4 a = *(const f32x4*)src, b = *(const f32x4*)(src + 4);
            u32x4 o; o.x = cvt_pk_bf16(sg * a.x, sg * a.y); o.y = cvt_pk_bf16(sg * a.z, sg * a.w); o.z = cvt_pk_bf16(sg * b.x, sg * b.y); o.w = cvt_pk_bf16(sg * b.z, sg * b.w);
            cf[ks] = __builtin_bit_cast(bf16x8, o); }
        dsk = p.in[I_SD][layer * 512 + g * 16 + cl];
    }
    const int nsteps = mode == 1 ? 16 : 64;
    const size_t r0 = mode == 1 ? (size_t)TP + sq * 16 : (size_t)sq * SEQ + chunk * 64;
    const float* U = (const float*)(p.ws + WS_U);
#pragma unroll
    for (int i = 0; i < 4; ++i) { const int idx = lane + 64 * i; if (idx < nsteps * 4) { const int t = idx >> 2, c4 = idx & 3; *(LAS f32x4*)(ul + t * 16 + 4 * c4) = *(const f32x4*)(U + (r0 + t) * 512 + g * 16 + 4 * c4); } }
    float sr = 0.f, si = 0.f;
    float* CH = (float*)(p.ws + WS_CH);
    const size_t cho = (((size_t)(sq * 32 + g)) * 256 + chunk) * 128;
    if (mode == 1) { const size_t so = (((size_t)layer * 16 + sq) * 32 + g) * 64 + lane; sr = p.in[I_SRE][so]; si = p.in[I_SIM][so]; }
    else if (mode == 2) { sr = CH[cho + lane]; si = CH[cho + 64 + lane]; }
    asm volatile("s_waitcnt vmcnt(0) lgkmcnt(0)" ::: "memory"); __builtin_amdgcn_wave_barrier();
    bf16* Yg = (bf16*)(p.ws + WS_YG);
    for (int hh = 0; hh * 32 < nsteps; ++hh) {
        const int ns = nsteps - hh * 32 < 32 ? nsteps - hh * 32 : 32;
#pragma unroll 4
        for (int t = 0; t < ns; ++t) {
            const LAS f32x4* up = (const LAS f32x4*)(ul + (hh * 32 + t) * 16);
            const f32x4 u0 = up[0], u1 = up[1], u2 = up[2], u3 = up[3];
            f32x2 xa = (f32x2){0.f, 0.f}, xb = (f32x2){0.f, 0.f};
#pragma unroll
            for (int e = 0; e < 4; ++e) { xa = bb[e] * (f32x2){u0[e], u0[e]} + xa; xb = bb[4 + e] * (f32x2){u1[e], u1[e]} + xb; }
#pragma unroll
            for (int e = 0; e < 4; ++e) { xa = bb[8 + e] * (f32x2){u2[e], u2[e]} + xa; xb = bb[12 + e] * (f32x2){u3[e], u3[e]} + xb; }
            const float xr = xa.x + xb.x, xi = xa.y + xb.y;
            const float nsr = fmaf(abr, sr, fmaf(-abi, si, xr)), nsi = fmaf(abr, si, fmaf(abi, sr, xi));
            sr = nsr; si = nsi;
            if (cproj) { Sl[t * 136 + lane] = (bf16)f2bf(sr); Sl[t * 136 + 64 + lane] = (bf16)f2bf(si); }
        }
        if (cproj) {
            asm volatile("s_waitcnt lgkmcnt(0)" ::: "memory"); __builtin_amdgcn_wave_barrier();
#pragma unroll
            for (int mt = 0; mt < 2; ++mt) {
                f32x4 ya = (f32x4){0.f, 0.f, 0.f, 0.f};
#pragma unroll
                for (int ks = 0; ks < 4; ++ks) { const bf16x8 a = *(const LAS bf16x8*)(Sl + (16 * mt + cl) * 136 + 32 * ks + 8 * g4); ya = __builtin_amdgcn_mfma_f32_16x16x32_bf16(a, cf[ks], ya, 0, 0, 0); }
#pragma unroll
                for (int i = 0; i < 4; ++i) { const int t = 16 * mt + 4 * g4 + i;
                    if (t < ns) { const float y = ya[i] + dsk * ul[(hh * 32 + t) * 16 + cl]; Yg[(r0 + hh * 32 + t) * 512 + g * 16 + cl] = (bf16)f2bf(gelu_tanh(y)); } }
            }
            asm volatile("s_waitcnt lgkmcnt(0)" ::: "memory"); __builtin_amdgcn_wave_barrier();
        }
    }
    if (mode == 0) { CH[cho + lane] = sr; CH[cho + 64 + lane] = si; }
    else if (mode == 1) { const size_t so = (((size_t)layer * 16 + sq) * 32 + g) * 64 + lane; p.out[O_SRS + so] = sr; p.out[O_SIS + so] = si; }
    else if (chunk == 255) { const size_t so = (((size_t)layer * 2 + sq) * 32 + g) * 64 + lane; p.out[O_SRP + so] = sr; p.out[O_SIP + so] = si; }
    asm volatile("s_waitcnt lgkmcnt(0)" ::: "memory"); __builtin_amdgcn_wave_barrier();
}
__device__ __forceinline__ void split_hl(f32x4 a, f32x4 c, u32x4& hi, u32x4& lo) {
    hi.x = cvt_pk_bf16(a.x, a.y); hi.y = cvt_pk_bf16(a.z, a.w); hi.z = cvt_pk_bf16(c.x, c.y); hi.w = cvt_pk_bf16(c.z, c.w);
    lo.x = cvt_pk_bf16(a.x - __uint_as_float(hi.x << 16), a.y - __uint_as_float(hi.x & 0xffff0000u)); lo.y = cvt_pk_bf16(a.z - __uint_as_float(hi.y << 16), a.w - __uint_as_float(hi.y & 0xffff0000u));
    lo.z = cvt_pk_bf16(c.x - __uint_as_float(hi.z << 16), c.y - __uint_as_float(hi.z & 0xffff0000u)); lo.w = cvt_pk_bf16(c.z - __uint_as_float(hi.w << 16), c.w - __uint_as_float(hi.w & 0xffff0000u));
}
__device__ __forceinline__ void ssm_task_v2(const Params& p, int layer, int mode, int sq, int g, int chunk0, int nchunk, int cstride, int lane, LAS unsigned char* wl) {
    LAS float* Xl = (LAS float*)wl;
    LAS bf16* Sl = (LAS bf16*)(wl + 8448);
    const int g4 = lane >> 4, cl = lane & 15;
    float abr, abi, fr, fi; ssm_disc(p, layer, g, lane, abr, abi, fr, fi);
    bf16x8 bfr[8];
    const int gg = g4 & 1;
#pragma unroll
    for (int q = 0; q < 4; ++q) {
        const int st = 16 * q + cl;
        const float frs = __shfl(fr, st), fis = __shfl(fi, st);
        const size_t bo = (((size_t)layer * 32 + g) * 64 + st) * 16 + 8 * gg;
        const f32x4 r0 = *(const f32x4*)(p.in[I_BRE] + bo), r1 = *(const f32x4*)(p.in[I_BRE] + bo + 4), i0 = *(const f32x4*)(p.in[I_BIM] + bo), i1 = *(const f32x4*)(p.in[I_BIM] + bo + 4);
        const f32x4 a0 = frs * r0 - fis * i0, a1 = frs * r1 - fis * i1, c0 = frs * i0 + fis * r0, c1 = frs * i1 + fis * r1;
        u32x4 hre, him;
        hre.x = cvt_pk_bf16(a0.x, a0.y); hre.y = cvt_pk_bf16(a0.z, a0.w); hre.z = cvt_pk_bf16(a1.x, a1.y); hre.w = cvt_pk_bf16(a1.z, a1.w);
        him.x = cvt_pk_bf16(c0.x, c0.y); him.y = cvt_pk_bf16(c0.z, c0.w); him.z = cvt_pk_bf16(c1.x, c1.y); him.w = cvt_pk_bf16(c1.z, c1.w);
        if (g4 >= 2) { hre = (u32x4){0u, 0u, 0u, 0u}; him = hre; }
        bfr[q] = __builtin_bit_cast(bf16x8, hre); bfr[4 + q] = __builtin_bit_cast(bf16x8, him);
    }
    const bool cproj = mode != 0;
    bf16x8 cf[4];
    float dsk = 0.f;
    if (cproj) {
        const size_t co = (((size_t)layer * 32 + g) * 16 + cl) * 64;
#pragma unroll
        for (int ks = 0; ks < 4; ++ks) { const float* src = (ks < 2 ? p.in[I_CRE] : p.in[I_CIM]) + co + 32 * (ks & 1) + 8 * g4; const float sg = ks < 2 ? 1.0f : -1.0f;
            const f32x4 a = *(const f32x4*)src, c = *(const f32x4*)(src + 4);
            u32x4 o; o.x = cvt_pk_bf16(sg * a.x, sg * a.y); o.y = cvt_pk_bf16(sg * a.z, sg * a.w); o.z = cvt_pk_bf16(sg * c.x, sg * c.y); o.w = cvt_pk_bf16(sg * c.z, sg * c.w);
            cf[ks] = __builtin_bit_cast(bf16x8, o); }
        dsk = p.in[I_SD][layer * 512 + g * 16 + cl];
    }
    const int nblk = mode == 1 ? 1 : 4;
    bf16* Yg = (bf16*)(p.ws + WS_YG);
    const bf16* U = (const bf16*)(p.ws + WS_U);
    float* CH = (float*)(p.ws + WS_CH);
    float sr = 0.f, si = 0.f;
    if (mode == 1) { const size_t so = (((size_t)layer * 16 + sq) * 32 + g) * 64 + lane; sr = p.in[I_SRE][so]; si = p.in[I_SIM][so]; }
    else if (mode == 2) { const size_t cso = (((size_t)(sq * 32 + g)) * 32 + (chunk0 >> 3)) * 128; sr = CH[cso + lane]; si = CH[cso + 64 + lane]; }
    for (int ci = 0; ci < nchunk; ++ci) {
    const int chunk = chunk0 + ci * cstride;
    const unsigned r0 = mode == 1 ? (unsigned)(TP + sq * 16) : (unsigned)(sq * SEQ + chunk * 64);
    u32x4 ulq[4];
#pragma unroll
    for (int blk = 0; blk < 4; ++blk) if (blk < nblk) {
        ulq[blk] = *(const u32x4*)(U + (r0 + 16 * blk + cl) * 512u + g * 16 + 8 * gg);
    }
#pragma unroll
    for (int blk = 0; blk < 4; ++blk) if (blk < nblk) {
        u32x4 ua;
        ua = g4 < 2 ? ulq[blk] : (u32x4){0u, 0u, 0u, 0u};
        float ud[4];
        if (cproj) {
#pragma unroll
            for (int i = 0; i < 4; ++i) ud[i] = bf2f(U[(r0 + 16 * blk + 4 * g4 + i) * 512u + g * 16 + cl]);
        }
        const bf16x8 uf = __builtin_bit_cast(bf16x8, ua);
        f32x4 xs[8];
#pragma unroll
        for (int nt = 0; nt < 8; ++nt) {
            xs[nt] = __builtin_amdgcn_mfma_f32_16x16x32_bf16(uf, bfr[nt], (f32x4){0.f, 0.f, 0.f, 0.f}, 0, 0, 0);
        }
        __builtin_amdgcn_sched_barrier(0); asm volatile("s_nop 15\n\ts_nop 15" ::: "memory"); __builtin_amdgcn_sched_barrier(0);
#pragma unroll
        for (int nt = 0; nt < 8; ++nt) {
#pragma unroll
            for (int i = 0; i < 4; ++i) Xl[(4 * g4 + i) * 132 + 16 * nt + cl] = xs[nt][i];
        }
        asm volatile("s_waitcnt lgkmcnt(0)" ::: "memory"); __builtin_amdgcn_wave_barrier();
        float xrv[16], xiv[16];
#pragma unroll
        for (int t = 0; t < 16; ++t) { xrv[t] = Xl[t * 132 + lane]; xiv[t] = Xl[t * 132 + 64 + lane]; }
        asm volatile("s_waitcnt lgkmcnt(0)" ::: "memory");
#pragma unroll
        for (int t = 0; t < 16; ++t) {
            const float nsr = fmaf(abr, sr, fmaf(-abi, si, xrv[t])), nsi = fmaf(abr, si, fmaf(abi, sr, xiv[t]));
            sr = nsr; si = nsi;
            if (cproj) { const unsigned pk = cvt_pk_bf16(sr, si); Sl[t * 136 + lane] = (bf16)(pk & 0xffffu); Sl[t * 136 + 64 + lane] = (bf16)(pk >> 16); }
        }
        if (cproj) {
            asm volatile("s_waitcnt lgkmcnt(0)" ::: "memory"); __builtin_amdgcn_wave_barrier();
            f32x4 ya = (f32x4){0.f, 0.f, 0.f, 0.f};
#pragma unroll
            for (int ks = 0; ks < 4; ++ks) { const bf16x8 a = *(const LAS bf16x8*)(Sl + cl * 136 + 32 * ks + 8 * g4); ya = __builtin_amdgcn_mfma_f32_16x16x32_bf16(a, cf[ks], ya, 0, 0, 0); }
#pragma unroll
            for (int i = 0; i < 4; ++i) { const float y = ya[i] + dsk * ud[i]; Yg[(r0 + 16 * blk + 4 * g4 + i) * 512u + g * 16 + cl] = (bf16)f2bf(gelu_tanh(y)); }
        }
        asm volatile("s_waitcnt lgkmcnt(0)" ::: "memory"); __builtin_amdgcn_wave_barrier();
    }
    if (mode == 1) { const size_t so = (((size_t)layer * 16 + sq) * 32 + g) * 64 + lane; p.out[O_SRS + so] = sr; p.out[O_SIS + so] = si; }
    else if (chunk == 255) { const size_t so = (((size_t)layer * 2 + sq) * 32 + g) * 64 + lane; p.out[O_SRP + so] = sr; p.out[O_SIP + so] = si; }
    }
}
__device__ __forceinline__ void ssm_pass1_fast(const Params& p, int layer, int sq, int g, int chunk0, int nchunk, int cstride, int lane) {
    const int g4 = lane >> 4, cl = lane & 15, gg = g4 & 1;
    float abr, abi, fr, fi; ssm_disc(p, layer, g, lane, abr, abi, fr, fi);
    bf16x8 bfr[8];
    float ar[4], ai[4], Ar[4], Ai[4], wr_[4], wi_[4];
#pragma unroll
    for (int q = 0; q < 4; ++q) {
        const int st = 16 * q + cl;
        const float frs = __shfl(fr, st), fis = __shfl(fi, st);
        ar[q] = __shfl(abr, st); ai[q] = __shfl(abi, st);
        const size_t bo = (((size_t)layer * 32 + g) * 64 + st) * 16 + 8 * gg;
        const f32x4 r0 = *(const f32x4*)(p.in[I_BRE] + bo), r1 = *(const f32x4*)(p.in[I_BRE] + bo + 4), i0 = *(const f32x4*)(p.in[I_BIM] + bo), i1 = *(const f32x4*)(p.in[I_BIM] + bo + 4);
        const f32x4 a0 = frs * r0 - fis * i0, a1 = frs * r1 - fis * i1, c0 = frs * i0 + fis * r0, c1 = frs * i1 + fis * r1;
        u32x4 hre, him;
        hre.x = cvt_pk_bf16(a0.x, a0.y); hre.y = cvt_pk_bf16(a0.z, a0.w); hre.z = cvt_pk_bf16(a1.x, a1.y); hre.w = cvt_pk_bf16(a1.z, a1.w);
        him.x = cvt_pk_bf16(c0.x, c0.y); him.y = cvt_pk_bf16(c0.z, c0.w); him.z = cvt_pk_bf16(c1.x, c1.y); him.w = cvt_pk_bf16(c1.z, c1.w);
        if (g4 >= 2) { hre = (u32x4){0u, 0u, 0u, 0u}; him = hre; }
        bfr[q] = __builtin_bit_cast(bf16x8, hre); bfr[4 + q] = __builtin_bit_cast(bf16x8, him);
        const float a2r = ar[q] * ar[q] - ai[q] * ai[q], a2i = 2.0f * ar[q] * ai[q];
        const float a4r = a2r * a2r - a2i * a2i, a4i = 2.0f * a2r * a2i;
        const float a8r = a4r * a4r - a4i * a4i, a8i = 2.0f * a4r * a4i;
        Ar[q] = a8r * a8r - a8i * a8i; Ai[q] = 2.0f * a8r * a8i;
        const float a12r = a8r * a4r - a8i * a4i, a12i = a8r * a4i + a8i * a4r;
        wr_[q] = g4 == 3 ? 1.0f : g4 == 2 ? a4r : g4 == 1 ? a8r : a12r;
        wi_[q] = g4 == 3 ? 0.0f : g4 == 2 ? a4i : g4 == 1 ? a8i : a12i;
    }
    const bf16* U = (const bf16*)(p.ws + WS_U);
    float* CH = (float*)(p.ws + WS_CH);
    float accr[4] = {0.f, 0.f, 0.f, 0.f}, acci[4] = {0.f, 0.f, 0.f, 0.f};
    u32x4 unx[4];
#pragma unroll
    for (int blk = 0; blk < 4; ++blk) unx[blk] = *(const u32x4*)(U + ((unsigned)(sq * SEQ + chunk0 * 64) + 16 * blk + cl) * 512u + g * 16 + 8 * gg);
    for (int ci = 0; ci < nchunk; ++ci) {
        const int chunk = chunk0 + ci * cstride;
        u32x4 ulq[4];
#pragma unroll
        for (int blk = 0; blk < 4; ++blk) ulq[blk] = unx[blk];
        if (ci + 1 < nchunk) {
#pragma unroll
            for (int blk = 0; blk < 4; ++blk) unx[blk] = *(const u32x4*)(U + ((unsigned)(sq * SEQ + (chunk + cstride) * 64) + 16 * blk + cl) * 512u + g * 16 + 8 * gg);
        }
#pragma unroll
        for (int blk = 0; blk < 4; ++blk) {
            const bf16x8 uf = __builtin_bit_cast(bf16x8, g4 < 2 ? ulq[blk] : (u32x4){0u, 0u, 0u, 0u});
#pragma unroll
            for (int q = 0; q < 4; ++q) {
                const f32x4 xr = __builtin_amdgcn_mfma_f32_16x16x32_bf16(uf, bfr[q], (f32x4){0.f, 0.f, 0.f, 0.f}, 0, 0, 0);
                const f32x4 xi = __builtin_amdgcn_mfma_f32_16x16x32_bf16(uf, bfr[4 + q], (f32x4){0.f, 0.f, 0.f, 0.f}, 0, 0, 0);
                float er = xr[0], ei = xi[0];
#pragma unroll
                for (int i = 1; i < 4; ++i) { const float nr = fmaf(ar[q], er, fmaf(-ai[q], ei, xr[i])), ni = fmaf(ar[q], ei, fmaf(ai[q], er, xi[i])); er = nr; ei = ni; }
                const float nr = fmaf(Ar[q], accr[q], fmaf(-Ai[q], acci[q], er)), ni = fmaf(Ar[q], acci[q], fmaf(Ai[q], accr[q], ei));
                accr[q] = nr; acci[q] = ni;
            }
        }
    }
    {
        float outr = 0.f, outi = 0.f;
#pragma unroll
        for (int q = 0; q < 4; ++q) {
            float zr = wr_[q] * accr[q] - wi_[q] * acci[q], zi = wr_[q] * acci[q] + wi_[q] * accr[q];
            zr += __shfl_xor(zr, 16); zr += __shfl_xor(zr, 32); zi += __shfl_xor(zi, 16); zi += __shfl_xor(zi, 32);
            if (g4 == q) { outr = zr; outi = zi; }
        }
        const size_t cho = (((size_t)(sq * 32 + g)) * 32 + (chunk0 >> 3)) * 128;
        CH[cho + lane] = outr; CH[cho + 64 + lane] = outi;
    }
}
__device__ __forceinline__ void ssm_phase(const Params& p, int layer, int pass3, LAS unsigned char* lds, int bid, int tid) {
    asm volatile("" : "+v"(tid));
    const int lane = tid & 63, wave = tid >> 6; LAS unsigned char* wl = lds + wave * 12800;
    const int gw = bid * 8 + wave;
    { const int sqg = gw >> 5;
      if (pass3) ssm_task_v2(p, layer, 2, sqg >> 5, sqg & 31, 8 * (gw & 31), 8, 1, lane, wl);
      else ssm_pass1_fast(p, layer, sqg >> 5, sqg & 31, 8 * (gw & 31), 8, 1, lane); }
    if (!pass3 && gw >= 1536) { const int sg = gw - 1536; ssm_task_v2(p, layer, 1, sg >> 5, sg & 31, 0, 1, 1, lane, wl); }
}
__device__ __forceinline__ void carry_phase(const Params& p, int layer, int bid, int tid) {
    asm volatile("" : "+v"(tid));
    const int lane = tid & 63, wave = tid >> 6, gw = bid * 8 + wave;
    if (gw >= 64) return;
    float abr, abi, fr, fi; ssm_disc(p, layer, gw & 31, lane, abr, abi, fr, fi);
    float ar = abr, ai = abi;
#pragma unroll
    for (int i = 0; i < 9; ++i) { const float nr = ar * ar - ai * ai, ni = 2.0f * ar * ai; ar = nr; ai = ni; }
    float* CH = (float*)(p.ws + WS_CH) + (size_t)gw * 32 * 128;
    float cr = 0.f, ci = 0.f;
    float fr8[32], fi8[32];
#pragma unroll
    for (int j = 0; j < 32; ++j) { fr8[j] = CH[j * 128 + lane]; fi8[j] = CH[j * 128 + 64 + lane]; }
#pragma unroll
    for (int j = 0; j < 32; ++j) { CH[j * 128 + lane] = cr; CH[j * 128 + 64 + lane] = ci;
        const float nr = fmaf(ar, cr, fmaf(-ai, ci, fr8[j])), ni = fmaf(ar, ci, fmaf(ai, cr, fi8[j])); cr = nr; ci = ni; }
}

__device__ __forceinline__ void attn_phase(const Params& p, int layer, LAS unsigned char* lds, int bid, int tid) {
    asm volatile("" : "+v"(tid));
    const int lane = tid & 63, wave = tid >> 6, g4 = lane >> 4, cl = lane & 15;
    LAS bf16* Kl = (LAS bf16*)lds;
    LAS bf16* Vt = (LAS bf16*)(lds + 27648);
    const bf16* Qb = (const bf16*)(p.ws + WS_Q); const bf16* Kb = (const bf16*)(p.ws + WS_K); const bf16* Vb = (const bf16*)(p.ws + WS_V);
    bf16* Ob = (bf16*)(p.ws + WS_O);
    u32x4 pk[3], pv[3];
#define ATT_LOAD(TKX) do { const int tk_ = (TKX); const bool smp_ = tk_ >= 1024; \
        const int b_ = smp_ ? (tk_ - 1024) >> 1 : tk_ >> 9, n_ = smp_ ? 0 : (tk_ >> 1) & 255, kvh_ = tk_ & 1; \
        _Pragma("unroll") for (int i = 0; i < 3; ++i) { \
            const int idx = tid + NTHR * i, key = idx >> 3, c8 = idx & 7; \
            u32x4 kv = (u32x4){0u, 0u, 0u, 0u}, vv = (u32x4){0u, 0u, 0u, 0u}; \
            if (!smp_) { \
                const int pos = 64 * (n_ - 2) + key; \
                if (pos >= 0) { const size_t o = ((size_t)b_ * SEQ + pos) * 128 + kvh_ * 64 + 8 * c8; kv = *(const u32x4*)(Kb + o); vv = *(const u32x4*)(Vb + o); } \
            } else if (key < 128) { \
                const size_t o = ((((size_t)layer * 16 + b_) * 128 + key) * 2 + kvh_) * 64 + 8 * c8; \
                const f32x4 k0 = *(const f32x4*)(p.in[I_CK] + o), k1 = *(const f32x4*)(p.in[I_CK] + o + 4), v0 = *(const f32x4*)(p.in[I_CV] + o), v1 = *(const f32x4*)(p.in[I_CV] + o + 4); \
                kv.x = cvt_pk_bf16(k0.x, k0.y); kv.y = cvt_pk_bf16(k0.z, k0.w); kv.z = cvt_pk_bf16(k1.x, k1.y); kv.w = cvt_pk_bf16(k1.z, k1.w); \
                vv.x = cvt_pk_bf16(v0.x, v0.y); vv.y = cvt_pk_bf16(v0.z, v0.w); vv.z = cvt_pk_bf16(v1.x, v1.y); vv.w = cvt_pk_bf16(v1.z, v1.w); \
            } else if (key < 144) { \
                const size_t o = ((size_t)TP + b_ * 16 + (key - 128)) * 128 + kvh_ * 64 + 8 * c8; kv = *(const u32x4*)(Kb + o); vv = *(const u32x4*)(Vb + o); \
            } \
            pk[i] = kv; pv[i] = vv; } } while (0)
    ATT_LOAD(bid);
    for (int tk = bid; tk < 1024 + 32; tk += NWG) {
        const bool smp = tk >= 1024;
        const int b = smp ? (tk - 1024) >> 1 : tk >> 9, n = smp ? 0 : (tk >> 1) & 255, kvh = tk & 1;
        __syncthreads();
#pragma unroll
        for (int i = 0; i < 3; ++i) {
            const int idx = tid + NTHR * i, key = idx >> 3, c8 = idx & 7;
            const u32x4 kv = pk[i], vv = pv[i];
            *(LAS u32x4*)(Kl + key * 72 + 8 * c8) = kv;
            LAS bf16* vd = Vt + (8 * c8) * 200 + key;
            vd[0] = (bf16)(vv.x & 0xffffu); vd[200] = (bf16)(vv.x >> 16); vd[400] = (bf16)(vv.y & 0xffffu); vd[600] = (bf16)(vv.y >> 16);
            vd[800] = (bf16)(vv.z & 0xffffu); vd[1000] = (bf16)(vv.z >> 16); vd[1200] = (bf16)(vv.w & 0xffffu); vd[1400] = (bf16)(vv.w >> 16);
        }
        __syncthreads();
        if (tk + NWG < 1024 + 32) ATT_LOAD(tk + NWG);
        const int gh = wave & 3, qh = wave >> 2, h = kvh * 4 + gh;
        if (smp && qh == 1) continue;
        const int nq = smp ? 16 : 32;
        const size_t qrow0 = smp ? (size_t)TP + b * 16 : (size_t)b * SEQ + 64 * n + 32 * qh;
        bf16x8 qf[2][2];
#pragma unroll
        for (int nt = 0; nt < 2; ++nt) { int qi = 16 * nt + cl; if (qi >= nq) qi = nq - 1;
#pragma unroll
            for (int ks = 0; ks < 2; ++ks) qf[nt][ks] = *(const bf16x8*)(Qb + (qrow0 + qi) * 512 + h * 64 + 32 * ks + 8 * g4); }
        f32x4 s[12][2];
#pragma unroll
        for (int mt = 0; mt < 12; ++mt) {
            s[mt][0] = (f32x4){0.f, 0.f, 0.f, 0.f}; s[mt][1] = (f32x4){0.f, 0.f, 0.f, 0.f};
#pragma unroll
            for (int ks = 0; ks < 2; ++ks) { const bf16x8 a = *(const LAS bf16x8*)(Kl + (16 * mt + cl) * 72 + 32 * ks + 8 * g4);
                s[mt][0] = __builtin_amdgcn_mfma_f32_16x16x32_bf16(a, qf[0][ks], s[mt][0], 0, 0, 0);
                s[mt][1] = __builtin_amdgcn_mfma_f32_16x16x32_bf16(a, qf[1][ks], s[mt][1], 0, 0, 0); }
            const bool valid = smp ? (mt < 9) : (n - 2 + (mt >> 2) >= 0);
            if (!valid) { s[mt][0] = (f32x4){-1e30f, -1e30f, -1e30f, -1e30f}; s[mt][1] = s[mt][0]; }
        }
        const float sink = p.in[I_SINK][layer * 8 + h];
        float inv[2];
#pragma unroll
        for (int nt = 0; nt < 2; ++nt) {
            float mx = sink;
#pragma unroll
            for (int mt = 0; mt < 12; ++mt) mx = fmaxf(mx, fmaxf(fmaxf(s[mt][nt].x, s[mt][nt].y), fmaxf(s[mt][nt].z, s[mt][nt].w)));
            mx = fmaxf(mx, __shfl_xor(mx, 16)); mx = fmaxf(mx, __shfl_xor(mx, 32));
            float sum = 0.f;
#pragma unroll
            for (int mt = 0; mt < 12; ++mt) {
#pragma unroll
                for (int e = 0; e < 4; ++e) { const float pe = __expf(s[mt][nt][e] - mx); s[mt][nt][e] = pe; sum += pe; } }
            sum += __shfl_xor(sum, 16); sum += __shfl_xor(sum, 32);
            inv[nt] = 1.0f / (sum + __expf(sink - mx));
        }
        f32x4 o[4][2];
#pragma unroll
        for (int dt = 0; dt < 4; ++dt) { o[dt][0] = (f32x4){0.f, 0.f, 0.f, 0.f}; o[dt][1] = (f32x4){0.f, 0.f, 0.f, 0.f}; }
#pragma unroll
        for (int ks = 0; ks < 6; ++ks) {
            bf16x8 pf[2];
#pragma unroll
            for (int nt = 0; nt < 2; ++nt) { u32x4 t; t.x = cvt_pk_bf16(s[2 * ks][nt].x, s[2 * ks][nt].y); t.y = cvt_pk_bf16(s[2 * ks][nt].z, s[2 * ks][nt].w);
                t.z = cvt_pk_bf16(s[2 * ks + 1][nt].x, s[2 * ks + 1][nt].y); t.w = cvt_pk_bf16(s[2 * ks + 1][nt].z, s[2 * ks + 1][nt].w); pf[nt] = __builtin_bit_cast(bf16x8, t); }
#pragma unroll
            for (int dt = 0; dt < 4; ++dt) {
                const LAS bf16* vp = Vt + (16 * dt + cl) * 200 + 32 * ks + 4 * g4;
                const u32x2 lo = *(const LAS u32x2*)vp, hi = *(const LAS u32x2*)(vp + 16);
                const bf16x8 a = __builtin_bit_cast(bf16x8, (u32x4){lo.x, lo.y, hi.x, hi.y});
                o[dt][0] = __builtin_amdgcn_mfma_f32_16x16x32_bf16(a, pf[0], o[dt][0], 0, 0, 0);
                o[dt][1] = __builtin_amdgcn_mfma_f32_16x16x32_bf16(a, pf[1], o[dt][1], 0, 0, 0);
            }
        }
#pragma unroll
        for (int nt = 0; nt < 2; ++nt) { const int qi = 16 * nt + cl;
            if (qi < nq) {
#pragma unroll
                for (int dt = 0; dt < 4; ++dt) st_bf4(Ob + (qrow0 + qi) * 512 + h * 64 + 16 * dt + 4 * g4, o[dt][nt] * inv[nt]); } }
    }
    __syncthreads();
}

__global__ void __launch_bounds__(512, 2) fwd(Params p) {
    extern __shared__ __attribute__((aligned(16))) unsigned char lds_raw[];
    LAS unsigned char* lds = (LAS unsigned char*)lds_raw;
    cg::grid_group grid = cg::this_grid();
    const int bid = blockIdx.x, tid = threadIdx.x, G = gridDim.x;
    unsigned char* ws = p.ws;
    float* X = p.out;
    bf16* H = (bf16*)(ws + WS_H);
    const float* modall = (const float*)(ws + WS_MOD);
    if (tid < 16) ((volatile LAS unsigned*)(lds + MISC_OFF))[tid] = 0u;
    __syncthreads();
    const xb::XcdBarrier bar = xb::xcd_barrier_post((unsigned*)(ws + WS_BAR), (volatile LAS unsigned*)(lds + MISC_OFF));
#define GSYNC() xb::xcd_barrier(bar)

#if !defined(ONLY) || ONLY == 0
    REPK(10) { p0_prologue(p, lds, bid, tid); if (PROBE == 10) { asm volatile("s_waitcnt vmcnt(0) lgkmcnt(0)" ::: "memory"); __syncthreads(); } }
    if (PROBE == 7 || PROBE == 8) { float* zr = (float*)(ws + WS_ZERO); for (int i = bid * NTHR + tid; i < 18 * NADA; i += NWG * NTHR) zr[i] = 0.f; }
#endif
    grid.sync();
    for (int layer = 0; layer < DEPTH; ++layer) {
        unsigned char* wl = ws + WS_W + (size_t)layer * W_L;
        const float* modl = modall + (size_t)layer * 18 * NADA;
#if !defined(ONLY) || ONLY == 1
        REPK(4) norm_phase(p, layer, 0, bid, tid);
#endif
        GSYNC();
#if !defined(ONLY) || ONLY == 2
        REPK(1) { Gemm g{H, (const bf16*)(wl + W_IN), MT, INC, D}; StaticOrder S; S.init(MT, INC, G, bid);
          EpiWin E{(bf16*)(ws + WS_U), (bf16*)(ws + WS_Q), (bf16*)(ws + WS_K), (bf16*)(ws + WS_V), (bf16*)(ws + WS_G), (const float*)(ws + WS_ROPE), p.out, layer};
          pg8::gemm_phase<EpiWin, StaticOrder, 0>(lds, g, S, E, nullptr); }
        GSYNC();
#endif
#if !defined(ONLY) || ONLY == 3
        REPK(2) ssm_phase(p, layer, 0, lds, bid, tid);
#endif
#if !defined(ONLY) || ONLY == 4
        REPK(3) attn_phase(p, layer, lds, bid, tid);
#endif
        GSYNC();
#if !defined(ONLY) || ONLY == 5
        carry_phase(p, layer, bid, tid);
        REPK(9) { Gemm g{(const bf16*)(ws + WS_O), (const bf16*)(wl + W_O), TP, D, 512}; StaticOrder S; S.init(TP, D, G, bid);
          EpiAttnO E{(const bf16*)(ws + WS_G), (bf16*)(ws + WS_P)};
          pg8::gemm_phase<EpiAttnO, StaticOrder, 0>(lds, g, S, E, nullptr);
          small_gemm<4>(g.A + (size_t)TP * 512, g.Bt, D, 512, TP, E, lds, bid, tid); }
        GSYNC();
#endif
#if !defined(ONLY) || ONLY == 3
        REPK(2) ssm_phase(p, layer, 1, lds, bid, tid);
#endif
        GSYNC();
#if !defined(ONLY) || ONLY == 6
        { Gemm g{(const bf16*)(ws + WS_YG), (const bf16*)(wl + W_GLU), TP, 2048, 512}; StaticOrder S; S.init(TP, 2048, G, bid);
          EpiGlu E{(const bf16*)(ws + WS_G), (bf16*)(ws + WS_P)};
          pg8::gemm_phase<EpiGlu, StaticOrder, 0>(lds, g, S, E, nullptr);
          small_gemm<2>(g.A + (size_t)TP * 512, g.Bt, 2048, 512, TP, E, lds, bid, tid); }
        GSYNC();
#endif
#if !defined(ONLY) || ONLY == 7
        { Gemm g{(const bf16*)(ws + WS_P), (const bf16*)(wl + W_OUT), TP, D, D}; StaticOrder S; S.init(TP, D, G, bid);
          EpiRes E{layer == 0 ? p.in[I_XP] : X, X, modl + 2048};
          pg8::gemm_phase<EpiRes, StaticOrder, 0>(lds, g, S, E, nullptr);
          EpiRes Es{layer == 0 ? p.in[I_XS] - (size_t)TP * D : X, X, modl + 2048};
          small_gemm<4>(g.A + (size_t)TP * D, g.Bt, D, D, TP, Es, lds, bid, tid); }
        GSYNC();
#endif
#if !defined(ONLY) || ONLY == 1
        REPK(4) norm_phase(p, layer, 1, bid, tid);
#endif
        GSYNC();
#if !defined(ONLY) || ONLY == 9
        REPK(5) { Gemm g{H, (const bf16*)(wl + W_UP), UP_TILES * 256, FF2, D}; StaticOrder S; S.init(UP_TILES * 256, FF2, G, bid);
          EpiUp<false> E{(bf16*)(ws + WS_ACT), p.in[I_CW] + (size_t)layer * 3 * FF2, p.in[I_CB] + (size_t)layer * FF2, nullptr, p.out, layer};
          pg8::gemm_phase<EpiUp<false>, StaticOrder, 1>(lds, g, S, E, nullptr); }
        { Gemm g{H + (size_t)HS_SAMPLE * D, (const bf16*)(wl + W_UP), 256, FF2, D}; StaticOrder S; S.init(256, FF2, G, G - 1 - bid);
          EpiUp<true> E{(bf16*)(ws + WS_ACT), p.in[I_CW] + (size_t)layer * 3 * FF2, p.in[I_CB] + (size_t)layer * FF2, p.in[I_SCONV] + (size_t)layer * 16 * 2 * FF2, p.out, layer};
          pg8::gemm_phase<EpiUp<true>, StaticOrder, 0>(lds, g, S, E, nullptr); }
        GSYNC();
#endif
        if (PROBE == 6) { for (int i_ = 0; i_ < 10; ++i_) GSYNC(); }
#if !defined(ONLY) || ONLY == 10
        { Gemm g{(const bf16*)(ws + WS_ACT), (const bf16*)(wl + W_DN), TP, D, FF}; StaticOrder S; S.init(TP, D, G, bid);
          EpiRes E{X, X, modl + 5120};
          pg8::gemm_phase<EpiRes, StaticOrder, 0>(lds, g, S, E, nullptr);
          small_gemm<4>(g.A + (size_t)TP * FF, g.Bt, D, FF, TP, E, lds, bid, tid); }
#endif
        GSYNC();
    }
#if !defined(ONLY) || ONLY == 1
    norm_phase(p, 0, 2, bid, tid);
#endif
}
}

extern "C" void kernel_launch(void* const* d_in, const int* in_sizes, int n_in, void* d_out, int out_size, void* d_ws, size_t ws_size, hipStream_t stream) {
    static int ok = 0;
    if (ok == 0) {
        ok = 1;
        if (n_in != 31 || (size_t)out_size != mk::O_END || ws_size < mk::WS_BAR + mk::BAR_BYTES) { fprintf(stderr, "kernel_launch: unexpected shapes n_in %d out %d ws %zu (need %zu)\n", n_in, out_size, ws_size, (size_t)mk::WS_END); ok = -1; }
        if (hipFuncSetAttribute((const void*)mk::fwd, hipFuncAttributeMaxDynamicSharedMemorySize, mk::LDS_BYTES) != hipSuccess) { fprintf(stderr, "kernel_launch: hipFuncSetAttribute failed\n"); ok = -1; }
        int per_cu = 0;
        if (hipOccupancyMaxActiveBlocksPerMultiprocessor(&per_cu, (const void*)mk::fwd, mk::NTHR, mk::LDS_BYTES) != hipSuccess || per_cu < 1) fprintf(stderr, "kernel_launch: occupancy query says %d blocks per CU\n", per_cu);
        (void)hipGetLastError();
    }
    if (ok < 0) return;
    if (hipMemsetAsync((char*)d_ws + mk::WS_BAR, 0, mk::BAR_BYTES, stream) != hipSuccess) { fprintf(stderr, "kernel_launch: memset of the barrier words failed\n"); return; }
    mk::Params p{};
    for (int i = 0; i < 31; ++i) p.in[i] = (const float*)d_in[i];
    p.out = (float*)d_out; p.ws = (unsigned char*)d_ws;
    void* args[] = {&p};
    hipError_t e = hipLaunchCooperativeKernel((void*)mk::fwd, dim3(mk::NWG), dim3(mk::NTHR), args, mk::LDS_BYTES, stream);
    if (e != hipSuccess) fprintf(stderr, "kernel_launch: cooperative launch failed: %s\n", hipGetErrorString(e));
}
```

```cpp
#include <hip/hip_runtime.h>
#include <hip/hip_cooperative_groups.h>
#include <cstdio>
#include <cstdint>
namespace cg = cooperative_groups;
namespace pg8 {
#define PG8_LAS __attribute__((address_space(3)))
typedef unsigned short bf16_t;
typedef short bf16x8 __attribute__((ext_vector_type(8)));
typedef float f32x4 __attribute__((ext_vector_type(4)));
typedef unsigned u32x4 __attribute__((ext_vector_type(4)));
constexpr int BM = 256, BK = 64, HALF = 128, HTB = HALF * BK * 2  , STAGE_BYTES = 8 * HTB, NXCD = 8, WGM = 8;

__host__ __device__ __forceinline__ int lds_byte(int r, int c) { const int st = (r >> 4) * 2 + (c >> 5), rr = r & 15, cc = c & 31, ob = rr * 64 + cc * 2; return st * 1024 + (ob ^ (((ob >> 9) & 1) << 5)); }
__host__ __device__ __forceinline__ void stage_rc(int b, int& R, int& C) { const int st = b / 1024, sb = b % 1024, swz = sb ^ (((sb >> 9) & 1) << 5); R = (st >> 1) * 16 + swz / 64; C = (st & 1) * 32 + (swz % 64) / 2; }
__host__ __device__ __forceinline__ int perm32(int rho) { const int n = rho >> 4, i = rho & 15; return 8 * (i >> 2) + 4 * n + (i & 3); }

struct Unit { int pm, pn; };
struct Gemm { const bf16_t* A; const bf16_t* Bt; int M, N, K; };
struct StaticOrder {
    int nM, nN, nwg, G, c;
    __host__ __device__ void init(int M, int N, int G_, int c_) { nM = M / BM; nN = N / BM; nwg = nM * nN; G = G_; c = c_; }
    __host__ __device__ bool next(int i, Unit& u) const {
        const long L = (long)i * G + c; if (L >= nwg) return false;
        int wgid = (int)L; { const int q = nwg / NXCD, r = nwg % NXCD, xcd = wgid % NXCD, off = wgid / NXCD; wgid = (xcd < r ? xcd * (q + 1) : r * (q + 1) + (xcd - r) * q) + off; }
        const int nig = WGM * nN, gid = wgid / nig, fm = gid * WGM, gsz = (nM - fm) < WGM ? (nM - fm) : WGM;
        u.pm = fm + ((wgid % nig) % gsz); u.pn = (wgid % nig) / gsz; return true;
    }
    __device__ __forceinline__ void a_ready(const Unit&) const {}
    __device__ __forceinline__ void done(const Unit&) const {}
};
__device__ __forceinline__ unsigned cvt_pk_bf16(float lo, float hi) { unsigned r; asm volatile("v_cvt_pk_bf16_f32 %0, %1, %2" : "=v"(r) : "v"(lo), "v"(hi)); return r; }
template <class Epi, class Sched, int AMAP = 0, bool STAMP = false>
__device__ __forceinline__ void gemm_phase(PG8_LAS unsigned char* lds, const Gemm g, const Sched& S, const Epi& E, unsigned long long* stamps) {
    int tid_o = threadIdx.x; asm volatile("" : "+v"(tid_o)); const int tid = tid_o, wid = __builtin_amdgcn_readfirstlane(tid >> 6), lane = tid & 63, wr = wid >> 2, wc = wid & 3, fr = lane & 15, fq = lane >> 4;
    const int K = g.K, nt = K / BK;
    int ts_lo = 0, ts_hi = 0, nts = 0; const unsigned long long rt_entry = STAMP ? (unsigned long long)0ull : 0ull;
#define PG8_STAMP() do { if (STAMP && wid == 0 && nts < 64) { const unsigned long long _c = (unsigned long long)0ull; \
        ts_lo = (lane == nts) ? (int)(unsigned)_c : ts_lo; ts_hi = (lane == nts) ? (int)(unsigned)(_c >> 32) : ts_hi; ++nts; } } while (0)
    PG8_STAMP();
    unsigned voffA[2], voffB[2];
#pragma unroll
    for (int i = 0; i < 2; ++i) { int R, C; stage_rc(tid * 16 + i * 8192, R, C); const int Rb = Epi::PERM ? ((R & ~31) + perm32(R & 31)) : R;
        const int Ra = AMAP ? ((R >> 6) * 62 + (R & 63)) : R; voffA[i] = (unsigned)(Ra * K + C) * 2u; voffB[i] = (unsigned)(Rb * K + C) * 2u; }
    const size_t kstep = (size_t)(BK * 2);
    const size_t hstep = (size_t)HALF * K * 2;
    const size_t tstep = 2 * hstep; const size_t hstepA = AMAP ? (size_t)124 * K * 2 : hstep; const size_t tstepA = 2 * hstepA;
    const unsigned ldsw = (unsigned)wid * 1024u;
    const int aoff = lds_byte(wr * 64 + fr, fq * 8), boff = lds_byte(wc * 32 + fr, fq * 8);
#define PG8_SA(b, h) (((b) * 2 + (h)) * HTB)
#define PG8_SB(b, h) ((4 + (b) * 2 + (h)) * HTB)
#define PG8_STAGE(bufoff, gbase, voff) do { _Pragma("unroll") for (int _i = 0; _i < 2; ++_i) \
        __builtin_amdgcn_global_load_lds((const unsigned*)((const char*)(gbase) + (voff)[_i]), (PG8_LAS unsigned*)(lds + (bufoff) + ldsw + _i * 8192), 16, 0, 0); } while (0)
#define PG8_LDA(dst, b, h) do { _Pragma("unroll") for (int m = 0; m < 4; ++m) _Pragma("unroll") for (int k = 0; k < 2; ++k) dst[m][k] = *(const PG8_LAS bf16x8*)(lds + PG8_SA(b, h) + aoff + m * 2048 + k * 1024); } while (0)
#define PG8_LDB(dst, b, h) do { _Pragma("unroll") for (int n = 0; n < 2; ++n) _Pragma("unroll") for (int k = 0; k < 2; ++k) dst[n][k] = *(const PG8_LAS bf16x8*)(lds + PG8_SB(b, h) + boff + n * 2048 + k * 1024); } while (0)
#define PG8_MMA(ai, bj, At, Bt) do { __builtin_amdgcn_s_setprio(1); _Pragma("unroll") for (int m = 0; m < 4; ++m) _Pragma("unroll") for (int n = 0; n < 2; ++n) _Pragma("unroll") for (int k = 0; k < 2; ++k) \
        acc[ai][bj][m][n] = __builtin_amdgcn_mfma_f32_16x16x32_bf16(Bt[n][k], At[m][k], acc[ai][bj][m][n], 0, 0, 0); __builtin_amdgcn_s_setprio(0); } while (0)
#define PG8_WAIT_V(n) asm volatile("s_waitcnt vmcnt(" #n ")" ::: "memory")
#define PG8_WAIT_L(n) asm volatile("s_waitcnt lgkmcnt(" #n ")" ::: "memory")
#define PG8_BAR __builtin_amdgcn_s_barrier()
#define PG8_SCHED __builtin_amdgcn_sched_barrier(0)
    Unit cur, nxt; int ui = 0;
    if (!S.next(0, cur)) return;
    f32x4 acc[2][2][4][2];
#pragma unroll
    for (int a = 0; a < 2; ++a)
#pragma unroll
        for (int b = 0; b < 2; ++b)
#pragma unroll
            for (int m = 0; m < 4; ++m)
#pragma unroll
                for (int n = 0; n < 2; ++n) acc[a][b][m][n] = (f32x4){0.f, 0.f, 0.f, 0.f};
    bf16x8 At[4][2], B0[2][2], B1[2][2];
    const char* cA = (const char*)g.A + (size_t)cur.pm * tstepA; const char* cB = (const char*)g.Bt + (size_t)cur.pn * tstep;
    S.a_ready(cur);
    PG8_STAGE(PG8_SB(0, 0), cB, voffB); PG8_STAGE(PG8_SB(0, 1), cB + hstep, voffB); PG8_STAGE(PG8_SA(0, 0), cA, voffA); PG8_STAGE(PG8_SA(0, 1), cA + hstepA, voffA);
    if (wr == 1) PG8_BAR;
    PG8_WAIT_V(2); PG8_BAR;
    PG8_STAGE(PG8_SB(1, 0), cB + kstep, voffB); PG8_STAGE(PG8_SA(1, 0), cA + kstep, voffA); PG8_STAGE(PG8_SB(1, 1), cB + hstep + kstep, voffB);
    PG8_WAIT_V(6); PG8_BAR;
    PG8_STAMP();
    for (;;) {
        const bool has_next = S.next(ui + 1, nxt);
        const char* nA = has_next ? (const char*)g.A + (size_t)nxt.pm * tstepA : cA; const char* nB = has_next ? (const char*)g.Bt + (size_t)nxt.pn * tstep : cB;
        for (int t = 0; t < nt; t += 2) {
            const bool last = (t == nt - 2);
            const char* a1 = cA + (size_t)(t + 1) * kstep;
            const char* a2 = last ? nA : cA + (size_t)(t + 2) * kstep; const char* b2 = last ? nB : cB + (size_t)(t + 2) * kstep;
            const char* a3 = a2 + kstep; const char* b3 = b2 + kstep;
            if (last && has_next) S.a_ready(nxt);
            PG8_LDB(B0, 0, 0); PG8_LDB(B1, 0, 1); PG8_SCHED; PG8_LDA(At, 0, 0); PG8_STAGE(PG8_SA(1, 1), a1 + hstepA, voffA);
            PG8_WAIT_V(8); PG8_WAIT_L(0); PG8_BAR; PG8_MMA(0, 0, At, B0); PG8_MMA(0, 1, At, B1); PG8_BAR; PG8_SCHED;
            PG8_LDA(At, 0, 1); PG8_STAGE(PG8_SB(0, 0), b2, voffB); PG8_STAGE(PG8_SB(0, 1), b2 + hstep, voffB); PG8_STAGE(PG8_SA(0, 0), a2, voffA);
            PG8_WAIT_V(8); PG8_WAIT_L(0); PG8_BAR; PG8_MMA(1, 0, At, B0); PG8_MMA(1, 1, At, B1); PG8_BAR; PG8_SCHED;
            PG8_LDB(B0, 1, 0); PG8_LDB(B1, 1, 1); PG8_SCHED; PG8_LDA(At, 1, 0); PG8_STAGE(PG8_SA(0, 1), a2 + hstepA, voffA);
            PG8_WAIT_V(8); PG8_WAIT_L(0); PG8_BAR; PG8_MMA(0, 0, At, B0); PG8_MMA(0, 1, At, B1); PG8_BAR; PG8_SCHED;
            PG8_LDA(At, 1, 1); PG8_STAGE(PG8_SB(1, 0), b3, voffB); PG8_STAGE(PG8_SB(1, 1), b3 + hstep, voffB); PG8_STAGE(PG8_SA(1, 0), a3, voffA);
            PG8_WAIT_V(8); PG8_WAIT_L(0); PG8_BAR; PG8_MMA(1, 0, At, B0); PG8_MMA(1, 1, At, B1); PG8_BAR; PG8_SCHED;
        }
        PG8_STAMP();
        if (wr == 0) PG8_BAR;
        if constexpr (!Epi::AFTER_DRAIN) { E(acc, cur, wr, wc, fr, fq); S.done(cur); }
        PG8_STAMP();
        if (!has_next) break;
#pragma unroll
        for (int a = 0; a < 2; ++a)
#pragma unroll
            for (int b = 0; b < 2; ++b)
#pragma unroll
                for (int m = 0; m < 4; ++m)
#pragma unroll
                    for (int n = 0; n < 2; ++n) acc[a][b][m][n] = (f32x4){0.f, 0.f, 0.f, 0.f};
        cur = nxt; cA = nA; cB = nB; ++ui;
        if (wr == 1) PG8_BAR;
    }
    PG8_WAIT_V(0);
    PG8_BAR;
    if constexpr (Epi::AFTER_DRAIN) { E.fused(acc, cur, wr, wc, fr, fq, lds, wid, lane); S.done(cur); }
    PG8_STAMP();
    if (STAMP && wid == 0) { stamps[lane] = lane < nts ? (((unsigned long long)(unsigned)ts_hi << 32) | (unsigned)ts_lo) : 0ull;
        if (lane == 62) stamps[62] = rt_entry; if (lane == 63) stamps[63] = (unsigned long long)0ull; }
#undef PG8_STAMP
#undef PG8_SA
#undef PG8_SB
#undef PG8_STAGE
#undef PG8_LDA
#undef PG8_LDB
#undef PG8_MMA
#undef PG8_WAIT_V
#undef PG8_WAIT_L
#undef PG8_BAR
#undef PG8_SCHED
}
}
namespace xb {
#define XB_TMO      128
#define XB_XCNT(j)  (256  + 64 * (j))
#define XB_XSUB(j)  (1280 + 64 * (j))
#define XB_XGEN(j)  (2304 + 64 * (j))
#define XB_TOP      3328
#define XB_TOPGEN   3392
#define XCD_BAR_WORDS 3456
#define XB_SPIN_CAP (1u << 18)

__device__ __forceinline__ unsigned xb_ld(unsigned* p)              { return __hip_atomic_load(p, __ATOMIC_RELAXED, __HIP_MEMORY_SCOPE_AGENT); }
__device__ __forceinline__ unsigned xb_add(unsigned* p, unsigned v) { return __hip_atomic_fetch_add(p, v, __ATOMIC_RELAXED, __HIP_MEMORY_SCOPE_AGENT); }
__device__ __forceinline__ unsigned xb_xcc_id() { return (unsigned)__builtin_amdgcn_s_getreg((3 << 11) | 20) & 0xFu; }
#define XB_SPIN(cond, bar) do { unsigned _sp = 0; while (cond) { __builtin_amdgcn_s_sleep(1); \
    if ((++_sp & 255u) == 0u) { if (xb_ld(&(bar)[XB_TMO])) break; if (_sp > XB_SPIN_CAP) { atomicAdd(&(bar)[XB_TMO], 1u); break; } } } } while (0)

struct XcdBarrier {
    unsigned* bar; unsigned x;
    volatile __attribute__((address_space(3))) unsigned* st;
};

__device__ __forceinline__ XcdBarrier xcd_barrier_post(unsigned* bar, volatile __attribute__((address_space(3))) unsigned* st) {
    XcdBarrier b; b.bar = bar; b.x = xb_xcc_id(); b.st = st;
    if (threadIdx.x == 0) (void)xb_add(&bar[XB_XCNT(b.x)], 1u);
    return b;
}
__device__ __forceinline__ void xcd_barrier_complete(unsigned* bar, unsigned x, unsigned& nloc, unsigned& nx) {
    const unsigned G = gridDim.x * gridDim.y * gridDim.z;
    unsigned sum, cnt, mine, sp = 0u;
    for (;;) {
        sum = 0u; cnt = 0u; mine = 0u;
#pragma unroll
        for (unsigned j = 0; j < 16; ++j) { const unsigned c = xb_ld(&bar[XB_XCNT(j)]); sum += c; cnt += (c > 0u) ? 1u : 0u; mine = (j == x) ? c : mine; }
        if (sum == G) break;
        __builtin_amdgcn_s_sleep(1);
        if ((++sp & 255u) == 0u) { if (xb_ld(&bar[XB_TMO])) break; if (sp > XB_SPIN_CAP) { atomicAdd(&bar[XB_TMO], 1u); break; } }
    }
    nloc = mine > 0u ? mine : 1u; nx = cnt > 0u ? cnt : 1u;
}

__device__ __forceinline__ void xcd_barrier(const XcdBarrier& b) {
    asm volatile("s_waitcnt vmcnt(0)" ::: "memory");
    __syncthreads();
    if (threadIdx.x == 0) {
        unsigned* bar = b.bar;
        __builtin_amdgcn_s_waitcnt(0);
        unsigned nloc = b.st[0], nx = b.st[1];
        if (nloc == 0u) { xcd_barrier_complete(bar, b.x, nloc, nx); b.st[0] = nloc; b.st[1] = nx; }
        const unsigned old = xb_add(&bar[XB_XSUB(b.x)], 1u);
        const unsigned gen = old / nloc;
        if (old + 1u == (gen + 1u) * nloc) {
            __builtin_amdgcn_fence(__ATOMIC_RELEASE, "agent");
            asm volatile("s_waitcnt vmcnt(0)" ::: "memory");
            const unsigned og = xb_add(&bar[XB_TOP], 1u);
            const unsigned tg = og / nx;
            if (og + 1u == (tg + 1u) * nx) xb_add(&bar[XB_TOPGEN], 1u);
            else XB_SPIN(xb_ld(&bar[XB_TOPGEN]) == tg, bar);
            __builtin_amdgcn_fence(__ATOMIC_ACQUIRE, "agent");
            xb_add(&bar[XB_XGEN(b.x)], 1u);
            asm volatile("s_waitcnt vmcnt(0)" ::: "memory");
        } else {
            XB_SPIN(xb_ld(&bar[XB_XGEN(b.x)]) == gen, bar);
            __builtin_amdgcn_fence(__ATOMIC_ACQUIRE, "agent");
            asm volatile("s_waitcnt vmcnt(0)" ::: "memory");
        }
    }
    __syncthreads();
}

}
#ifndef PROBE
#define PROBE 0
#endif
#define REPK(k) _Pragma("unroll 1") for (int rep_ = 0; rep_ < ((PROBE == (k)) ? 2 : 1); ++rep_)
namespace mk {
#ifndef SCHB
#define SCHB (void)0
#endif
using pg8::Unit; using pg8::Gemm; using pg8::StaticOrder; using pg8::cvt_pk_bf16;
#define LAS __attribute__((address_space(3)))
typedef unsigned short bf16;
typedef float f32x4 __attribute__((ext_vector_type(4)));
typedef short bf16x8 __attribute__((ext_vector_type(8)));
typedef unsigned u32x2 __attribute__((ext_vector_type(2)));
typedef unsigned u32x4 __attribute__((ext_vector_type(4)));

constexpr int D = 1024, SEQ = 16384, TP = 32768, TS = 256, MT = 33024, DEPTH = 4, INC = 3328, FF = 2816, FF2 = 5632, NADA = 6144;
constexpr int HSEQ = 16386, HS_SAMPLE = 33280, H_ROWS = 33536, UP_TILES = 133;
constexpr int NWG = 256, NTHR = 512;
constexpr int LDS_BYTES = 135168;
constexpr size_t O_Y = 0, O_YS = 33554432, O_KP = 33816576, O_VP = 33947648, O_SRP = 34078720, O_SIP = 34095104, O_CP = 34111488,
                 O_KS = 34201600, O_VS = 34332672, O_SRS = 34463744, O_SIS = 34594816, O_CS = 34725888, O_END = 35446784;
constexpr size_t WS_BAR = 518586368, BAR_BYTES = 16384;
constexpr size_t WS_ZERO = 518602752;
constexpr int MISC_OFF = 131072;
constexpr size_t W_L = 29360128, W_IN = 0, W_GLU = 6815744, W_O = 8912896, W_OUT = 9961472, W_UP = 12058624, W_DN = 23592960;
constexpr size_t WS_W = 0, WS_MOD = 117440512, WS_ROPE = 119209984, WS_CH = 120258560, WS_H = 128647168, WS_O = WS_H, WS_YG = WS_H + 33816576,
                 WS_U = 197328896, WS_Q = 264962048, WS_K = 298778624, WS_V = 307232768, WS_G = 315686912, WS_P = 450953216, WS_END = 518586368, WS_ACT = WS_U;

struct Params { const float* in[31]; float* out; unsigned char* ws; };
enum { I_XP = 0, I_XS, I_CK, I_CV, I_SRE, I_SIM, I_SCONV, I_CP, I_CS, I_ADAW, I_ADAB, I_N1G, I_N2G, I_WIN, I_ARE, I_AIM, I_LDT, I_BRE, I_BIM, I_CRE, I_CIM, I_SD,
       I_WGLU, I_SINK, I_WO, I_WOUT, I_WUP, I_CW, I_CB, I_WDN, I_FG };

__device__ __forceinline__ float bf2f(unsigned h) { return __uint_as_float(h << 16); }
__device__ __forceinline__ unsigned f2bf(float f) { unsigned u = __float_as_uint(f); return (u + 0x7fffu + ((u >> 16) & 1u)) >> 16; }
__device__ __forceinline__ float sigm(float x) { return __builtin_amdgcn_rcpf(1.0f + __builtin_amdgcn_exp2f(-1.4426950409f * x)); }
__device__ __forceinline__ float gelu_tanh(float x) { const float z = 1.5957691216f * (x + 0.044715f * x * x * x); return x * sigm(z); }
__device__ __forceinline__ f32x4 ld_bf4(const bf16* p) { const u32x2 v = *(const u32x2*)p; return (f32x4){__uint_as_float(v.x << 16), __uint_as_float(v.x & 0xffff0000u), __uint_as_float(v.y << 16), __uint_as_float(v.y & 0xffff0000u)}; }
__device__ __forceinline__ void st_bf4(bf16* p, f32x4 v) { u32x2 o; o.x = cvt_pk_bf16(v.x, v.y); o.y = cvt_pk_bf16(v.z, v.w); *(u32x2*)p = o; }
__device__ __forceinline__ int modrow_of(int row) { return row < TP ? (row >> 14) : 2 + ((row - TP) >> 4); }
__device__ __forceinline__ int pos_of(int row) { return row < TP ? (row & (SEQ - 1)) : 2048 + ((row - TP) & 15); }
__device__ __forceinline__ float wave_sum(float v) {
#pragma unroll
    for (int o = 1; o < 64; o <<= 1) v += __shfl_xor(v, o);
    return v;
}
template <int CTRL> __device__ __forceinline__ float dpp_mov(float old, float src) {
    return __builtin_bit_cast(float, __builtin_amdgcn_update_dpp(__builtin_bit_cast(int, old), __builtin_bit_cast(int, src), CTRL, 0xf, 0xf, false));
}
template <int CTRL> __device__ __forceinline__ float dpp_rot(float src) {
    return __builtin_bit_cast(float, __builtin_amdgcn_mov_dpp(__builtin_bit_cast(int, src), CTRL, 0xf, 0xf, true));
}
__device__ __forceinline__ f32x4 row_prev1(f32x4 cur, f32x4 pm) { f32x4 r;
#pragma unroll
    for (int e = 0; e < 4; ++e) r[e] = dpp_mov<0x111>(dpp_rot<0x121>(pm[e]), cur[e]);
    return r; }
__device__ __forceinline__ f32x4 row_prev2(f32x4 cur, f32x4 pm) { f32x4 r;
#pragma unroll
    for (int e = 0; e < 4; ++e) r[e] = dpp_mov<0x112>(dpp_rot<0x122>(pm[e]), cur[e]);
    return r; }

typedef float f32x2 __attribute__((ext_vector_type(2)));
template <int E> __device__ __forceinline__ f32x2 conv_pair(f32x4 b, f32x4 w0, f32x4 w1, f32x4 w2, f32x4 cur, f32x4 pm) {
    const f32x2 c = (f32x2){cur[E], cur[E + 1]};
    const f32x2 p1 = (f32x2){dpp_mov<0x111>(dpp_rot<0x121>(pm[E]), cur[E]), dpp_mov<0x111>(dpp_rot<0x121>(pm[E + 1]), cur[E + 1])};
    const f32x2 p2 = (f32x2){dpp_mov<0x112>(dpp_rot<0x122>(pm[E]), cur[E]), dpp_mov<0x112>(dpp_rot<0x122>(pm[E + 1]), cur[E + 1])};
    f32x2 r = (f32x2){b[E], b[E + 1]} + (f32x2){w2[E], w2[E + 1]} * c;
    r = (f32x2){w1[E], w1[E + 1]} * p1 + r;
    r = (f32x2){w0[E], w0[E + 1]} * p2 + r;
    return r;
}
struct EpiWin {
    static constexpr bool PERM = false, AFTER_DRAIN = false;
    bf16* U; bf16* Q; bf16* Kb; bf16* Vb; bf16* G; const float* rope; float* out; int layer;
    __device__ __forceinline__ f32x4 rot(f32x4 v, f32x4 cs, f32x4 sn, int fq) const {
        f32x4 o, r;
#pragma unroll
        for (int e = 0; e < 4; ++e) o[e] = __shfl_xor(v[e], 32);
        if (fq < 2) r = v * cs - o * sn; else r = v * cs + o * sn;
        return r;
    }
    __device__ __forceinline__ void operator()(const f32x4 (&acc)[2][2][4][2], const Unit& u, int wr, int wc, int fr, int fq) const {
        const int pn = u.pn;
        const bool need_rot = (pn >= 2 && pn <= 4) && (wc & 1) == 0;
#pragma unroll
        for (int ai = 0; ai < 2; ++ai) {
            f32x4 rcs[4], rsn[4];
#pragma unroll
            for (int m = 0; m < 4; ++m) { rcs[m] = (f32x4){1.f, 1.f, 1.f, 1.f}; rsn[m] = (f32x4){0.f, 0.f, 0.f, 0.f};
                if (need_rot) { const float* rp = rope + (unsigned)(pos_of(u.pm * 256 + ai * 128 + wr * 64 + m * 16 + fr) * 16 + 4 * (fq & 1)); rcs[m] = *(const f32x4*)rp; rsn[m] = *(const f32x4*)(rp + 8); } }
#pragma unroll
            for (int m = 0; m < 4; ++m) {
                const int row = u.pm * 256 + ai * 128 + wr * 64 + m * 16 + fr;
                const int pos = pos_of(row);
                if (pn < 2) {
#pragma unroll
                    for (int bj = 0; bj < 2; ++bj)
#pragma unroll
                        for (int n = 0; n < 2; ++n) st_bf4(U + (unsigned)(row * 512 + pn * 256 + bj * 128 + wc * 32 + n * 16 + 4 * fq), acc[ai][bj][m][n]);
                } else if (pn < 4) {
#pragma unroll
                    for (int bj = 0; bj < 2; ++bj)
#pragma unroll
                        for (int n = 0; n < 2; ++n) {
                            f32x4 v = acc[ai][bj][m][n] * 0.125f;
                            if (n == 0 && (wc & 1) == 0) v = rot(v, rcs[m], rsn[m], fq);
                            st_bf4(Q + (unsigned)(row * 512 + (pn - 2) * 256 + bj * 128 + wc * 32 + n * 16 + 4 * fq), v);
                        }
                } else if (pn == 4) {
#pragma unroll
                    for (int bj = 0; bj < 2; ++bj)
#pragma unroll
                        for (int n = 0; n < 2; ++n) {
                            f32x4 v = acc[ai][bj][m][n];
                            const int c = wc * 32 + n * 16 + 4 * fq;
                            if (bj == 0 && n == 0 && (wc & 1) == 0) v = rot(v, rcs[m], rsn[m], fq);
                            st_bf4((bj == 0 ? Kb : Vb) + (unsigned)(row * 128 + c), v);
                            if (row >= TP) *(f32x4*)(out + (bj == 0 ? O_KS : O_VS) + (unsigned)((layer * 256 + (row - TP)) * 128 + c)) = v;
                            else if (pos >= SEQ - 128) *(f32x4*)(out + (bj == 0 ? O_KP : O_VP) + (unsigned)(((layer * 2 + (row >> 14)) * 128 + (pos - (SEQ - 128))) * 128 + c)) = v;
                        }
                } else {
#pragma unroll
                    for (int bj = 0; bj < 2; ++bj)
#pragma unroll
                        for (int n = 0; n < 2; ++n) {
                            const f32x4 a = acc[ai][bj][m][n]; f32x4 v;
#pragma unroll
                            for (int e = 0; e < 4; ++e) v[e] = sigm(a[e]);
                            st_bf4(G + (unsigned)(row * 2048 + (pn - 5) * 256 + bj * 128 + wc * 32 + n * 16 + 4 * fq), v);
                        }
                }
            }
        }
    }
};
struct EpiAttnO {
    static constexpr bool PERM = false, AFTER_DRAIN = false;
    const bf16* G; bf16* P;
    __device__ __forceinline__ void quad(int row, int cb, int fq, f32x4 v0, f32x4 v1) const {
        const int col = cb + 4 * fq;
        st_bf4(P + (unsigned)(row * 1024 + col), ld_bf4(G + (unsigned)(row * 2048 + 1024 + col)) * v0);
        st_bf4(P + (unsigned)(row * 1024 + col + 16), ld_bf4(G + (unsigned)(row * 2048 + 1024 + col + 16)) * v1);
    }
    __device__ __forceinline__ void operator()(const f32x4 (&acc)[2][2][4][2], const Unit& u, int wr, int wc, int fr, int fq) const {
#pragma unroll
        for (int ai = 0; ai < 2; ++ai) {
            u32x2 gq[4][2][2];
#pragma unroll
            for (int m = 0; m < 4; ++m)
#pragma unroll
                for (int bj = 0; bj < 2; ++bj)
#pragma unroll
                    for (int n = 0; n < 2; ++n) gq[m][bj][n] = *(const u32x2*)(G + (unsigned)((u.pm * 256 + ai * 128 + wr * 64 + m * 16 + fr) * 2048 + 1024 + u.pn * 256 + bj * 128 + wc * 32 + 16 * n + 4 * fq));
#pragma unroll
            for (int m = 0; m < 4; ++m)
#pragma unroll
                for (int bj = 0; bj < 2; ++bj)
#pragma unroll
                    for (int n = 0; n < 2; ++n) { const u32x2 q = gq[m][bj][n];
                        const f32x4 gb = (f32x4){__uint_as_float(q.x << 16), __uint_as_float(q.x & 0xffff0000u), __uint_as_float(q.y << 16), __uint_as_float(q.y & 0xffff0000u)};
                        st_bf4(P + (unsigned)((u.pm * 256 + ai * 128 + wr * 64 + m * 16 + fr) * 1024 + u.pn * 256 + bj * 128 + wc * 32 + 16 * n + 4 * fq), gb * acc[ai][bj][m][n]); }
        }
    }
};
struct EpiGlu {
    static constexpr bool PERM = false, AFTER_DRAIN = false;
    const bf16* G; bf16* P;
    __device__ __forceinline__ void quad(int row, int cb, int fq, f32x4 a, f32x4 b) const {
        const int j = (cb >> 1) + 4 * fq;
        const f32x4 ga = ld_bf4(G + (unsigned)(row * 2048 + j)), pb = ld_bf4(P + (unsigned)(row * 1024 + j));
        f32x4 v;
#pragma unroll
        for (int e = 0; e < 4; ++e) v[e] = ga[e] * a[e] * sigm(b[e]) + pb[e];
        st_bf4(P + (unsigned)(row * 1024 + j), v);
    }
    __device__ __forceinline__ void operator()(const f32x4 (&acc)[2][2][4][2], const Unit& u, int wr, int wc, int fr, int fq) const {
#pragma unroll
        for (int ai = 0; ai < 2; ++ai) {
            u32x2 gq[4][2], pq[4][2];
#pragma unroll
            for (int m = 0; m < 4; ++m)
#pragma unroll
                for (int bj = 0; bj < 2; ++bj) { const int row = u.pm * 256 + ai * 128 + wr * 64 + m * 16 + fr, j = ((u.pn * 256 + bj * 128 + wc * 32) >> 1) + 4 * fq;
                    gq[m][bj] = *(const u32x2*)(G + (unsigned)(row * 2048 + j)); pq[m][bj] = *(const u32x2*)(P + (unsigned)(row * 1024 + j)); }
#pragma unroll
            for (int m = 0; m < 4; ++m)
#pragma unroll
                for (int bj = 0; bj < 2; ++bj) { const int row = u.pm * 256 + ai * 128 + wr * 64 + m * 16 + fr, j = ((u.pn * 256 + bj * 128 + wc * 32) >> 1) + 4 * fq;
                    const u32x2 q = gq[m][bj], r = pq[m][bj];
                    const f32x4 ga = (f32x4){__uint_as_float(q.x << 16), __uint_as_float(q.x & 0xffff0000u), __uint_as_float(q.y << 16), __uint_as_float(q.y & 0xffff0000u)};
                    const f32x4 pb = (f32x4){__uint_as_float(r.x << 16), __uint_as_float(r.x & 0xffff0000u), __uint_as_float(r.y << 16), __uint_as_float(r.y & 0xffff0000u)};
                    const f32x4 a = acc[ai][bj][m][0], bb = acc[ai][bj][m][1]; f32x4 v;
#pragma unroll
                    for (int e2 = 0; e2 < 4; ++e2) v[e2] = ga[e2] * a[e2] * sigm(bb[e2]) + pb[e2];
                    st_bf4(P + (unsigned)(row * 1024 + j), v); }
        }
    }
};
struct EpiRes {
    static constexpr bool PERM = false, AFTER_DRAIN = false;
    const float* xb; float* X; const float* gvec;
    __device__ __forceinline__ void quad(int row, int cb, int fq, f32x4 v0, f32x4 v1) const {
        const unsigned go = (unsigned)(modrow_of(row) * NADA), o = (unsigned)(row * D + cb + 4 * fq);
        *(f32x4*)(X + o) = *(const f32x4*)(xb + o) + *(const f32x4*)(gvec + (go + cb + 4 * fq)) * v0;
        *(f32x4*)(X + o + 16) = *(const f32x4*)(xb + o + 16) + *(const f32x4*)(gvec + (go + cb + 4 * fq + 16)) * v1;
    }
    __device__ __forceinline__ void operator()(const f32x4 (&acc)[2][2][4][2], const Unit& u, int wr, int wc, int fr, int fq) const {
        const unsigned go = (unsigned)(modrow_of(u.pm * 256) * NADA);
        f32x4 gv[2][2];
#pragma unroll
        for (int bj = 0; bj < 2; ++bj)
#pragma unroll
            for (int n = 0; n < 2; ++n) gv[bj][n] = *(const f32x4*)(gvec + (go + u.pn * 256 + bj * 128 + wc * 32 + 16 * n + 4 * fq));
#pragma unroll
        for (int ai = 0; ai < 2; ++ai) {
            f32x4 xr[4][2][2];
#pragma unroll
            for (int m = 0; m < 4; ++m)
#pragma unroll
                for (int bj = 0; bj < 2; ++bj)
#pragma unroll
                    for (int n = 0; n < 2; ++n) xr[m][bj][n] = *(const f32x4*)(xb + (unsigned)((u.pm * 256 + ai * 128 + wr * 64 + m * 16 + fr) * D + u.pn * 256 + bj * 128 + wc * 32 + 16 * n + 4 * fq));
#pragma unroll
            for (int m = 0; m < 4; ++m)
#pragma unroll
                for (int bj = 0; bj < 2; ++bj)
#pragma unroll
                    for (int n = 0; n < 2; ++n) *(f32x4*)(X + (unsigned)((u.pm * 256 + ai * 128 + wr * 64 + m * 16 + fr) * D + u.pn * 256 + bj * 128 + wc * 32 + 16 * n + 4 * fq)) = xr[m][bj][n] + gv[bj][n] * acc[ai][bj][m][n];
        }
    }
};
template <int SPLIT, class Epi> __device__ __forceinline__ void small_gemm(const bf16* A, const bf16* Wt, int N, int K, int row0, const Epi& E, LAS unsigned char* lds, int bid, int tid) {
    asm volatile("" : "+v"(tid));
    const int lane = tid & 63, wave = tid >> 6, fr = lane & 15, fq = lane >> 4;
    const int nct = N >> 5, ntile = 16 * nct, tpw = 8 / SPLIT, kp = wave % SPLIT, tl = wave / SPLIT, kb = (K / SPLIT) * kp, ke = kb + K / SPLIT;
    LAS f32x4* red = (LAS f32x4*)lds;
    for (int t0 = bid * tpw; t0 < ntile; t0 += NWG * tpw) {
        const int tile = t0 + tl, rt = tile / nct, ct = tile - rt * nct;
        const bf16* ap = A + (unsigned)((16 * rt + fr) * K + 8 * fq);
        const bf16* bp0 = Wt + (unsigned)((32 * ct + fr) * K + 8 * fq);
        const bf16* bp1 = bp0 + (unsigned)(16 * K);
        f32x4 c0 = (f32x4){0.f, 0.f, 0.f, 0.f}, c1 = (f32x4){0.f, 0.f, 0.f, 0.f};
        for (int k0 = kb; k0 < ke; k0 += 256) {
            const int nst = (ke - k0) >> 5;
            bf16x8 a[8], b0[8], b1[8];
#pragma unroll
            for (int s = 0; s < 8; ++s) if (s < nst) { a[s] = *(const bf16x8*)(ap + k0 + 32 * s); b0[s] = *(const bf16x8*)(bp0 + k0 + 32 * s); b1[s] = *(const bf16x8*)(bp1 + k0 + 32 * s); }
#pragma unroll
            for (int s = 0; s < 8; ++s) if (s < nst) { c0 = __builtin_amdgcn_mfma_f32_16x16x32_bf16(b0[s], a[s], c0, 0, 0, 0); c1 = __builtin_amdgcn_mfma_f32_16x16x32_bf16(b1[s], a[s], c1, 0, 0, 0); }
        }
        if (SPLIT > 1) {
            __builtin_amdgcn_sched_barrier(0); asm volatile("s_nop 15\n\ts_nop 15" ::: "memory"); __builtin_amdgcn_sched_barrier(0);
            red[(wave * 2 + 0) * 64 + lane] = c0; red[(wave * 2 + 1) * 64 + lane] = c1;
            __syncthreads();
            if (kp == 0) {
#pragma unroll
                for (int j = 1; j < SPLIT; ++j) { c0 += red[((wave + j) * 2 + 0) * 64 + lane]; c1 += red[((wave + j) * 2 + 1) * 64 + lane]; }
            }
        }
        if (kp == 0) E.quad(row0 + 16 * rt + fr, 32 * ct, fq, c0, c1);
        if (SPLIT > 1) __syncthreads();
    }
}
template <bool SAMPLE> struct EpiUp {
    static constexpr bool PERM = false, AFTER_DRAIN = false;
    bf16* ACT; const float* cw; const float* cb; const float* sconv; float* out; int layer;
    __device__ __forceinline__ void operator()(const f32x4 (&acc)[2][2][4][2], const Unit& u, int wr, int wc, int fr, int fq) const {
        const f32x4 z = (f32x4){0.f, 0.f, 0.f, 0.f};
#pragma unroll
        for (int bj = 0; bj < 2; ++bj) {
            const int jf = 16 * (8 * u.pn + 4 * bj + wc) + 4 * fq;
            typedef const __attribute__((address_space(4))) f32x4* cptr4;
            const f32x4 wv0 = *(cptr4)(cw + jf), wv1 = *(cptr4)(cw + FF2 + jf), wv2 = *(cptr4)(cw + 2 * FF2 + jf), bv = *(cptr4)(cb + jf);
            const f32x4 wg0 = *(cptr4)(cw + FF + jf), wg1 = *(cptr4)(cw + FF2 + FF + jf), wg2 = *(cptr4)(cw + 2 * FF2 + FF + jf), bg = *(cptr4)(cb + FF + jf);
#pragma unroll
            for (int ai = 0; ai < 2; ++ai)
#pragma unroll
                for (int m = 0; m < 4; ++m) {
                    const f32x4 cv = acc[ai][bj][m][0], cg = acc[ai][bj][m][1];
                    const f32x4 pv = m > 0 ? acc[ai][bj][m > 0 ? m - 1 : 0][0] : z, pg = m > 0 ? acc[ai][bj][m > 0 ? m - 1 : 0][1] : z;
                    f32x4 val = bv + wv2 * cv, gat = bg + wg2 * cg;
                    bool valid; unsigned aoff;
                    if (SAMPLE) {
                        const int s = 8 * ai + 4 * wr + m, t = fr;
                        f32x4 p1v = row_prev1(cv, z), p2v = row_prev2(cv, z), p1g = row_prev1(cg, z), p2g = row_prev2(cg, z);
                        if (t < 2) {
                            const float* st = sconv + (unsigned)(s * 2 * FF2 + jf);
                            const f32x4 s1v = *(const f32x4*)(st + FF2), s1g = *(const f32x4*)(st + FF2 + FF);
                            if (t == 0) { p1v = s1v; p1g = s1g; p2v = *(const f32x4*)st; p2g = *(const f32x4*)(st + FF); }
                            else { p2v = s1v; p2g = s1g; }
                        }
                        val += wv0 * p2v + wv1 * p1v; gat += wg0 * p2g + wg1 * p1g;
                        valid = true; aoff = (unsigned)(TP + 16 * s + t) * FF + jf;
                        if (t >= 14) { float* o = out + O_CS + (unsigned)(((layer * 16 + s) * 2 + (t - 14)) * FF2 + jf); *(f32x4*)o = cv; *(f32x4*)(o + FF) = cg; }
                    } else {
                        { f32x2 v01 = conv_pair<0>(bv, wv0, wv1, wv2, cv, pv), v23 = conv_pair<2>(bv, wv0, wv1, wv2, cv, pv);
                          asm volatile("" : "+v"(v01), "+v"(v23));
                          const f32x2 g01 = conv_pair<0>(bg, wg0, wg1, wg2, cg, pg), g23 = conv_pair<2>(bg, wg0, wg1, wg2, cg, pg);
                          val = (f32x4){v01.x, v01.y, v23.x, v23.y}; gat = (f32x4){g01.x, g01.y, g23.x, g23.y}; }
                        const int j = 16 * m + fr, hs = 248 * u.pm + 62 * (2 * ai + wr) + j;
                        const int b = hs >= HSEQ ? 1 : 0, pos = hs - b * HSEQ - 2;
                        valid = (j >= 2) && (pos >= 0) && (hs < 2 * HSEQ);
                        aoff = (unsigned)(b * SEQ + pos) * FF + jf;
                        if (valid && pos >= SEQ - 2) { float* o = out + O_CP + (unsigned)(((layer * 2 + b) * 2 + (pos - (SEQ - 2))) * FF2 + jf); *(f32x4*)o = cv; *(f32x4*)(o + FF) = cg; }
                    }
                    if (valid) {
                        f32x4 a;
#pragma unroll
                        for (int e = 0; e < 4; ++e) a[e] = gat[e] * sigm(gat[e]) * val[e];
                        st_bf4(ACT + aoff, a);
                    }
                    SCHB;
                }
        }
    }
};

__device__ __forceinline__ int dstrow(int mode, int half, int n) { if (mode == 0) return n; const int j = n < half ? n : n - half; return 32 * (j >> 4) + (j & 15) + (n < half ? 0 : 16); }
__device__ __forceinline__ void transpose_item(const float* W, int K, int N, bf16* WT, int mode, int half, LAS float* scr, int item, int lane) {
    const int nblk = N / 32, kb = item / nblk, nb = item % nblk, k0 = 64 * kb, n0 = 32 * nb;
#pragma unroll 8
    for (int i = 0; i < 32; ++i) { const int kk = 2 * i + (lane >> 5); scr[kk * 33 + (lane & 31)] = W[(size_t)(k0 + kk) * N + n0 + (lane & 31)]; }
    asm volatile("s_waitcnt lgkmcnt(0)" ::: "memory");
    const int c = lane & 7;
#pragma unroll
    for (int j = 0; j < 4; ++j) { const int n = (lane >> 3) + 8 * j; const LAS float* s = scr + (8 * c) * 33 + n;
        u32x4 o; o.x = cvt_pk_bf16(s[0 * 33], s[1 * 33]); o.y = cvt_pk_bf16(s[2 * 33], s[3 * 33]); o.z = cvt_pk_bf16(s[4 * 33], s[5 * 33]); o.w = cvt_pk_bf16(s[6 * 33], s[7 * 33]);
        *(u32x4*)(WT + (size_t)dstrow(mode, half, n0 + n) * K + k0 + 8 * c) = o; }
    asm volatile("s_waitcnt lgkmcnt(0)" ::: "memory");
}
__device__ __forceinline__ void dsincos(double x, double& s, double& c) {
    const double k = rint(x * 0.15915494309189535);
    const double r = (x - k * 6.283185307179586) - k * 2.4492935982947064e-16;
    const double r2 = r * r;
    double ts = 1.0, tc = 1.0, ss = 1.0, cc = 1.0;
#pragma unroll
    for (int i = 1; i <= 13; ++i) { tc = -tc * r2 / (double)((2 * i - 1) * (2 * i)); cc += tc; ts = -ts * r2 / (double)((2 * i) * (2 * i + 1)); ss += ts; }
    s = ss * r; c = cc;
}
__device__ __forceinline__ void p0_prologue(const Params& p, LAS unsigned char* lds, int bid, int tid) {
    asm volatile("" : "+v"(tid));
    const int lane = tid & 63, wave = tid >> 6;
    float* mod = (float*)(p.ws + WS_MOD);
    if (bid < 192) {
        LAS float* sc = (LAS float*)lds;
        LAS float* part = (LAS float*)(lds + 81920);
        for (int idx = tid; idx < 18 * 1024; idx += NTHR) { const int bb = idx >> 10, d = idx & 1023;
            const float c = bb < 2 ? p.in[I_CP][bb * 1024 + d] : p.in[I_CS][(bb - 2) * 1024 + d]; sc[d * 20 + bb] = c / (1.0f + __expf(-c)); }
        __syncthreads();
        const int l = bid / 48, e0 = (bid % 48) * 128, col = tid & 127, dq = tid >> 7;
        float a[18];
#pragma unroll
        for (int i = 0; i < 18; ++i) a[i] = 0.f;
        const float* wp = p.in[I_ADAW] + ((size_t)l * 1024 + dq * 256) * NADA + e0 + col;
#pragma unroll 8
        for (int d = 0; d < 256; ++d) {
            const float w = wp[(size_t)d * NADA];
            const LAS f32x4* s4 = (const LAS f32x4*)(sc + (dq * 256 + d) * 20);
            const f32x4 s0 = s4[0], s1 = s4[1], s2 = s4[2], s3 = s4[3], s5 = s4[4];
            a[0] += w * s0.x; a[1] += w * s0.y; a[2] += w * s0.z; a[3] += w * s0.w; a[4] += w * s1.x; a[5] += w * s1.y; a[6] += w * s1.z; a[7] += w * s1.w;
            a[8] += w * s2.x; a[9] += w * s2.y; a[10] += w * s2.z; a[11] += w * s2.w; a[12] += w * s3.x; a[13] += w * s3.y; a[14] += w * s3.z; a[15] += w * s3.w;
            a[16] += w * s5.x; a[17] += w * s5.y;
        }
#pragma unroll
        for (int i = 0; i < 18; ++i) part[(dq * 128 + col) * 18 + i] = a[i];
        __syncthreads();
        for (int idx = tid; idx < 128 * 18; idx += NTHR) { const int c2 = idx & 127, bb = idx >> 7;
            const float v = part[(0 * 128 + c2) * 18 + bb] + part[(1 * 128 + c2) * 18 + bb] + part[(2 * 128 + c2) * 18 + bb] + part[(3 * 128 + c2) * 18 + bb] + p.in[I_ADAB][l * NADA + e0 + c2];
            mod[((size_t)l * 18 + bb) * NADA + e0 + c2] = v; }
        __syncthreads();
    }
    {
        float* rope = (float*)(p.ws + WS_ROPE);
        for (int idx = bid * NTHR + tid; idx < SEQ * 8; idx += NWG * NTHR) { const int pos = idx >> 3, i = idx & 7;
            const double f = i == 0 ? 1.0 : i == 1 ? 0.19392274474868576 : i == 2 ? 0.03760603093086393 : i == 3 ? 0.007292664737217109 : i == 4 ? 0.001414213562373095 : i == 5 ? 0.0002742481756762073 : i == 6 ? 5.318295896944988e-05 : 1.031338537721246e-05;
            double s, c; dsincos((double)pos * f, s, c); rope[pos * 16 + i] = (float)c; rope[pos * 16 + 8 + i] = (float)s; }
    }
    {
        LAS float* scr = (LAS float*)(lds + wave * 8704);
        constexpr int I_1 = 16 * 104, I_2 = 8 * 64, I_3 = 8 * 32, I_4 = 16 * 32, I_5 = 16 * 176, I_6 = 44 * 32, I_L = I_1 + I_2 + I_3 + I_4 + I_5 + I_6;
        const int gw = bid * 8 + wave;
        for (int it = gw; it < DEPTH * I_L; it += NWG * 8) {
            const int l = it / I_L; int r = it % I_L; unsigned char* wl = p.ws + WS_W + (size_t)l * W_L;
            if (r < I_1) { transpose_item(p.in[I_WIN] + (size_t)l * D * INC, D, INC, (bf16*)(wl + W_IN), 0, 0, scr, r, lane); continue; } r -= I_1;
            if (r < I_2) { transpose_item(p.in[I_WGLU] + (size_t)l * 512 * 2048, 512, 2048, (bf16*)(wl + W_GLU), 1, 1024, scr, r, lane); continue; } r -= I_2;
            if (r < I_3) { transpose_item(p.in[I_WO] + (size_t)l * 512 * 1024, 512, 1024, (bf16*)(wl + W_O), 0, 0, scr, r, lane); continue; } r -= I_3;
            if (r < I_4) { transpose_item(p.in[I_WOUT] + (size_t)l * D * D, D, D, (bf16*)(wl + W_OUT), 0, 0, scr, r, lane); continue; } r -= I_4;
            if (r < I_5) { transpose_item(p.in[I_WUP] + (size_t)l * D * FF2, D, FF2, (bf16*)(wl + W_UP), 1, FF, scr, r, lane); continue; } r -= I_5;
            transpose_item(p.in[I_WDN] + (size_t)l * FF * D, FF, D, (bf16*)(wl + W_DN), 0, 0, scr, r, lane);
        }
    }
}

__device__ __forceinline__ void norm_phase(const Params& p, int layer, int mode, int bid, int tid) {
    asm volatile("" : "+v"(tid));
    const int lane = tid & 63, wave = tid >> 6, gw = bid * 8 + wave;
    float* X = p.out; bf16* H = (bf16*)(p.ws + WS_H);
    const float* mod = (const float*)(p.ws + WS_MOD) + (size_t)layer * 18 * NADA;
    const float* gsrc = mode == 0 ? p.in[I_N1G] + layer * D : mode == 1 ? p.in[I_N2G] + layer * D : p.in[I_FG];
    f32x4 g[4];
#pragma unroll
    for (int j = 0; j < 4; ++j) g[j] = *(const f32x4*)(gsrc + 4 * lane + 256 * j);
    if (mode == 1 && gw < 4) { const int hs = (gw & 1) + (gw >> 1) * HSEQ; unsigned* o = (unsigned*)(H + (size_t)hs * D); unsigned zz = 0u; asm volatile("" : "+v"(zz));
#pragma unroll
        for (int j = 0; j < 8; ++j) o[lane + 64 * j] = zz; }
    for (int row = gw; row < MT; row += NWG * 8) {
        const float* xr = (mode == 0 && layer == 0) ? (row < TP ? p.in[I_XP] + (size_t)row * D : p.in[I_XS] + (size_t)(row - TP) * D) : X + (size_t)row * D;
        f32x4 v[4]; float s = 0.f;
#pragma unroll
        for (int j = 0; j < 4; ++j) { v[j] = *(const f32x4*)(xr + 4 * lane + 256 * j); s += (v[j].x * v[j].x + v[j].y * v[j].y) + (v[j].z * v[j].z + v[j].w * v[j].w); }
        const float rstd = 1.0f / sqrtf(wave_sum(s) * (1.0f / D) + 1e-6f);
        if (mode == 2) {
#pragma unroll
            for (int j = 0; j < 4; ++j) *(f32x4*)(X + (size_t)row * D + 4 * lane + 256 * j) = v[j] * rstd * g[j];
        } else {
            const float* mr = mod + (size_t)modrow_of(row) * NADA + (mode == 0 ? 0 : 3072);
            size_t hrow = row;
            if (mode == 1) hrow = row < TP ? (size_t)(row >> 14) * HSEQ + 2 + (row & (SEQ - 1)) : (size_t)HS_SAMPLE + (row - TP);
#pragma unroll
            for (int j = 0; j < 4; ++j) { const f32x4 sh = *(const f32x4*)(mr + 4 * lane + 256 * j), sc = *(const f32x4*)(mr + 1024 + 4 * lane + 256 * j);
                st_bf4(H + hrow * D + 4 * lane + 256 * j, (v[j] * rstd * g[j]) * (sc + 1.0f) + sh); }
        }
    }
}

struct SsmPar { float abr, abi; float bbr[16], bbi[16]; };
__device__ __forceinline__ void ssm_disc(const Params& p, int layer, int g, int lane, float& abr, float& abi, float& fr, float& fi) {
    const int gi = (layer * 32 + g) * 64 + lane;
    const float are = p.in[I_ARE][gi], aim = p.in[I_AIM][gi], dt = expf(p.in[I_LDT][layer * 32 + g]);
    const float mag = expf(are * dt); float sn, cs; sincosf(aim * dt, &sn, &cs);
    abr = mag * cs; abi = mag * sn;
    const float nr = abr - 1.0f, ni = abi, den = are * are + aim * aim;
    fr = (nr * are + ni * aim) / den; fi = (ni * are - nr * aim) / den;
}
__device__ __forceinline__ void ssm_task(const Params& p, int layer, int mode, int sq, int g, int chunk, int lane, LAS unsigned char* wl) {
    LAS float* ul = (LAS float*)wl;
    LAS bf16* Sl = (LAS bf16*)(wl + 4096);
    float abr, abi, fr, fi; ssm_disc(p, layer, g, lane, abr, abi, fr, fi);
    typedef float f32x2 __attribute__((ext_vector_type(2)));
    f32x2 bb[16];
    { const size_t bo = (((size_t)layer * 32 + g) * 64 + lane) * 16;
#pragma unroll
      for (int c4 = 0; c4 < 4; ++c4) { const f32x4 br = *(const f32x4*)(p.in[I_BRE] + bo + 4 * c4), bi = *(const f32x4*)(p.in[I_BIM] + bo + 4 * c4);
#pragma unroll
          for (int e = 0; e < 4; ++e) { bb[4 * c4 + e].x = fr * br[e] - fi * bi[e]; bb[4 * c4 + e].y = fr * bi[e] + fi * br[e]; } } }
    const bool cproj = mode != 0;
    const int g4 = lane >> 4, cl = lane & 15;
    bf16x8 cf[4];
    float dsk = 0.f;
    if (cproj) {
        const size_t co = (((size_t)layer * 32 + g) * 16 + cl) * 64;
#pragma unroll
        for (int ks = 0; ks < 4; ++ks) { const float* src = (ks < 2 ? p.in[I_CRE] : p.in[I_CIM]) + co + 32 * (ks & 1) + 8 * g4; const float sg = ks < 2 ? 1.0f : -1.0f;
            const f32x4 a = *(const f32x4*)src, b = *(const f32x4*)(src + 4);
            u32x4 o; o.x = cvt_pk_bf16(sg * a.x, sg * a.y); o.y = cvt_pk_bf16(sg * a.z, sg * a.w); o.z = cvt_pk_bf16(sg * b.x, sg * b.y); o.w = cvt_pk_bf16(sg * b.z, sg * b.w);
            cf[ks] = __builtin_bit_cast(bf16x8, o); }
        dsk = p.in[I_SD][layer * 512 + g * 16 + cl];
    }
    const int nsteps = mode == 1 ? 16 : 64;
    const size_t r0 = mode == 1 ? (size_t)TP + sq * 16 : (size_t)sq * SEQ + chunk * 64;
    const float* U = (const float*)(p.ws + WS_U);
#pragma unroll
    for (int i = 0; i < 4; ++i) { const int idx = lane + 64 * i; if (idx < nsteps * 4) { const int t = idx >> 2, c4 = idx & 3; *(LAS f32x4*)(ul + t * 16 + 4 * c4) = *(const f32x4*)(U + (r0 + t) * 512 + g * 16 + 4 * c4); } }
    float sr = 0.f, si = 0.f;
    float* CH = (float*)(p.ws + WS_CH);
    const size_t cho = (((size_t)(sq * 32 + g)) * 256 + chunk) * 128;
    if (mode == 1) { const size_t so = (((size_t)layer * 16 + sq) * 32 + g) * 64 + lane; sr = p.in[I_SRE][so]; si = p.in[I_SIM][so]; }
    else if (mode == 2) { sr = CH[cho + lane]; si = CH[cho + 64 + lane]; }
    asm volatile("s_waitcnt vmcnt(0) lgkmcnt(0)" ::: "memory"); __builtin_amdgcn_wave_barrier();
    bf16* Yg = (bf16*)(p.ws + WS_YG);
    for (int hh = 0; hh * 32 < nsteps; ++hh) {
        const int ns = nsteps - hh * 32 < 32 ? nsteps - hh * 32 : 32;
#pragma unroll 4
        for (int t = 0; t < ns; ++t) {
            const LAS f32x4* up = (const LAS f32x4*)(ul + (hh * 32 + t) * 16);
            const f32x4 u0 = up[0], u1 = up[1], u2 = up[2], u3 = up[3];
            f32x2 xa = (f32x2){0.f, 0.f}, xb = (f32x2){0.f, 0.f};
#pragma unroll
            for (int e = 0; e < 4; ++e) { xa = bb[e] * (f32x2){u0[e], u0[e]} + xa; xb = bb[4 + e] * (f32x2){u1[e], u1[e]} + xb; }
#pragma unroll
            for (int e = 0; e < 4; ++e) { xa = bb[8 + e] * (f32x2){u2[e], u2[e]} + xa; xb = bb[12 + e] * (f32x2){u3[e], u3[e]} + xb; }
            const float xr = xa.x + xb.x, xi = xa.y + xb.y;
            const float nsr = fmaf(abr, sr, fmaf(-abi, si, xr)), nsi = fmaf(abr, si, fmaf(abi, sr, xi));
            sr = nsr; si = nsi;
            if (cproj) { Sl[t * 136 + lane] = (bf16)f2bf(sr); Sl[t * 136 + 64 + lane] = (bf16)f2bf(si); }
        }
        if (cproj) {
            asm volatile("s_waitcnt lgkmcnt(0)" ::: "memory"); __builtin_amdgcn_wave_barrier();
#pragma unroll
            for (int mt = 0; mt < 2; ++mt) {
                f32x4 ya = (f32x4){0.f, 0.f, 0.f, 0.f};
#pragma unroll
                for (int ks = 0; ks < 4; ++ks) { const bf16x8 a = *(const LAS bf16x8*)(Sl + (16 * mt + cl) * 136 + 32 * ks + 8 * g4); ya = __builtin_amdgcn_mfma_f32_16x16x32_bf16(a, cf[ks], ya, 0, 0, 0); }
#pragma unroll
                for (int i = 0; i < 4; ++i) { const int t = 16 * mt + 4 * g4 + i;
                    if (t < ns) { const float y = ya[i] + dsk * ul[(hh * 32 + t) * 16 + cl]; Yg[(r0 + hh * 32 + t) * 512 + g * 16 + cl] = (bf16)f2bf(gelu_tanh(y)); } }
            }
            asm volatile("s_waitcnt lgkmcnt(0)" ::: "memory"); __builtin_amdgcn_wave_barrier();
        }
    }
    if (mode == 0) { CH[cho + lane] = sr; CH[cho + 64 + lane] = si; }
    else if (mode == 1) { const size_t so = (((size_t)layer * 16 + sq) * 32 + g) * 64 + lane; p.out[O_SRS + so] = sr; p.out[O_SIS + so] = si; }
    else if (chunk == 255) { const size_t so = (((size_t)layer * 2 + sq) * 32 + g) * 64 + lane; p.out[O_SRP + so] = sr; p.out[O_SIP + so] = si; }
    asm volatile("s_waitcnt lgkmcnt(0)" ::: "memory"); __builtin_amdgcn_wave_barrier();
}
__device__ __forceinline__ void split_hl(f32x4 a, f32x4 c, u32x4& hi, u32x4& lo) {
    hi.x = cvt_pk_bf16(a.x, a.y); hi.y = cvt_pk_bf16(a.z, a.w); hi.z = cvt_pk_bf16(c.x, c.y); hi.w = cvt_pk_bf16(c.z, c.w);
    lo.x = cvt_pk_bf16(a.x - __uint_as_float(hi.x << 16), a.y - __uint_as_float(hi.x & 0xffff0000u)); lo.y = cvt_pk_bf16(a.z - __uint_as_float(hi.y << 16), a.w - __uint_as_float(hi.y & 0xffff0000u));
    lo.z = cvt_pk_bf16(c.x - __uint_as_float(hi.z << 16), c.y - __uint_as_float(hi.z & 0xffff0000u)); lo.w = cvt_pk_bf16(c.z - __uint_as_float(hi.w << 16), c.w - __uint_as_float(hi.w & 0xffff0000u));
}
__device__ __forceinline__ void ssm_task_v2(const Params& p, int layer, int mode, int sq, int g, int chunk0, int nchunk, int cstride, int lane, LAS unsigned char* wl) {
    LAS float* Xl = (LAS float*)wl;
    LAS bf16* Sl = (LAS bf16*)(wl + 8448);
    const int g4 = lane >> 4, cl = lane & 15;
    float abr, abi, fr, fi; ssm_disc(p, layer, g, lane, abr, abi, fr, fi);
    bf16x8 bfr[8];
    const int gg = g4 & 1;
#pragma unroll
    for (int q = 0; q < 4; ++q) {
        const int st = 16 * q + cl;
        const float frs = __shfl(fr, st), fis = __shfl(fi, st);
        const size_t bo = (((size_t)layer * 32 + g) * 64 + st) * 16 + 8 * gg;
        const f32x4 r0 = *(const f32x4*)(p.in[I_BRE] + bo), r1 = *(const f32x4*)(p.in[I_BRE] + bo + 4), i0 = *(const f32x4*)(p.in[I_BIM] + bo), i1 = *(const f32x4*)(p.in[I_BIM] + bo + 4);
        const f32x4 a0 = frs * r0 - fis * i0, a1 = frs * r1 - fis * i1, c0 = frs * i0 + fis * r0, c1 = frs * i1 + fis * r1;
        u32x4 hre, him;
        hre.x = cvt_pk_bf16(a0.x, a0.y); hre.y = cvt_pk_bf16(a0.z, a0.w); hre.z = cvt_pk_bf16(a1.x, a1.y); hre.w = cvt_pk_bf16(a1.z, a1.w);
        him.x = cvt_pk_bf16(c0.x, c0.y); him.y = cvt_pk_bf16(c0.z, c0.w); him.z = cvt_pk_bf16(c1.x, c1.y); him.w = cvt_pk_bf16(c1.z, c1.w);
        if (g4 >= 2) { hre = (u32x4){0u, 0u, 0u, 0u}; him = hre; }
        bfr[q] = __builtin_bit_cast(bf16x8, hre); bfr[4 + q] = __builtin_bit_cast(bf16x8, him);
    }
    const bool cproj = mode != 0;
    bf16x8 cf[4];
    float dsk = 0.f;
    if (cproj) {
        const size_t co = (((size_t)layer * 32 + g) * 16 + cl) * 64;
#pragma unroll
        for (int ks = 0; ks < 4; ++ks) { const float* src = (ks < 2 ? p.in[I_CRE] : p.in[I_CIM]) + co + 32 * (ks & 1) + 8 * g4; const float sg = ks < 2 ? 1.0f : -1.0f;
            const f32x4 a = *(const f32x4*)src, c = *(const f32x4*)(src + 4);
            u32x4 o; o.x = cvt_pk_bf16(sg * a.x, sg * a.y); o.y = cvt_pk_bf16(sg * a.z, sg * a.w); o.z = cvt_pk_bf16(sg * c.x, sg * c.y); o.w = cvt_pk_bf16(sg * c.z, sg * c.w);
            cf[ks] = __builtin_bit_cast(bf16x8, o); }
        dsk = p.in[I_SD][layer * 512 + g * 16 + cl];
    }
    const int nblk = mode == 1 ? 1 : 4;
    bf16* Yg = (bf16*)(p.ws + WS_YG);
    const bf16* U = (const bf16*)(p.ws + WS_U);
    float* CH = (float*)(p.ws + WS_CH);
    float sr = 0.f, si = 0.f;
    if (mode == 1) { const size_t so = (((size_t)layer * 16 + sq) * 32 + g) * 64 + lane; sr = p.in[I_SRE][so]; si = p.in[I_SIM][so]; }
    else if (mode == 2) { const size_t cso = (((size_t)(sq * 32 + g)) * 32 + (chunk0 >> 3)) * 128; sr = CH[cso + lane]; si = CH[cso + 64 + lane]; }
    for (int ci = 0; ci < nchunk; ++ci) {
    const int chunk = chunk0 + ci * cstride;
    const unsigned r0 = mode == 1 ? (unsigned)(TP + sq * 16) : (unsigned)(sq * SEQ + chunk * 64);
    u32x4 ulq[4];
#pragma unroll
    for (int blk = 0; blk < 4; ++blk) if (blk < nblk) {
        ulq[blk] = *(const u32x4*)(U + (r0 + 16 * blk + cl) * 512u + g * 16 + 8 * gg);
    }
#pragma unroll
    for (int blk = 0; blk < 4; ++blk) if (blk < nblk) {
        u32x4 ua;
        ua = g4 < 2 ? ulq[blk] : (u32x4){0u, 0u, 0u, 0u};
        float ud[4];
        if (cproj) {
#pragma unroll
            for (int i = 0; i < 4; ++i) ud[i] = bf2f(U[(r0 + 16 * blk + 4 * g4 + i) * 512u + g * 16 + cl]);
        }
        const bf16x8 uf = __builtin_bit_cast(bf16x8, ua);
        f32x4 xs[8];
#pragma unroll
        for (int nt = 0; nt < 8; ++nt) {
            xs[nt] = __builtin_amdgcn_mfma_f32_16x16x32_bf16(uf, bfr[nt], (f32x4){0.f, 0.f, 0.f, 0.f}, 0, 0, 0);
        }
        __builtin_amdgcn_sched_barrier(0); asm volatile("s_nop 15\n\ts_nop 15" ::: "memory"); __builtin_amdgcn_sched_barrier(0);
#pragma unroll
        for (int nt = 0; nt < 8; ++nt) {
#pragma unroll
            for (int i = 0; i < 4; ++i) Xl[(4 * g4 + i) * 132 + 16 * nt + cl] = xs[nt][i];
        }
        asm volatile("s_waitcnt lgkmcnt(0)" ::: "memory"); __builtin_amdgcn_wave_barrier();
        float xrv[16], xiv[16];
#pragma unroll
        for (int t = 0; t < 16; ++t) { xrv[t] = Xl[t * 132 + lane]; xiv[t] = Xl[t * 132 + 64 + lane]; }
        asm volatile("s_waitcnt lgkmcnt(0)" ::: "memory");
#pragma unroll
        for (int t = 0; t < 16; ++t) {
            const float nsr = fmaf(abr, sr, fmaf(-abi, si, xrv[t])), nsi = fmaf(abr, si, fmaf(abi, sr, xiv[t]));
            sr = nsr; si = nsi;
            if (cproj) { const unsigned pk = cvt_pk_bf16(sr, si); Sl[t * 136 + lane] = (bf16)(pk & 0xffffu); Sl[t * 136 + 64 + lane] = (bf16)(pk >> 16); }
        }
        if (cproj) {
            asm volatile("s_waitcnt lgkmcnt(0)" ::: "memory"); __builtin_amdgcn_wave_barrier();
            f32x4 ya = (f32x4){0.f, 0.f, 0.f, 0.f};
#pragma unroll
            for (int ks = 0; ks < 4; ++ks) { const bf16x8 a = *(const LAS bf16x8*)(Sl + cl * 136 + 32 * ks + 8 * g4); ya = __builtin_amdgcn_mfma_f32_16x16x32_bf16(a, cf[ks], ya, 0, 0, 0); }
#pragma unroll
            for (int i = 0; i < 4; ++i) { const float y = ya[i] + dsk * ud[i]; Yg[(r0 + 16 * blk + 4 * g4 + i) * 512u + g * 16 + cl] = (bf16)f2bf(gelu_tanh(y)); }
        }
        asm volatile("s_waitcnt lgkmcnt(0)" ::: "memory"); __builtin_amdgcn_wave_barrier();
    }
    if (mode == 1) { const size_t so = (((size_t)layer * 16 + sq) * 32 + g) * 64 + lane; p.out[O_SRS + so] = sr; p.out[O_SIS + so] = si; }
    else if (chunk == 255) { const size_t so = (((size_t)layer * 2 + sq) * 32 + g) * 64 + lane; p.out[O_SRP + so] = sr; p.out[O_SIP + so] = si; }
    }
}
__device__ __forceinline__ void ssm_pass1_fast(const Params& p, int layer, int sq, int g, int chunk0, int nchunk, int cstride, int lane) {
    const int g4 = lane >> 4, cl = lane & 15, gg = g4 & 1;
    float abr, abi, fr, fi; ssm_disc(p, layer, g, lane, abr, abi, fr, fi);
    bf16x8 bfr[8];
    float ar[4], ai[4], Ar[4], Ai[4], wr_[4], wi_[4];
#pragma unroll
    for (int q = 0; q < 4; ++q) {
        const int st = 16 * q + cl;
        const float frs = __shfl(fr, st), fis = __shfl(fi, st);
        ar[q] = __shfl(abr, st); ai[q] = __shfl(abi, st);
        const size_t bo = (((size_t)layer * 32 + g) * 64 + st) * 16 + 8 * gg;
        const f32x4 r0 = *(const f32x4*)(p.in[I_BRE] + bo), r1 = *(const f32x4*)(p.in[I_BRE] + bo + 4), i0 = *(const f32x4*)(p.in[I_BIM] + bo), i1 = *(const f32x4*)(p.in[I_BIM] + bo + 4);
        const f32x4 a0 = frs * r0 - fis * i0, a1 = frs * r1 - fis * i1, c0 = frs * i0 + fis * r0, c1 = frs * i1 + fis * r1;
        u32x4 hre, him;
        hre.x = cvt_pk_bf16(a0.x, a0.y); hre.y = cvt_pk_bf16(a0.z, a0.w); hre.z = cvt_pk_bf16(a1.x, a1.y); hre.w = cvt_pk_bf16(a1.z, a1.w);
        him.x = cvt_pk_bf16(c0.x, c0.y); him.y = cvt_pk_bf16(c0.z, c0.w); him.z = cvt_pk_bf16(c1.x, c1.y); him.w = cvt_pk_bf16(c1.z, c1.w);
        if (g4 >= 2) { hre = (u32x4){0u, 0u, 0u, 0u}; him = hre; }
        bfr[q] = __builtin_bit_cast(bf16x8, hre); bfr[4 + q] = __builtin_bit_cast(bf16x8, him);
        const float a2r = ar[q] * ar[q] - ai[q] * ai[q], a2i = 2.0f * ar[q] * ai[q];
        const float a4r = a2r * a2r - a2i * a2i, a4i = 2.0f * a2r * a2i;
        const float a8r = a4r * a4r - a4i * a4i, a8i = 2.0f * a4r * a4i;
        Ar[q] = a8r * a8r - a8i * a8i; Ai[q] = 2.0f * a8r * a8i;
        const float a12r = a8r * a4r - a8i * a4i, a12i = a8r * a4i + a8i * a4r;
        wr_[q] = g4 == 3 ? 1.0f : g4 == 2 ? a4r : g4 == 1 ? a8r : a12r;
        wi_[q] = g4 == 3 ? 0.0f : g4 == 2 ? a4i : g4 == 1 ? a8i : a12i;
    }
    const bf16* U = (const bf16*)(p.ws + WS_U);
    float* CH = (float*)(p.ws + WS_CH);
    float accr[4] = {0.f, 0.f, 0.f, 0.f}, acci[4] = {0.f, 0.f, 0.f, 0.f};
    u32x4 unx[4];
#pragma unroll
    for (int blk = 0; blk < 4; ++blk) unx[blk] = *(const u32x4*)(U + ((unsigned)(sq * SEQ + chunk0 * 64) + 16 * blk + cl) * 512u + g * 16 + 8 * gg);
    for (int ci = 0; ci < nchunk; ++ci) {
        const int chunk = chunk0 + ci * cstride;
        u32x4 ulq[4];
#pragma unroll
        for (int blk = 0; blk < 4; ++blk) ulq[blk] = unx[blk];
        if (ci + 1 < nchunk) {
#pragma unroll
            for (int blk = 0; blk < 4; ++blk) unx[blk] = *(const u32x4*)(U + ((unsigned)(sq * SEQ + (chunk + cstride) * 64) + 16 * blk + cl) * 512u + g * 16 + 8 * gg);
        }
#pragma unroll
        for (int blk = 0; blk < 4; ++blk) {
            const bf16x8 uf = __builtin_bit_cast(bf16x8, g4 < 2 ? ulq[blk] : (u32x4){0u, 0u, 0u, 0u});
#pragma unroll
            for (int q = 0; q < 4; ++q) {
                const f32x4 xr = __builtin_amdgcn_mfma_f32_16x16x32_bf16(uf, bfr[q], (f32x4){0.f, 0.f, 0.f, 0.f}, 0, 0, 0);
                const f32x4 xi = __builtin_amdgcn_mfma_f32_16x16x32_bf16(uf, bfr[4 + q], (f32x4){0.f, 0.f, 0.f, 0.f}, 0, 0, 0);
                float er = xr[0], ei = xi[0];
#pragma unroll
                for (int i = 1; i < 4; ++i) { const float nr = fmaf(ar[q], er, fmaf(-ai[q], ei, xr[i])), ni = fmaf(ar[q], ei, fmaf(ai[q], er, xi[i])); er = nr; ei = ni; }
                const float nr = fmaf(Ar[q], accr[q], fmaf(-Ai[q], acci[q], er)), ni = fmaf(Ar[q], acci[q], fmaf(Ai[q], accr[q], ei));
                accr[q] = nr; acci[q] = ni;
            }
        }
    }
    {
        float outr = 0.f, outi = 0.f;
#pragma unroll
        for (int q = 0; q < 4; ++q) {
            float zr = wr_[q] * accr[q] - wi_[q] * acci[q], zi = wr_[q] * acci[q] + wi_[q] * accr[q];
            zr += __shfl_xor(zr, 16); zr += __shfl_xor(zr, 32); zi += __shfl_xor(zi, 16); zi += __shfl_xor(zi, 32);
            if (g4 == q) { outr = zr; outi = zi; }
        }
        const size_t cho = (((size_t)(sq * 32 + g)) * 32 + (chunk0 >> 3)) * 128;
        CH[cho + lane] = outr; CH[cho + 64 + lane] = outi;
    }
}
__device__ __forceinline__ void ssm_phase(const Params& p, int layer, int pass3, LAS unsigned char* lds, int bid, int tid) {
    asm volatile("" : "+v"(tid));
    const int lane = tid & 63, wave = tid >> 6; LAS unsigned char* wl = lds + wave * 12800;
    const int gw = bid * 8 + wave;
    { const int sqg = gw >> 5;
      if (pass3) ssm_task_v2(p, layer, 2, sqg >> 5, sqg & 31, 8 * (gw & 31), 8, 1, lane, wl);
      else ssm_pass1_fast(p, layer, sqg >> 5, sqg & 31, 8 * (gw & 31), 8, 1, lane); }
    if (!pass3 && gw >= 1536) { const int sg = gw - 1536; ssm_task_v2(p, layer, 1, sg >> 5, sg & 31, 0, 1, 1, lane, wl); }
}
__device__ __forceinline__ void carry_phase(const Params& p, int layer, int bid, int tid) {
    asm volatile("" : "+v"(tid));
    const int lane = tid & 63, wave = tid >> 6, gw = bid * 8 + wave;
    if (gw >= 64) return;
    float abr, abi, fr, fi; ssm_disc(p, layer, gw & 31, lane, abr, abi, fr, fi);
    float ar = abr, ai = abi;
#pragma unroll
    for (int i = 0; i < 9; ++i) { const float nr = ar * ar - ai * ai, ni = 2.0f * ar * ai; ar = nr; ai = ni; }
    float* CH = (float*)(p.ws + WS_CH) + (size_t)gw * 32 * 128;
    float cr = 0.f, ci = 0.f;
    float fr8[32], fi8[32];
#pragma unroll
    for (int j = 0; j < 32; ++j) { fr8[j] = CH[j * 128 + lane]; fi8[j] = CH[j * 128 + 64 + lane]; }
#pragma unroll
    for (int j = 0; j < 32; ++j) { CH[j * 128 + lane] = cr; CH[j * 128 + 64 + lane] = ci;
        const float nr = fmaf(ar, cr, fmaf(-ai, ci, fr8[j])), ni = fmaf(ar, ci, fmaf(ai, cr, fi8[j])); cr = nr; ci = ni; }
}

__device__ __forceinline__ void attn_phase(const Params& p, int layer, LAS unsigned char* lds, int bid, int tid) {
    asm volatile("" : "+v"(tid));
    const int lane = tid & 63, wave = tid >> 6, g4 = lane >> 4, cl = lane & 15;
    LAS bf16* Kl = (LAS bf16*)lds;
    LAS bf16* Vt = (LAS bf16*)(lds + 27648);
    const bf16* Qb = (const bf16*)(p.ws + WS_Q); const bf16* Kb = (const bf16*)(p.ws + WS_K); const bf16* Vb = (const bf16*)(p.ws + WS_V);
    bf16* Ob = (bf16*)(p.ws + WS_O);
    u32x4 pk[3], pv[3];
#define ATT_LOAD(TKX) do { const int tk_ = (TKX); const bool smp_ = tk_ >= 1024; \
        const int b_ = smp_ ? (tk_ - 1024) >> 1 : tk_ >> 9, n_ = smp_ ? 0 : (tk_ >> 1) & 255, kvh_ = tk_ & 1; \
        _Pragma("unroll") for (int i = 0; i < 3; ++i) { \
            const int idx = tid + NTHR * i, key = idx >> 3, c8 = idx & 7; \
            u32x4 kv = (u32x4){0u, 0u, 0u, 0u}, vv = (u32x4){0u, 0u, 0u, 0u}; \
            if (!smp_) { \
                const int pos = 64 * (n_ - 2) + key; \
                if (pos >= 0) { const size_t o = ((size_t)b_ * SEQ + pos) * 128 + kvh_ * 64 + 8 * c8; kv = *(const u32x4*)(Kb + o); vv = *(const u32x4*)(Vb + o); } \
            } else if (key < 128) { \
                const size_t o = ((((size_t)layer * 16 + b_) * 128 + key) * 2 + kvh_) * 64 + 8 * c8; \
                const f32x4 k0 = *(const f32x4*)(p.in[I_CK] + o), k1 = *(const f32x4*)(p.in[I_CK] + o + 4), v0 = *(const f32x4*)(p.in[I_CV] + o), v1 = *(const f32x4*)(p.in[I_CV] + o + 4); \
                kv.x = cvt_pk_bf16(k0.x, k0.y); kv.y = cvt_pk_bf16(k0.z, k0.w); kv.z = cvt_pk_bf16(k1.x, k1.y); kv.w = cvt_pk_bf16(k1.z, k1.w); \
                vv.x = cvt_pk_bf16(v0.x, v0.y); vv.y = cvt_pk_bf16(v0.z, v0.w); vv.z = cvt_pk_bf16(v1.x, v1.y); vv.w = cvt_pk_bf16(v1.z, v1.w); \
            } else if (key < 144) { \
                const size_t o = ((size_t)TP + b_ * 16 + (key - 128)) * 128 + kvh_ * 64 + 8 * c8; kv = *(const u32x4*)(Kb + o); vv = *(const u32x4*)(Vb + o); \
            } \
            pk[i] = kv; pv[i] = vv; } } while (0)
    ATT_LOAD(bid);
    for (int tk = bid; tk < 1024 + 32; tk += NWG) {
        const bool smp = tk >= 1024;
        const int b = smp ? (tk - 1024) >> 1 : tk >> 9, n = smp ? 0 : (tk >> 1) & 255, kvh = tk & 1;
        __syncthreads();
#pragma unroll
        for (int i = 0; i < 3; ++i) {
            const int idx = tid + NTHR * i, key = idx >> 3, c8 = idx & 7;
            const u32x4 kv = pk[i], vv = pv[i];
            *(LAS u32x4*)(Kl + key * 72 + 8 * c8) = kv;
            LAS bf16* vd = Vt + (8 * c8) * 200 + key;
            vd[0] = (bf16)(vv.x & 0xffffu); vd[200] = (bf16)(vv.x >> 16); vd[400] = (bf16)(vv.y & 0xffffu); vd[600] = (bf16)(vv.y >> 16);
            vd[800] = (bf16)(vv.z & 0xffffu); vd[1000] = (bf16)(vv.z >> 16); vd[1200] = (bf16)(vv.w & 0xffffu); vd[1400] = (bf16)(vv.w >> 16);
        }
        __syncthreads();
        if (tk + NWG < 1024 + 32) ATT_LOAD(tk + NWG);
        const int gh = wave & 3, qh = wave >> 2, h = kvh * 4 + gh;
        if (smp && qh == 1) continue;
        const int nq = smp ? 16 : 32;
        const size_t qrow0 = smp ? (size_t)TP + b * 16 : (size_t)b * SEQ + 64 * n + 32 * qh;
        bf16x8 qf[2][2];
#pragma unroll
        for (int nt = 0; nt < 2; ++nt) { int qi = 16 * nt + cl; if (qi >= nq) qi = nq - 1;
#pragma unroll
            for (int ks = 0; ks < 2; ++ks) qf[nt][ks] = *(const bf16x8*)(Qb + (qrow0 + qi) * 512 + h * 64 + 32 * ks + 8 * g4); }
        f32x4 s[12][2];
#pragma unroll
        for (int mt = 0; mt < 12; ++mt) {
            s[mt][0] = (f32x4){0.f, 0.f, 0.f, 0.f}; s[mt][1] = (f32x4){0.f, 0.f, 0.f, 0.f};
#pragma unroll
            for (int ks = 0; ks < 2; ++ks) { const bf16x8 a = *(const LAS bf16x8*)(Kl + (16 * mt + cl) * 72 + 32 * ks + 8 * g4);
                s[mt][0] = __builtin_amdgcn_mfma_f32_16x16x32_bf16(a, qf[0][ks], s[mt][0], 0, 0, 0);
                s[mt][1] = __builtin_amdgcn_mfma_f32_16x16x32_bf16(a, qf[1][ks], s[mt][1], 0, 0, 0); }
            const bool valid = smp ? (mt < 9) : (n - 2 + (mt >> 2) >= 0);
            if (!valid) { s[mt][0] = (f32x4){-1e30f, -1e30f, -1e30f, -1e30f}; s[mt][1] = s[mt][0]; }
        }
        const float sink = p.in[I_SINK][layer * 8 + h];
        float inv[2];
#pragma unroll
        for (int nt = 0; nt < 2; ++nt) {
            float mx = sink;
#pragma unroll
            for (int mt = 0; mt < 12; ++mt) mx = fmaxf(mx, fmaxf(fmaxf(s[mt][nt].x, s[mt][nt].y), fmaxf(s[mt][nt].z, s[mt][nt].w)));
            mx = fmaxf(mx, __shfl_xor(mx, 16)); mx = fmaxf(mx, __shfl_xor(mx, 32));
            float sum = 0.f;
#pragma unroll
            for (int mt = 0; mt < 12; ++mt) {
#pragma unroll
                for (int e = 0; e < 4; ++e) { const float pe = __expf(s[mt][nt][e] - mx); s[mt][nt][e] = pe; sum += pe; } }
            sum += __shfl_xor(sum, 16); sum += __shfl_xor(sum, 32);
            inv[nt] = 1.0f / (sum + __expf(sink - mx));
        }
        f32x4 o[4][2];
#pragma unroll
        for (int dt = 0; dt < 4; ++dt) { o[dt][0] = (f32x4){0.f, 0.f, 0.f, 0.f}; o[dt][1] = (f32x4){0.f, 0.f, 0.f, 0.f}; }
#pragma unroll
        for (int ks = 0; ks < 6; ++ks) {
            bf16x8 pf[2];
#pragma unroll
            for (int nt = 0; nt < 2; ++nt) { u32x4 t; t.x = cvt_pk_bf16(s[2 * ks][nt].x, s[2 * ks][nt].y); t.y = cvt_pk_bf16(s[2 * ks][nt].z, s[2 * ks][nt].w);
                t.z = cvt_pk_bf16(s[2 * ks + 1][nt].x, s[2 * ks + 1][nt].y); t.w = cvt_pk_bf16(s[2 * ks + 1][nt].z, s[2 * ks + 1][nt].w); pf[nt] = __builtin_bit_cast(bf16x8, t); }
#pragma unroll
            for (int dt = 0; dt < 4; ++dt) {
                const LAS bf16* vp = Vt + (16 * dt + cl) * 200 + 32 * ks + 4 * g4;
                const u32x2 lo = *(const LAS u32x2*)vp, hi = *(const LAS u32x2*)(vp + 16);
                const bf16x8 a = __builtin_bit_cast(bf16x8, (u32x4){lo.x, lo.y, hi.x, hi.y});
                o[dt][0] = __builtin_amdgcn_mfma_f32_16x16x32_bf16(a, pf[0], o[dt][0], 0, 0, 0);
                o[dt][1] = __builtin_amdgcn_mfma_f32_16x16x32_bf16(a, pf[1], o[dt][1], 0, 0, 0);
            }
        }
#pragma unroll
        for (int nt = 0; nt < 2; ++nt) { const int qi = 16 * nt + cl;
            if (qi < nq) {
#pragma unroll
                for (int dt = 0; dt < 4; ++dt) st_bf4(Ob + (qrow0 + qi) * 512 + h * 64 + 16 * dt + 4 * g4, o[dt][nt] * inv[nt]); } }
    }
    __syncthreads();
}

__global__ void __launch_bounds__(512, 2) fwd(Params p) {
    extern __shared__ __attribute__((aligned(16))) unsigned char lds_raw[];
    LAS unsigned char* lds = (LAS unsigned char*)lds_raw;
    cg::grid_group grid = cg::this_grid();
    const int bid = blockIdx.x, tid = threadIdx.x, G = gridDim.x;
    unsigned char* ws = p.ws;
    float* X = p.out;
    bf16* H = (bf16*)(ws + WS_H);
    const float* modall = (const float*)(ws + WS_MOD);
    if (tid < 16) ((volatile LAS unsigned*)(lds + MISC_OFF))[tid] = 0u;
    __syncthreads();
    const xb::XcdBarrier bar = xb::xcd_barrier_post((unsigned*)(ws + WS_BAR), (volatile LAS unsigned*)(lds + MISC_OFF));
#define GSYNC() xb::xcd_barrier(bar)

#if !defined(ONLY) || ONLY == 0
    REPK(10) { p0_prologue(p, lds, bid, tid); if (PROBE == 10) { asm volatile("s_waitcnt vmcnt(0) lgkmcnt(0)" ::: "memory"); __syncthreads(); } }
    if (PROBE == 7 || PROBE == 8) { float* zr = (float*)(ws + WS_ZERO); for (int i = bid * NTHR + tid; i < 18 * NADA; i += NWG * NTHR) zr[i] = 0.f; }
#endif
    grid.sync();
    for (int layer = 0; layer < DEPTH; ++layer) {
        unsigned char* wl = ws + WS_W + (size_t)layer * W_L;
        const float* modl = modall + (size_t)layer * 18 * NADA;
#if !defined(ONLY) || ONLY == 1
        REPK(4) norm_phase(p, layer, 0, bid, tid);
#endif
        GSYNC();
#if !defined(ONLY) || ONLY == 2
        REPK(1) { Gemm g{H, (const bf16*)(wl + W_IN), MT, INC, D}; StaticOrder S; S.init(MT, INC, G, bid);
          EpiWin E{(bf16*)(ws + WS_U), (bf16*)(ws + WS_Q), (bf16*)(ws + WS_K), (bf16*)(ws + WS_V), (bf16*)(ws + WS_G), (const float*)(ws + WS_ROPE), p.out, layer};
          pg8::gemm_phase<EpiWin, StaticOrder, 0>(lds, g, S, E, nullptr); }
        GSYNC();
#endif
#if !defined(ONLY) || ONLY == 3
        REPK(2) ssm_phase(p, layer, 0, lds, bid, tid);
#endif
#if !defined(ONLY) || ONLY == 4
        REPK(3) attn_phase(p, layer, lds, bid, tid);
#endif
        GSYNC();
#if !defined(ONLY) || ONLY == 5
        carry_phase(p, layer, bid, tid);
        REPK(9) { Gemm g{(const bf16*)(ws + WS_O), (const bf16*)(wl + W_O), TP, D, 512}; StaticOrder S; S.init(TP, D, G, bid);
          EpiAttnO E{(const bf16*)(ws + WS_G), (bf16*)(ws + WS_P)};
          pg8::gemm_phase<EpiAttnO, StaticOrder, 0>(lds, g, S, E, nullptr);
          small_gemm<4>(g.A + (size_t)TP * 512, g.Bt, D, 512, TP, E, lds, bid, tid); }
        GSYNC();
#endif
#if !defined(ONLY) || ONLY == 3
        REPK(2) ssm_phase(p, layer, 1, lds, bid, tid);
#endif
        GSYNC();
#if !defined(ONLY) || ONLY == 6
        { Gemm g{(const bf16*)(ws + WS_YG), (const bf16*)(wl + W_GLU), TP, 2048, 512}; StaticOrder S; S.init(TP, 2048, G, bid);
          EpiGlu E{(const bf16*)(ws + WS_G), (bf16*)(ws + WS_P)};
          pg8::gemm_phase<EpiGlu, StaticOrder, 0>(lds, g, S, E, nullptr);
          small_gemm<2>(g.A + (size_t)TP * 512, g.Bt, 2048, 512, TP, E, lds, bid, tid); }
        GSYNC();
#endif
#if !defined(ONLY) || ONLY == 7
        { Gemm g{(const bf16*)(ws + WS_P), (const bf16*)(wl + W_OUT), TP, D, D}; StaticOrder S; S.init(TP, D, G, bid);
          EpiRes E{layer == 0 ? p.in[I_XP] : X, X, modl + 2048};
          pg8::gemm_phase<EpiRes, StaticOrder, 0>(lds, g, S, E, nullptr);
          EpiRes Es{layer == 0 ? p.in[I_XS] - (size_t)TP * D : X, X, modl + 2048};
          small_gemm<4>(g.A + (size_t)TP * D, g.Bt, D, D, TP, Es, lds, bid, tid); }
        GSYNC();
#endif
#if !defined(ONLY) || ONLY == 1
        REPK(4) norm_phase(p, layer, 1, bid, tid);
#endif
        GSYNC();
#if !defined(ONLY) || ONLY == 9
        REPK(5) { Gemm g{H, (const bf16*)(wl + W_UP), UP_TILES * 256, FF2, D}; StaticOrder S; S.init(UP_TILES * 256, FF2, G, bid);
          EpiUp<false> E{(bf16*)(ws + WS_ACT), p.in[I_CW] + (size_t)layer * 3 * FF2, p.in[I_CB] + (size_t)layer * FF2, nullptr, p.out, layer};
          pg8::gemm_phase<EpiUp<false>, StaticOrder, 1>(lds, g, S, E, nullptr); }
        { Gemm g{H + (size_t)HS_SAMPLE * D, (const bf16*)(wl + W_UP), 256, FF2, D}; StaticOrder S; S.init(256, FF2, G, G - 1 - bid);
          EpiUp<true> E{(bf16*)(ws + WS_ACT), p.in[I_CW] + (size_t)layer * 3 * FF2, p.in[I_CB] + (size_t)layer * FF2, p.in[I_SCONV] + (size_t)layer * 16 * 2 * FF2, p.out, layer};
          pg8::gemm_phase<EpiUp<true>, StaticOrder, 0>(lds, g, S, E, nullptr); }
        GSYNC();
#endif
        if (PROBE == 6) { for (int i_ = 0; i_ < 10; ++i_) GSYNC(); }
#if !defined(ONLY) || ONLY == 10
        { Gemm g{(const bf16*)(ws + WS_ACT), (const bf16*)(wl + W_DN), TP, D, FF}; StaticOrder S; S.init(TP, D, G, bid);
          EpiRes E{X, X, modl + 5120};
          pg8::gemm_phase<EpiRes, StaticOrder, 0>(lds, g, S, E, nullptr);
          small_gemm<4>(g.A + (size_t)TP * FF, g.Bt, D, FF, TP, E, lds, bid, tid); }
#endif
        GSYNC();
    }
#if !defined(ONLY) || ONLY == 1
    norm_phase(p, 0, 2, bid, tid);
#endif
}
}

extern "C" void kernel_launch(void* const* d_in, const int* in_sizes, int n_in, void* d_out, int out_size, void* d_ws, size_t ws_size, hipStream_t stream) {
    static int ok = 0;
    if (ok == 0) {
        ok = 1;
        if (n_in != 31 || (size_t)out_size != mk::O_END || ws_size < mk::WS_BAR + mk::BAR_BYTES) { fprintf(stderr, "kernel_launch: unexpected shapes n_in %d out %d ws %zu (need %zu)\n", n_in, out_size, ws_size, (size_t)mk::WS_END); ok = -1; }
        if (hipFuncSetAttribute((const void*)mk::fwd, hipFuncAttributeMaxDynamicSharedMemorySize, mk::LDS_BYTES) != hipSuccess) { fprintf(stderr, "kernel_launch: hipFuncSetAttribute failed\n"); ok = -1; }
        int per_cu = 0;
        if (hipOccupancyMaxActiveBlocksPerMultiprocessor(&per_cu, (const void*)mk::fwd, mk::NTHR, mk::LDS_BYTES) != hipSuccess || per_cu < 1) fprintf(stderr, "kernel_launch: occupancy query says %d blocks per CU\n", per_cu);
        (void)hipGetLastError();
    }
    if (ok < 0) return;
    if (hipMemsetAsync((char*)d_ws + mk::WS_BAR, 0, mk::BAR_BYTES, stream) != hipSuccess) { fprintf(stderr, "kernel_launch: memset of the barrier words failed\n"); return; }
    mk::Params p{};
    for (int i = 0; i < 31; ++i) p.in[i] = (const float*)d_in[i];
    p.out = (float*)d_out; p.ws = (unsigned char*)d_ws;
    void* args[] = {&p};
    hipError_t e = hipLaunchCooperativeKernel((void*)mk::fwd, dim3(mk::NWG), dim3(mk::NTHR), args, mk::LDS_BYTES, stream);
    if (e != hipSuccess) fprintf(stderr, "kernel_launch: cooperative launch failed: %s\n", hipGetErrorString(e));
}
```
